# Optimizing an MI355X kernel written in HIP

```python
import math
import jax
import jax.numpy as jnp
from jax import lax
import numpy as np

D_MODEL = 1024
BATCH = 4
SEQ = 4096
DEPTH = 2

GRID_W = 64
CTX_LEN = 256
GLA_HEADS = 4
GLA_DK = 64
GLA_DV = 128
GLA_KEY = GLA_HEADS * GLA_DK
GLA_VAL = GLA_HEADS * GLA_DV
GLA_RANK = 16
GLA_GATE_NORM = 16.0
GLA_CHUNK = 64
S5_WIDTH = 512
S5_GROUP = 16
S5_GROUPS = S5_WIDTH // S5_GROUP
S5_STATE = 64
FFN_DENSE = 2816
N_EXPERTS = 8
TOP_K = 2
FFN_EXPERT = 3584
N_DENSE = (DEPTH + 1) // 2
N_MOE = DEPTH // 2
EPS = 1e-6
IN_SIZES = (GLA_KEY, GLA_VAL, GLA_RANK, GLA_RANK, S5_WIDTH, GLA_KEY, GLA_VAL, D_MODEL, D_MODEL)
IN_OFFSETS = tuple(int(o) for o in np.cumsum(IN_SIZES)[:-1])
IN_WIDTH = int(sum(IN_SIZES))
STATE_WIDTH = GLA_KEY + GLA_VAL + 2 * GLA_RANK + S5_WIDTH

kernel_name = 'hybrid_gla_s5_moe_prefix_dit'


def _rmsnorm(x, w):
    xf = x.astype(jnp.float32)
    y = xf * lax.rsqrt(jnp.mean(xf * xf, axis=-1, keepdims=True) + EPS)
    return (y * w.astype(jnp.float32)).astype(x.dtype)


def _modulate(h, shift, scale):
    return h * (1 + scale) + shift


def _flip(t):
    return jnp.flip(t, axis=1)


def _to_col(t, rows):
    b_, n, ch = t.shape
    return t.reshape(b_, rows, GRID_W, ch).transpose(0, 2, 1, 3).reshape(b_, n, ch)


def _to_row(t, rows):
    b_, n, ch = t.shape
    return t.reshape(b_, GRID_W, rows, ch).transpose(0, 2, 1, 3).reshape(b_, n, ch)


def _gla_chunked(q, k, v, g, s0):
    b_, n, h, dk = q.shape
    dv = v.shape[-1]
    nc = n // GLA_CHUNK
    q, k, v, g = (t.reshape(b_, nc, GLA_CHUNK, h, t.shape[-1]) for t in (q, k, v, g))
    bcum = jnp.cumsum(g, axis=2)
    blast = bcum[:, :, -1:]
    qd = q * jnp.exp(bcum)
    kd = k * jnp.exp(-bcum)
    kl = k * jnp.exp(blast - bcum)
    mask = jnp.tril(jnp.ones((GLA_CHUNK, GLA_CHUNK), bool))
    att = jnp.where(mask, jnp.einsum('bnihd,bnjhd->bnhij', qd, kd), 0.0)
    o = jnp.einsum('bnhij,bnjhe->bnihe', att, v)
    ds = jnp.einsum('bnjhd,bnjhe->nbhde', kl, v)
    decay = jnp.exp(blast[:, :, 0]).transpose(1, 0, 2, 3)

    def step(s, inp):
        d, dsn = inp
        return d[..., None] * s + dsn, s

    s_fin, s_start = lax.scan(step, s0, (decay, ds))
    o = o + jnp.einsum('bnihd,nbhde->bnihe', qd, s_start)
    return o.reshape(b_, n, h, dv), s_fin


def _gla_final_state(k, v, g):
    btot = jnp.cumsum(g, axis=1)
    kl = k * jnp.exp(btot[:, -1:] - btot)
    return jnp.einsum('blhd,blhe->bhde', kl, v)


def _gla_bidir(q, k, v, gf, gb, sf0, sb0):
    of, sf = _gla_chunked(q, k, v, gf, sf0)
    ob, sb = _gla_chunked(_flip(q), _flip(k), _flip(v), _flip(gb), sb0)
    return of + _flip(ob), sf, sb


def _s5_discretize(a_re, a_im, log_dt, b_re, b_im):
    f32 = jnp.float32
    lam = lax.complex(a_re.astype(f32), a_im.astype(f32))
    delta = jnp.exp(log_dt.astype(f32))[:, None]
    lam_bar = jnp.exp(lam * delta)
    b_mat = lax.complex(b_re.astype(f32), b_im.astype(f32))
    b_bar = ((lam_bar - 1) / lam)[..., None] * b_mat
    return lam_bar, b_bar


def _linear_combine(e1, e2):
    a1, b1 = e1
    a2, b2 = e2
    return a1 * a2, a2 * b1 + b2


def _s5_scan(u, lam_bar, b_bar, h0):
    bu = jnp.einsum('blgh,gph->blgp', u.astype(jnp.float32).astype(jnp.complex64), b_bar)
    a = jnp.broadcast_to(lam_bar, (1, u.shape[1]) + lam_bar.shape)
    a_cum, h = lax.associative_scan(_linear_combine, (a, bu), axis=1)
    if h0 is not None:
        h = h + a_cum * h0[:, None]
    return h


def _s5_bidir(u, disc_f, disc_b, h0f, h0b):
    b_, n, _ = u.shape
    ug = u.reshape(b_, n, S5_GROUPS, S5_GROUP)
    hf = _s5_scan(ug, *disc_f, h0f)
    hb = _flip(_s5_scan(_flip(ug), *disc_b, h0b))
    return hf, hb


def _s5_readout(hf, hb, u, c_mat, d_skip):
    b_, n, _ = u.shape
    y = jnp.real(jnp.einsum('blgp,ghp->blgh', hf + hb, c_mat)).reshape(b_, n, S5_WIDTH)
    return y.astype(u.dtype) + d_skip * u


def _state_inputs(k, v, zf, zb, u, p):
    b_, n, _ = k.shape
    gf = jax.nn.log_sigmoid((zf @ p['gla_lr_f'] + p['gla_bias_f']).astype(jnp.float32)) / GLA_GATE_NORM
    gb = jax.nn.log_sigmoid((zb @ p['gla_lr_b'] + p['gla_bias_b']).astype(jnp.float32)) / GLA_GATE_NORM
    hd = lambda t, d: t.reshape(b_, n, GLA_HEADS, d)
    return {'k': hd(k, GLA_DK), 'v': hd(v, GLA_DV), 'gf': hd(gf, GLA_DK), 'gb': hd(gb, GLA_DK), 'u': u}


def _project(h, p, full):
    b_, n, _ = h.shape
    if full:
        k, v, zf, zb, u, q, r, ga, gm = jnp.split(h @ p['w_in'], IN_OFFSETS, axis=-1)
        d = _state_inputs(k, v, zf, zb, u, p)
        d.update(q=q.reshape(b_, n, GLA_HEADS, GLA_DK) * GLA_DK ** -0.5, r=r, ga=ga, gm=gm)
        return d
    k, v, zf, zb, u = jnp.split(h @ p['w_in'][:, :STATE_WIDTH], IN_OFFSETS[:4], axis=-1)
    return _state_inputs(k, v, zf, zb, u, p)


def _merge(o_gla, y_s5, pr, p):
    b_, n = y_s5.shape[:2]
    dt = y_s5.dtype
    o = o_gla * lax.rsqrt(jnp.mean(o_gla * o_gla, axis=-1, keepdims=True) + EPS) * p['gla_norm_w'].astype(jnp.float32)
    o = o.reshape(b_, n, GLA_VAL).astype(dt) * jax.nn.silu(pr['r'])
    ya = o @ p['w_gla_proj']
    s = jax.nn.gelu(y_s5)
    s = s * jax.nn.sigmoid(s @ p['s5_w_glu'] + p['s5_b_glu'])
    yb = s @ p['w_s5_proj']
    m = jax.nn.sigmoid(pr['ga']) * ya + jax.nn.sigmoid(pr['gm']) * yb
    return m @ p['w_out']


def _token_mixer(hl, hc, p, rows, ctx_out):
    disc_f = _s5_discretize(p['s5_a_re_f'], p['s5_a_im_f'], p['s5_log_dt_f'], p['s5_b_re'], p['s5_b_im'])
    disc_b = _s5_discretize(p['s5_a_re_b'], p['s5_a_im_b'], p['s5_log_dt_b'], p['s5_b_re'], p['s5_b_im'])
    c_mat = lax.complex(p['s5_c_re'].astype(jnp.float32), p['s5_c_im'].astype(jnp.float32))
    pc = _project(hc, p, ctx_out)
    hcf, hcb = _s5_bidir(pc['u'], disc_f, disc_b, None, None)
    if ctx_out:
        s0 = jnp.zeros((hc.shape[0], GLA_HEADS, GLA_DK, GLA_DV), jnp.float32)
        oc, sfc, sbc = _gla_bidir(pc['q'], pc['k'], pc['v'], pc['gf'], pc['gb'], s0, s0)
        out_c = _merge(oc, _s5_readout(hcf, hcb, pc['u'], c_mat, p['s5_d']), pc, p)
    else:
        sfc = _gla_final_state(pc['k'], pc['v'], pc['gf'])
        sbc = _gla_final_state(_flip(pc['k']), _flip(pc['v']), _flip(pc['gb']))
        out_c = None
    pl = _project(hl, p, True)
    ol, _, _ = _gla_bidir(pl['q'], pl['k'], pl['v'], pl['gf'], pl['gb'], sfc, sbc)
    ul = _to_col(pl['u'], rows)
    hlf, hlb = _s5_bidir(ul, disc_f, disc_b, hcf[:, -1], hcb[:, 0])
    yl = _to_row(_s5_readout(hlf, hlb, ul, c_mat, p['s5_d']), rows)
    out_l = _merge(ol, yl, pl, p)
    return out_l, out_c


def _swiglu(h, w_gate, w_up, w_down):
    return (jax.nn.silu(h @ w_gate) * (h @ w_up)) @ w_down


def _moe(h, w_router, w_gate, w_up, w_down):
    logits = (h @ w_router).astype(jnp.float32)
    top_v, top_i = lax.top_k(logits, TOP_K)
    weights = jax.nn.softmax(top_v, axis=-1)
    gates = jnp.sum(jax.nn.one_hot(top_i, N_EXPERTS, dtype=jnp.float32) * weights[..., None], axis=-2).astype(h.dtype)
    out = jnp.zeros_like(h)
    for e in range(N_EXPERTS):
        out = out + gates[..., e:e + 1] * _swiglu(h, w_gate[e], w_up[e], w_down[e])
    return out


def setup_inputs(seed: int = 0) -> dict:
    key = jax.random.key(seed)
    ks = iter(jax.random.split(key, 64))
    f32 = jnp.float32
    nrm = lambda shape, scale: scale * jax.random.normal(next(ks), shape, f32)
    D, G, P, H, L_ = D_MODEL, S5_GROUPS, S5_STATE, S5_GROUP, DEPTH
    n_idx = jnp.arange(P, dtype=f32)
    log_dt = lambda: jax.random.uniform(next(ks), (L_, G), f32, math.log(1e-3), math.log(1e-1))
    return {
        'x': nrm((BATCH, SEQ, D), 1.0),
        'c': nrm((BATCH, D), 1.0),
        'ctx': nrm((BATCH, CTX_LEN, D), 1.0),
        'c_ctx': nrm((D,), 1.0),
        'w_mod': nrm((L_, D, 6 * D), 0.5 * D ** -0.5),
        'b_mod': nrm((L_, 6 * D), 0.01),
        'norm1_w': 1.0 + nrm((L_, D), 0.02),
        'norm2_w': 1.0 + nrm((L_, D), 0.02),
        'final_norm_w': 1.0 + nrm((D,), 0.02),
        'w_in': nrm((L_, D, IN_WIDTH), D ** -0.5),
        'gla_lr_f': nrm((L_, GLA_RANK, GLA_KEY), GLA_RANK ** -0.5),
        'gla_lr_b': nrm((L_, GLA_RANK, GLA_KEY), GLA_RANK ** -0.5),
        'gla_bias_f': nrm((L_, GLA_KEY), 0.1),
        'gla_bias_b': nrm((L_, GLA_KEY), 0.1),
        'gla_norm_w': 1.0 + nrm((L_, GLA_DV), 0.02),
        's5_a_re_f': -0.5 + nrm((L_, G, P), 0.01),
        's5_a_im_f': math.pi * n_idx + nrm((L_, G, P), 0.01),
        's5_log_dt_f': log_dt(),
        's5_a_re_b': -0.5 + nrm((L_, G, P), 0.01),
        's5_a_im_b': math.pi * n_idx + nrm((L_, G, P), 0.01),
        's5_log_dt_b': log_dt(),
        's5_b_re': nrm((L_, G, P, H), (2 * H) ** -0.5),
        's5_b_im': nrm((L_, G, P, H), (2 * H) ** -0.5),
        's5_c_re': nrm((L_, G, H, P), 2 ** -0.5),
        's5_c_im': nrm((L_, G, H, P), 2 ** -0.5),
        's5_d': nrm((L_, S5_WIDTH), 1.0),
        's5_w_glu': nrm((L_, S5_WIDTH, S5_WIDTH), S5_WIDTH ** -0.5),
        's5_b_glu': nrm((L_, S5_WIDTH), 0.01),
        'w_gla_proj': nrm((L_, GLA_VAL, D), GLA_VAL ** -0.5),
        'w_s5_proj': nrm((L_, S5_WIDTH, D), S5_WIDTH ** -0.5),
        'w_out': nrm((L_, D, D), D ** -0.5),
        'ffn_w_gate': nrm((N_DENSE, D, FFN_DENSE), D ** -0.5),
        'ffn_w_up': nrm((N_DENSE, D, FFN_DENSE), D ** -0.5),
        'ffn_w_down': nrm((N_DENSE, FFN_DENSE, D), FFN_DENSE ** -0.5),
        'moe_router': nrm((N_MOE, D, N_EXPERTS), D ** -0.5),
        'moe_w_gate': nrm((N_MOE, N_EXPERTS, D, FFN_EXPERT), D ** -0.5),
        'moe_w_up': nrm((N_MOE, N_EXPERTS, D, FFN_EXPERT), D ** -0.5),
        'moe_w_down': nrm((N_MOE, N_EXPERTS, FFN_EXPERT, D), FFN_EXPERT ** -0.5),
    }


def reference(x, c, ctx, c_ctx, w_mod, b_mod, norm1_w, norm2_w, final_norm_w, w_in,
              gla_lr_f, gla_lr_b, gla_bias_f, gla_bias_b, gla_norm_w,
              s5_a_re_f, s5_a_im_f, s5_log_dt_f, s5_a_re_b, s5_a_im_b, s5_log_dt_b,
              s5_b_re, s5_b_im, s5_c_re, s5_c_im, s5_d, s5_w_glu, s5_b_glu,
              w_gla_proj, w_s5_proj, w_out,
              ffn_w_gate, ffn_w_up, ffn_w_down,
              moe_router, moe_w_gate, moe_w_up, moe_w_down):
    D = D_MODEL
    rows = x.shape[1] // GRID_W
    silu_c = jax.nn.silu(c)
    silu_cc = jax.nn.silu(c_ctx)
    lat, cx = x, ctx
    for l in range(DEPTH):
        ctx_out = l < DEPTH - 1
        p = {
            'w_in': w_in[l], 'gla_lr_f': gla_lr_f[l], 'gla_lr_b': gla_lr_b[l],
            'gla_bias_f': gla_bias_f[l], 'gla_bias_b': gla_bias_b[l], 'gla_norm_w': gla_norm_w[l],
            's5_a_re_f': s5_a_re_f[l], 's5_a_im_f': s5_a_im_f[l], 's5_log_dt_f': s5_log_dt_f[l],
            's5_a_re_b': s5_a_re_b[l], 's5_a_im_b': s5_a_im_b[l], 's5_log_dt_b': s5_log_dt_b[l],
            's5_b_re': s5_b_re[l], 's5_b_im': s5_b_im[l], 's5_c_re': s5_c_re[l], 's5_c_im': s5_c_im[l],
            's5_d': s5_d[l], 's5_w_glu': s5_w_glu[l], 's5_b_glu': s5_b_glu[l],
            'w_gla_proj': w_gla_proj[l], 'w_s5_proj': w_s5_proj[l], 'w_out': w_out[l],
        }
        mod = (silu_c @ w_mod[l] + b_mod[l])[:, None, :]
        sh1, sc1, g1, sh2, sc2, g2 = jnp.split(mod, 6, axis=-1)
        n_mod = 6 if ctx_out else 2
        mc = jnp.split(silu_cc @ w_mod[l][:, :n_mod * D] + b_mod[l][:n_mod * D], n_mod)

        def channel_mixer(h):
            if l % 2 == 0:
                i = l // 2
                return _swiglu(h, ffn_w_gate[i], ffn_w_up[i], ffn_w_down[i])
            i = l // 2
            return _moe(h, moe_router[i], moe_w_gate[i], moe_w_up[i], moe_w_down[i])

        hl = _modulate(_rmsnorm(lat, norm1_w[l]), sh1, sc1)
        hc = _modulate(_rmsnorm(cx, norm1_w[l]), mc[0], mc[1])
        ml, mcx = _token_mixer(hl, hc, p, rows, ctx_out)
        lat = lat + g1 * ml
        lat = lat + g2 * channel_mixer(_modulate(_rmsnorm(lat, norm2_w[l]), sh2, sc2))
        if ctx_out:
            cx = cx + mc[2] * mcx
            cx = cx + mc[5] * channel_mixer(_modulate(_rmsnorm(cx, norm2_w[l]), mc[3], mc[4]))
    return _rmsnorm(lat, final_norm_w)
```

```cpp
#include <hip/hip_runtime.h>
#include <cstdio>
#include <cstdint>

#ifndef MK_ONE_LAUNCH
#define MK_ONE_LAUNCH 0
#endif

namespace pg8 {
#define PG8_LAS __attribute__((address_space(3)))
typedef unsigned short bf16_t;
typedef short bf16x8 __attribute__((ext_vector_type(8)));
typedef float f32x4 __attribute__((ext_vector_type(4)));
typedef unsigned u32x4 __attribute__((ext_vector_type(4)));
constexpr int BM = 256, BK = 64, HALF = 128, HTB = HALF * BK * 2, STAGE_BYTES = 8 * HTB, NXCD = 8, WGM = 8;

__host__ __device__ __forceinline__ int lds_byte(int r, int c) { const int st = (r >> 4) * 2 + (c >> 5), rr = r & 15, cc = c & 31, ob = rr * 64 + cc * 2; return st * 1024 + (ob ^ (((ob >> 9) & 1) << 5)); }
__host__ __device__ __forceinline__ void stage_rc(int b, int& R, int& C) { const int st = b / 1024, sb = b % 1024, swz = sb ^ (((sb >> 9) & 1) << 5); R = (st >> 1) * 16 + swz / 64; C = (st & 1) * 32 + (swz % 64) / 2; }
__host__ __device__ __forceinline__ int perm32(int rho) { const int n = rho >> 4, i = rho & 15; return 8 * (i >> 2) + 4 * n + (i & 3); }

struct Unit { int pm, pn, kind; const char* A; const char* B; };

struct Order {
    int G, c;
    int n0;
    const char* A0; const char* B0; int nM0, nN0, kind0;
    const char* A1; const char* B1; int nM1, nN1, kind1;
    size_t tstep;
    int pm0;
    int apm0;
    int moe; int pb1, pb2, pb3, pb4, pb5, pb6, pb7; size_t estride;
    __device__ __forceinline__ void init1(int G_, int c_, const void* A, const void* B, int nM, int nN, int K) {
        G = G_; c = c_; A0 = (const char*)A; B0 = (const char*)B; nM0 = nM; nN0 = nN; kind0 = 0; n0 = nM * nN; A1 = A0; B1 = B0; nM1 = 0; nN1 = 1; kind1 = 1;
        tstep = (size_t)256 * K * 2; pm0 = 0; apm0 = 0; moe = 0; pb1 = pb2 = pb3 = pb4 = pb5 = pb6 = pb7 = 0; estride = 0; }
    __device__ __forceinline__ bool next(int i, Unit& u) const {
        long L = (long)i * G + c; const bool s = L >= n0; if (s) L -= n0;
        const int nM = s ? nM1 : nM0, nN = s ? nN1 : nN0, nwg = nM * nN; if (L >= nwg) return false;
        int wgid = (int)L; { const int q = nwg / NXCD, r = nwg % NXCD, xcd = wgid % NXCD, off = wgid / NXCD; wgid = (xcd < r ? xcd * (q + 1) : r * (q + 1) + (xcd - r) * q) + off; }
        const int nig = WGM * nN, gid = wgid / nig, fm = gid * WGM, gsz = (nM - fm) < WGM ? (nM - fm) : WGM;
        const int pm = pm0 + fm + ((wgid % nig) % gsz), pn = (wgid % nig) / gsz;
        u.pm = pm; u.pn = pn; u.kind = s ? kind1 : kind0;
        u.A = (s ? A1 : A0) + (size_t)(pm - apm0) * tstep;
        const char* b = (s ? B1 : B0) + (size_t)pn * tstep;
        if (moe) { const int e = (pm >= pb1) + (pm >= pb2) + (pm >= pb3) + (pm >= pb4) + (pm >= pb5) + (pm >= pb6) + (pm >= pb7); b += (size_t)e * estride; }
        u.B = b; return true;
    }
    __device__ __forceinline__ void a_ready(const Unit&) const {}
    __device__ __forceinline__ void done(const Unit&) const {}
};

__device__ __forceinline__ unsigned cvt_pk_bf16(float lo, float hi) { unsigned r; asm volatile("v_cvt_pk_bf16_f32 %0, %1, %2" : "=v"(r) : "v"(lo), "v"(hi)); return r; }

template <class Epi, class Sched, bool ALIGN_EPI = true, bool SP2 = true>
__device__ __forceinline__ void gemm_phase(PG8_LAS unsigned char* lds, const int tid, const int K, const Sched& S, const Epi& E) {
    const int wid = __builtin_amdgcn_readfirstlane(tid >> 6), lane = tid & 63, wr = wid >> 2, wc = wid & 3, fr = lane & 15, fq = lane >> 4;
    const int nt = K / BK;
    unsigned voffA[2], voffB[2];
#pragma unroll
    for (int i = 0; i < 2; ++i) { int R, C; stage_rc(tid * 16 + i * 8192, R, C); const int Rb = ((R & ~31) + perm32(R & 31));
        voffA[i] = (unsigned)(R * K + C) * 2u; voffB[i] = (unsigned)(Rb * K + C) * 2u; }
    const size_t kstep = (size_t)(BK * 2);
    const size_t hstep = (size_t)HALF * K * 2;
    const unsigned ldsw = (unsigned)wid * 1024u;
    const int aoff = lds_byte(wr * 64 + fr, fq * 8), boff = lds_byte(wc * 32 + fr, fq * 8);
#define PG8_SA(b, h) (((b) * 2 + (h)) * HTB)
#define PG8_SB(b, h) ((4 + (b) * 2 + (h)) * HTB)
#define PG8_STAGE(bufoff, gbase, voff) do { _Pragma("unroll") for (int _i = 0; _i < 2; ++_i) \
        __builtin_amdgcn_global_load_lds((const unsigned*)((const char*)(gbase) + (voff)[_i]), (PG8_LAS unsigned*)(lds + (bufoff) + ldsw + _i * 8192), 16, 0, 0); } while (0)
#define PG8_LDA(dst, b, h) do { _Pragma("unroll") for (int m = 0; m < 4; ++m) _Pragma("unroll") for (int k = 0; k < 2; ++k) dst[m][k] = *(const PG8_LAS bf16x8*)(lds + PG8_SA(b, h) + aoff + m * 2048 + k * 1024); } while (0)
#define PG8_LDB(dst, b, h) do { _Pragma("unroll") for (int n = 0; n < 2; ++n) _Pragma("unroll") for (int k = 0; k < 2; ++k) dst[n][k] = *(const PG8_LAS bf16x8*)(lds + PG8_SB(b, h) + boff + n * 2048 + k * 1024); } while (0)
#define PG8_MMA(ai, bj, At, Bt) do { __builtin_amdgcn_s_setprio(1); _Pragma("unroll") for (int m = 0; m < 4; ++m) _Pragma("unroll") for (int n = 0; n < 2; ++n) _Pragma("unroll") for (int k = 0; k < 2; ++k) \
        acc[ai][bj][m][n] = __builtin_amdgcn_mfma_f32_16x16x32_bf16(Bt[n][k], At[m][k], acc[ai][bj][m][n], 0, 0, 0); __builtin_amdgcn_s_setprio(0); } while (0)
#define PG8_WAIT_V(n) asm volatile("s_waitcnt vmcnt(" #n ")" ::: "memory")
#define PG8_WAIT_L(n) asm volatile("s_waitcnt lgkmcnt(" #n ")" ::: "memory")
#define PG8_BAR __builtin_amdgcn_s_barrier()
#define PG8_SCHED __builtin_amdgcn_sched_barrier(0)
    Unit cur, nxt; int ui = 0;
    if (!S.next(0, cur)) return;
    f32x4 acc[2][2][4][2];
#pragma unroll
    for (int a = 0; a < 2; ++a)
#pragma unroll
        for (int b = 0; b < 2; ++b)
#pragma unroll
            for (int m = 0; m < 4; ++m)
#pragma unroll
                for (int n = 0; n < 2; ++n) acc[a][b][m][n] = (f32x4){0.f, 0.f, 0.f, 0.f};
    bf16x8 At[4][2], B0[2][2], B1[2][2];
    const char* cA = cur.A; const char* cB = cur.B;
    S.a_ready(cur);
    if constexpr (SP2) {
        PG8_STAGE(PG8_SB(0, 0), cB, voffB); PG8_STAGE(PG8_SB(0, 1), cB + hstep, voffB); PG8_STAGE(PG8_SA(0, 0), cA, voffA); PG8_STAGE(PG8_SA(0, 1), cA + hstep, voffA);
        if (wr == 1) PG8_BAR;
        PG8_WAIT_V(2); PG8_BAR;
        PG8_STAGE(PG8_SB(1, 0), cB + kstep, voffB); PG8_STAGE(PG8_SA(1, 0), cA + kstep, voffA); PG8_STAGE(PG8_SB(1, 1), cB + hstep + kstep, voffB);
        PG8_WAIT_V(6); PG8_BAR;
    } else {
        PG8_STAGE(PG8_SB(0, 0), cB, voffB); PG8_STAGE(PG8_SA(0, 0), cA, voffA); PG8_STAGE(PG8_SB(0, 1), cB + hstep, voffB); PG8_STAGE(PG8_SA(0, 1), cA + hstep, voffA);
        if (wr == 1) PG8_BAR;
        PG8_WAIT_V(4); PG8_BAR;
        PG8_STAGE(PG8_SB(1, 0), cB + kstep, voffB); PG8_STAGE(PG8_SA(1, 0), cA + kstep, voffA); PG8_STAGE(PG8_SB(1, 1), cB + hstep + kstep, voffB);
        PG8_WAIT_V(6); PG8_BAR;
    }
    for (;;) {
        const bool has_next = S.next(ui + 1, nxt);
        const char* nA = has_next ? nxt.A : cA; const char* nB = has_next ? nxt.B : cB;
        for (int t = 0; t < nt; t += 2) {
            const bool last = (t == nt - 2);
            const char* a1 = cA + (size_t)(t + 1) * kstep;
            const char* a2 = last ? nA : cA + (size_t)(t + 2) * kstep; const char* b2 = last ? nB : cB + (size_t)(t + 2) * kstep;
            const char* a3 = a2 + kstep; const char* b3 = b2 + kstep;
            if (last && has_next) S.a_ready(nxt);
            if constexpr (SP2) {
            PG8_LDB(B0, 0, 0); PG8_LDB(B1, 0, 1); PG8_SCHED; PG8_LDA(At, 0, 0); PG8_STAGE(PG8_SA(1, 1), a1 + hstep, voffA);
            PG8_WAIT_V(8); PG8_WAIT_L(0); PG8_BAR; PG8_MMA(0, 0, At, B0); PG8_MMA(0, 1, At, B1); PG8_BAR; PG8_SCHED;
            PG8_LDA(At, 0, 1); PG8_STAGE(PG8_SB(0, 0), b2, voffB); PG8_STAGE(PG8_SB(0, 1), b2 + hstep, voffB); PG8_STAGE(PG8_SA(0, 0), a2, voffA);
            PG8_WAIT_V(8); PG8_WAIT_L(0); PG8_BAR; PG8_MMA(1, 0, At, B0); PG8_MMA(1, 1, At, B1); PG8_BAR; PG8_SCHED;
            PG8_LDB(B0, 1, 0); PG8_LDB(B1, 1, 1); PG8_SCHED; PG8_LDA(At, 1, 0); PG8_STAGE(PG8_SA(0, 1), a2 + hstep, voffA);
            PG8_WAIT_V(8); PG8_WAIT_L(0); PG8_BAR; PG8_MMA(0, 0, At, B0); PG8_MMA(0, 1, At, B1); PG8_BAR; PG8_SCHED;
            PG8_LDA(At, 1, 1); PG8_STAGE(PG8_SB(1, 0), b3, voffB); PG8_STAGE(PG8_SB(1, 1), b3 + hstep, voffB); PG8_STAGE(PG8_SA(1, 0), a3, voffA);
            PG8_WAIT_V(8); PG8_WAIT_L(0); PG8_BAR; PG8_MMA(1, 0, At, B0); PG8_MMA(1, 1, At, B1); PG8_BAR; PG8_SCHED;
            } else {
            PG8_LDB(B0, 0, 0); PG8_SCHED; PG8_LDA(At, 0, 0); PG8_STAGE(PG8_SA(1, 1), a1 + hstep, voffA);
            PG8_WAIT_L(8); PG8_BAR; PG8_WAIT_L(0); PG8_MMA(0, 0, At, B0); PG8_BAR; PG8_SCHED;
            PG8_LDB(B1, 0, 1); PG8_STAGE(PG8_SB(0, 0), b2, voffB);
            PG8_BAR; PG8_WAIT_L(0); PG8_MMA(0, 1, At, B1); PG8_BAR;
            PG8_LDA(At, 0, 1); PG8_STAGE(PG8_SA(0, 0), a2, voffA);
            PG8_BAR; PG8_WAIT_L(0); PG8_MMA(1, 0, At, B0); PG8_BAR; PG8_SCHED;
            PG8_STAGE(PG8_SB(0, 1), b2 + hstep, voffB);
            PG8_WAIT_V(6); PG8_BAR; PG8_MMA(1, 1, At, B1); PG8_BAR;
            PG8_LDB(B0, 1, 0); PG8_SCHED; PG8_LDA(At, 1, 0); PG8_STAGE(PG8_SA(0, 1), a2 + hstep, voffA);
            PG8_WAIT_L(8); PG8_BAR; PG8_WAIT_L(0); PG8_MMA(0, 0, At, B0); PG8_BAR; PG8_SCHED;
            PG8_LDB(B1, 1, 1); PG8_STAGE(PG8_SB(1, 0), b3, voffB);
            PG8_BAR; PG8_WAIT_L(0); PG8_MMA(0, 1, At, B1); PG8_BAR;
            PG8_LDA(At, 1, 1); PG8_STAGE(PG8_SA(1, 0), a3, voffA);
            PG8_BAR; PG8_WAIT_L(0); PG8_MMA(1, 0, At, B0); PG8_BAR; PG8_SCHED;
            PG8_STAGE(PG8_SB(1, 1), b3 + hstep, voffB);
            PG8_WAIT_V(6); PG8_BAR; PG8_MMA(1, 1, At, B1); PG8_BAR;
            }
        }
        if constexpr (ALIGN_EPI) { if (wr == 0) PG8_BAR; }
        E(acc, cur, wr, wc, fr, fq); S.done(cur);
        if (!has_next) break;
#pragma unroll
        for (int a = 0; a < 2; ++a)
#pragma unroll
            for (int b = 0; b < 2; ++b)
#pragma unroll
                for (int m = 0; m < 4; ++m)
#pragma unroll
                    for (int n = 0; n < 2; ++n) acc[a][b][m][n] = (f32x4){0.f, 0.f, 0.f, 0.f};
        cur = nxt; cA = nA; cB = nB; ++ui;
        if constexpr (ALIGN_EPI) { if (wr == 1) PG8_BAR; }
    }
    PG8_WAIT_V(0);
    if constexpr (!ALIGN_EPI) { if (wr == 0) PG8_BAR; }
    PG8_BAR;
#undef PG8_SA
#undef PG8_SB
#undef PG8_STAGE
#undef PG8_LDA
#undef PG8_LDB
#undef PG8_MMA
#undef PG8_WAIT_V
#undef PG8_WAIT_L
#undef PG8_BAR
#undef PG8_SCHED
}
}

constexpr int NWAVES = 8;
constexpr int D = 1024, NBATCH = 4, SEQ = 4096, CTXL = 256;
constexpr int NLAT = NBATCH * SEQ, NCTX = NBATCH * CTXL, NROW = NLAT + NCTX, NPAN = NROW / 256;
constexpr int INW_SRC = 4128, INW = 4608;
constexpr int FFD = 2816, FFE = 3584, NEXP = 8;
constexpr float EPS = 1e-6f;

constexpr size_t MiB = 1u << 20;
constexpr size_t WS_CTL = 0, CTL_ZERO_BYTES = 1 * MiB;
constexpr size_t WS_TAB = 1 * MiB;
constexpr size_t WS_LATX = 8 * MiB;
constexpr size_t WS_W = 76 * MiB;
constexpr size_t WS_XN = 120 * MiB;
constexpr size_t WS_IP = 154 * MiB;
constexpr size_t WS_DS = 324 * MiB;
constexpr size_t WS_S5F = 392 * MiB;
constexpr size_t WS_OG = 401 * MiB;
constexpr size_t WS_SG = 418 * MiB;
constexpr size_t WS_O32 = 435 * MiB;
constexpr size_t WS_Y32 = 469 * MiB;
constexpr size_t WS_WM = 76 * MiB;
constexpr size_t WS_XG = 244 * MiB;
constexpr size_t WS_HM = 312 * MiB;
constexpr size_t WS_YS = 424 * MiB;
constexpr size_t WS_END = 504 * MiB;
constexpr size_t IP_K = 0, IP_V = IP_K + (size_t)NROW * 256 * 2, IP_GF = IP_V + (size_t)NROW * 512 * 2, IP_GB = IP_GF + (size_t)NROW * 256 * 4,
                 IP_U = IP_GB + (size_t)NROW * 256 * 4, IP_Q = IP_U + (size_t)NROW * 512 * 2, IP_R = IP_Q + (size_t)NROW * 256 * 2,
                 IP_GA = IP_R + (size_t)NROW * 512 * 2, IP_GM = IP_GA + (size_t)NROW * 1024 * 2, IP_END = IP_GM + (size_t)NROW * 1024 * 2;
static_assert(IP_END <= 170 * MiB, "in-proj region");
constexpr size_t IP_T = IP_K;
constexpr size_t IP_S2 = IP_U;
constexpr size_t IP_HMID = 0;
static_assert((size_t)NROW * 1024 * 2 <= IP_GB, "T overlay");
static_assert((size_t)NROW * FFD * 2 <= 170 * MiB, "HMID overlay");
constexpr size_t W_IN = 0;
constexpr size_t W_GLU = 18 * MiB;
constexpr size_t W_GP = 19 * MiB;
constexpr size_t W_SP = 21 * MiB;
constexpr size_t W_OUT = 23 * MiB;
constexpr size_t W_FGU = 27 * MiB;
constexpr size_t W_FD = 38 * MiB;
constexpr size_t WM_GU = 0;
constexpr size_t WM_D = 112 * MiB;
constexpr size_t T_MODV = 0;
constexpr size_t T_LAMB = 256 * 1024;
constexpr size_t T_BBAR = 512 * 1024;
constexpr size_t T_TOKE = 2 * MiB;
constexpr size_t T_TOKW = 2 * MiB + 256 * 1024;
constexpr size_t T_TOKS = 2 * MiB + 512 * 1024;
constexpr int CW_TMO = 0, CW_CODE = 1;
constexpr int CW_BAR = 4096;
constexpr int CW_CNT = 16384;

constexpr int RING_OFF = 0, RING_BYTES = 131072;
constexpr int LDSCTL_OFF = RING_BYTES, MISC_OFF = LDSCTL_OFF + 320;
constexpr int LDS_BYTES = 147456;

#define GAS __attribute__((address_space(1)))
#define LAS __attribute__((address_space(3)))
typedef unsigned short bf16;
typedef unsigned v4u __attribute__((ext_vector_type(4)));
typedef unsigned v2u __attribute__((ext_vector_type(2)));
typedef float f32x4 __attribute__((ext_vector_type(4)));
typedef float f32x2 __attribute__((ext_vector_type(2)));
typedef short bf16x8 __attribute__((ext_vector_type(8)));
typedef GAS unsigned gu32;
#define RLX_AGENT __ATOMIC_RELAXED, __HIP_MEMORY_SCOPE_AGENT
#define LDS_WAIT() asm volatile("s_waitcnt lgkmcnt(0)" ::: "memory")
#define VM_WAIT() asm volatile("s_waitcnt vmcnt(0)" ::: "memory")
__device__ __forceinline__ unsigned f2bf(float f) { unsigned u = __builtin_bit_cast(unsigned, f); return (u + 0x7fffu + ((u >> 16) & 1u)) >> 16; }
__device__ __forceinline__ unsigned pk2(float lo, float hi) { return f2bf(lo) | (f2bf(hi) << 16); }
__device__ __forceinline__ float bf2f(unsigned b) { return __builtin_bit_cast(float, b << 16); }
__device__ __forceinline__ float bflo(unsigned w) { return __builtin_bit_cast(float, w << 16); }
__device__ __forceinline__ float bfhi(unsigned w) { return __builtin_bit_cast(float, w & 0xffff0000u); }
__device__ __forceinline__ float sigmoidf_(float x) { return __builtin_amdgcn_rcpf(1.0f + __expf(-x)); }
__device__ __forceinline__ float siluf_(float x) { return x * __builtin_amdgcn_rcpf(1.0f + __expf(-x)); }
__device__ __forceinline__ float geluf_(float x) { const float t = 1.5957691216057308f * (x + 0.044715f * x * x * x); return x * __builtin_amdgcn_rcpf(1.0f + __expf(-t)); }
__device__ __forceinline__ float logsigmoidf_(float z) { return fminf(z, 0.f) - __logf(1.0f + __expf(-fabsf(z))); }

#define XB_TMO      128
#define XB_XCNT(j)  (256  + 64 * (j))
#define XB_XSUB(j)  (1280 + 64 * (j))
#define XB_XGEN(j)  (2304 + 64 * (j))
#define XB_TOP      3328
#define XB_TOPGEN   3392
#define XCD_BAR_WORDS 3456
#define XB_SPIN_CAP (1u << 18)
__device__ __forceinline__ unsigned xb_ld(unsigned* p)              { return __hip_atomic_load(p, __ATOMIC_RELAXED, __HIP_MEMORY_SCOPE_AGENT); }
__device__ __forceinline__ unsigned xb_add(unsigned* p, unsigned v) { return __hip_atomic_fetch_add(p, v, __ATOMIC_RELAXED, __HIP_MEMORY_SCOPE_AGENT); }
__device__ __forceinline__ unsigned xb_xcc_id() { return (unsigned)__builtin_amdgcn_s_getreg((3 << 11) | 20) & 0xFu; }
#define XB_SPIN(cond, bar) do { unsigned _sp = 0; while (cond) { __builtin_amdgcn_s_sleep(1); \
    if ((++_sp & 255u) == 0u) { if (xb_ld(&(bar)[XB_TMO])) break; if (_sp > XB_SPIN_CAP) { atomicAdd(&(bar)[XB_TMO], 1u); break; } } } } while (0)
struct XcdBarrier { unsigned* bar; unsigned x; volatile LAS unsigned* st; };
__device__ __forceinline__ XcdBarrier xcd_barrier_post(unsigned* bar, volatile LAS unsigned* st) {
    XcdBarrier b; b.bar = bar; b.x = xb_xcc_id(); b.st = st;
    if (threadIdx.x == 0) (void)xb_add(&bar[XB_XCNT(b.x)], 1u);
    return b;
}
__device__ __forceinline__ void xcd_barrier_complete(unsigned* bar, unsigned x, unsigned& nloc, unsigned& nx) {
    const unsigned G = gridDim.x * gridDim.y * gridDim.z;
    unsigned sum, cnt, mine, sp = 0u;
    for (;;) {
        sum = 0u; cnt = 0u; mine = 0u;
#pragma unroll
        for (unsigned j = 0; j < 16; ++j) { const unsigned c = xb_ld(&bar[XB_XCNT(j)]); sum += c; cnt += (c > 0u) ? 1u : 0u; mine = (j == x) ? c : mine; }
        if (sum == G) break;
        __builtin_amdgcn_s_sleep(1);
        if ((++sp & 255u) == 0u) { if (xb_ld(&bar[XB_TMO])) break; if (sp > XB_SPIN_CAP) { atomicAdd(&bar[XB_TMO], 1u); break; } }
    }
    nloc = mine > 0u ? mine : 1u; nx = cnt > 0u ? cnt : 1u;
}
__device__ __forceinline__ void xcd_barrier(const XcdBarrier& b) {
    asm volatile("s_waitcnt vmcnt(0)" ::: "memory");
    __syncthreads();
    if (threadIdx.x == 0) {
        unsigned* bar = b.bar;
        __builtin_amdgcn_s_waitcnt(0);
        unsigned nloc = b.st[0], nx = b.st[1];
        if (nloc == 0u) { xcd_barrier_complete(bar, b.x, nloc, nx); b.st[0] = nloc; b.st[1] = nx; }
        const unsigned old = xb_add(&bar[XB_XSUB(b.x)], 1u);
        const unsigned gen = old / nloc;
        if (old + 1u == (gen + 1u) * nloc) {
            __builtin_amdgcn_fence(__ATOMIC_RELEASE, "agent");
            asm volatile("s_waitcnt vmcnt(0)" ::: "memory");
            const unsigned og = xb_add(&bar[XB_TOP], 1u);
            const unsigned tg = og / nx;
            if (og + 1u == (tg + 1u) * nx) xb_add(&bar[XB_TOPGEN], 1u);
            else XB_SPIN(xb_ld(&bar[XB_TOPGEN]) == tg, bar);
            __builtin_amdgcn_fence(__ATOMIC_ACQUIRE, "agent");
            xb_add(&bar[XB_XGEN(b.x)], 1u);
            asm volatile("s_waitcnt vmcnt(0)" ::: "memory");
        } else {
            XB_SPIN(xb_ld(&bar[XB_XGEN(b.x)]) == gen, bar);
            __builtin_amdgcn_fence(__ATOMIC_ACQUIRE, "agent");
            asm volatile("s_waitcnt vmcnt(0)" ::: "memory");
        }
    }
    __syncthreads();
}

enum InIdx { I_X = 0, I_C, I_CTX, I_CCTX, I_WMOD, I_BMOD, I_N1W, I_N2W, I_FNW, I_WIN, I_LRF, I_LRB, I_BIASF, I_BIASB, I_GNW,
             I_AREF, I_AIMF, I_LDTF, I_AREB, I_AIMB, I_LDTB, I_BRE, I_BIM, I_CRE, I_CIM, I_S5D, I_WGLU, I_BGLU, I_WGP, I_WSP, I_WOUT,
             I_FG, I_FU, I_FD, I_ROUTER, I_MG, I_MU, I_MD, N_IN };
struct Args { const float* in[N_IN]; float* out; unsigned char* ws; int ph_lo, ph_hi; };

__device__ __forceinline__ float wave_sum(float v) {
#pragma unroll
    for (int o = 1; o < 64; o <<= 1) v += __shfl_xor(v, o);
    return v;
}

__device__ __forceinline__ void transpose_item(const float* W, int ldw, int k0, int n0, bf16* WT, int ldt, int drow0, LAS float* scr, int lane) {
#pragma unroll 8
    for (int i = 0; i < 32; ++i) { const int kk = 2 * i + (lane >> 5); scr[kk * 33 + (lane & 31)] = W[(size_t)(k0 + kk) * ldw + n0 + (lane & 31)]; }
    LDS_WAIT(); asm volatile("" ::: "memory");
    const int c = lane & 7;
#pragma unroll
    for (int j = 0; j < 4; ++j) { const int n = (lane >> 3) + 8 * j; const LAS float* s = scr + (8 * c) * 33 + n;
        v4u o; o.x = pk2(s[0 * 33], s[1 * 33]); o.y = pk2(s[2 * 33], s[3 * 33]); o.z = pk2(s[4 * 33], s[5 * 33]); o.w = pk2(s[6 * 33], s[7 * 33]);
        *(GAS v4u*)(WT + (size_t)(drow0 + n) * ldt + k0 + 8 * c) = o; }
    LDS_WAIT(); asm volatile("" ::: "memory");
}
__device__ __forceinline__ bool conv_matrix(int& r, const float* W, int K, int N, bf16* WT, int mode, int roff, LAS float* scr, int lane) {
    const int nblk = N / 32, items = (K / 64) * nblk;
    if (r >= items) { r -= items; return false; }
    const int kb = r / nblk, nb = r % nblk, k0 = 64 * kb, n0 = 32 * nb;
    int drow0;
    if (mode == 0) drow0 = n0 + roff;
    else if (mode == 1) { if (n0 == 768) return true; drow0 = n0 < 768 ? n0 : n0 + 480; }
    else drow0 = (n0 >> 7) * 256 + (n0 & 127) + roff;
    transpose_item(W, N, k0, n0, WT, K, drow0, scr, lane);
    return true;
}

using pg8::Unit; using pg8::cvt_pk_bf16;
typedef pg8::f32x4 accv;
#define EPI_ARGS const accv (&acc)[2][2][4][2], const Unit& u, int wr, int wc, int fr, int fq
__device__ __forceinline__ v4u pack8(f32x4 a, f32x4 b) { v4u w; w.x = cvt_pk_bf16(a[0], a[1]); w.y = cvt_pk_bf16(a[2], a[3]); w.z = cvt_pk_bf16(b[0], b[1]); w.w = cvt_pk_bf16(b[2], b[3]); return w; }
__device__ __forceinline__ void unpack8(v4u w, f32x4& a, f32x4& b) { a = (f32x4){bflo(w.x), bfhi(w.x), bflo(w.y), bfhi(w.y)}; b = (f32x4){bflo(w.z), bfhi(w.z), bflo(w.w), bfhi(w.w)}; }

struct EpiInProj {
    bf16 *Kb, *Vb, *Ub, *Qb, *Rb, *GAb, *GMb; float *GF, *GB; const float *bias_f, *bias_b;
    __device__ __forceinline__ void operator()(EPI_ARGS) const {
        const int pn = u.pn, row0 = u.pm * 256 + wr * 64 + fr, cw = wc * 32 + 8 * fq;
        if (pn == 3 || pn == 4) {
            float* dst = pn == 3 ? GF : GB; const float* bias = pn == 3 ? bias_f : bias_b;
#pragma unroll
            for (int bj = 0; bj < 2; ++bj) { const int c = cw + bj * 128; const f32x4 b0 = *(const f32x4*)(bias + c), b1 = *(const f32x4*)(bias + c + 4);
#pragma unroll
                for (int ai = 0; ai < 2; ++ai)
#pragma unroll
                    for (int m = 0; m < 4; ++m) { float* p = dst + (size_t)(row0 + ai * 128 + m * 16) * 256 + c; f32x4 v0 = acc[ai][bj][m][0] + b0, v1 = acc[ai][bj][m][1] + b1;
#pragma unroll
                        for (int j = 0; j < 4; ++j) { v0[j] = logsigmoidf_(v0[j]) * 0.0625f; v1[j] = logsigmoidf_(v1[j]) * 0.0625f; }
                        *(f32x4*)p = v0; *(f32x4*)(p + 4) = v1; } }
            return;
        }
        bf16* dst; int ld, cb, act;
        if (pn == 0) { dst = Kb; ld = 256; cb = 0; act = 0; }
        else if (pn <= 2) { dst = Vb; ld = 512; cb = (pn - 1) * 256; act = 0; }
        else if (pn <= 6) { dst = Ub; ld = 512; cb = (pn - 5) * 256; act = 0; }
        else if (pn == 7) { dst = Qb; ld = 256; cb = 0; act = 1; }
        else if (pn <= 9) { dst = Rb; ld = 512; cb = (pn - 8) * 256; act = 2; }
        else if (pn <= 13) { dst = GAb; ld = 1024; cb = (pn - 10) * 256; act = 3; }
        else { dst = GMb; ld = 1024; cb = (pn - 14) * 256; act = 3; }
#pragma unroll
        for (int ai = 0; ai < 2; ++ai)
#pragma unroll
            for (int m = 0; m < 4; ++m) { bf16* rowp = dst + (size_t)(row0 + ai * 128 + m * 16) * ld + cb + cw;
#pragma unroll
                for (int bj = 0; bj < 2; ++bj) { f32x4 v0 = acc[ai][bj][m][0], v1 = acc[ai][bj][m][1];
                    if (act == 1) { v0 = v0 * 0.125f; v1 = v1 * 0.125f; }
                    else if (act == 2) {
#pragma unroll
                        for (int j = 0; j < 4; ++j) { v0[j] = siluf_(v0[j]); v1[j] = siluf_(v1[j]); } }
                    else if (act == 3) {
#pragma unroll
                        for (int j = 0; j < 4; ++j) { v0[j] = sigmoidf_(v0[j]); v1[j] = sigmoidf_(v1[j]); } }
                    *(v4u*)(rowp + bj * 128) = pack8(v0, v1); } }
    }
};
struct EpiD12 {
    const bf16* SG; bf16* S2; const float* bglu; const bf16* GA; bf16* T;
    __device__ __forceinline__ void operator()(EPI_ARGS) const {
        const int row0 = u.pm * 256 + wr * 64 + fr, c0 = u.pn * 256 + wc * 32 + 8 * fq;
#pragma unroll
        for (int ai = 0; ai < 2; ++ai)
#pragma unroll
            for (int m = 0; m < 4; ++m) { const size_t row = (size_t)(row0 + ai * 128 + m * 16);
#pragma unroll
                for (int bj = 0; bj < 2; ++bj) { const int c = c0 + bj * 128; f32x4 v0 = acc[ai][bj][m][0], v1 = acc[ai][bj][m][1], s0, s1;
                    if (u.kind == 0) { const f32x4 b0 = *(const f32x4*)(bglu + c), b1 = *(const f32x4*)(bglu + c + 4); unpack8(*(const v4u*)(SG + row * 512 + c), s0, s1);
#pragma unroll
                        for (int j = 0; j < 4; ++j) { v0[j] = s0[j] * sigmoidf_(v0[j] + b0[j]); v1[j] = s1[j] * sigmoidf_(v1[j] + b1[j]); }
                        *(v4u*)(S2 + row * 512 + c) = pack8(v0, v1); }
                    else { unpack8(*(const v4u*)(GA + row * 1024 + c), s0, s1); *(v4u*)(T + row * 1024 + c) = pack8(v0 * s0, v1 * s1); } } }
    }
};
struct EpiD3 {
    const bf16* T; const bf16* GM; bf16* MB;
    __device__ __forceinline__ void operator()(EPI_ARGS) const {
        const int row0 = u.pm * 256 + wr * 64 + fr, c0 = u.pn * 256 + wc * 32 + 8 * fq;
#pragma unroll
        for (int ai = 0; ai < 2; ++ai)
#pragma unroll
            for (int m = 0; m < 4; ++m) { const size_t row = (size_t)(row0 + ai * 128 + m * 16);
#pragma unroll
                for (int bj = 0; bj < 2; ++bj) { const int c = c0 + bj * 128; f32x4 t0, t1, g0, g1; unpack8(*(const v4u*)(T + row * 1024 + c), t0, t1); unpack8(*(const v4u*)(GM + row * 1024 + c), g0, g1);
                    *(v4u*)(MB + row * 1024 + c) = pack8(t0 + g0 * acc[ai][bj][m][0], t1 + g1 * acc[ai][bj][m][1]); } }
    }
};
struct EpiResid {
    const float* rl; const float* rc; float* out; const float* modv; int gidx;
    __device__ __forceinline__ void operator()(EPI_ARGS) const {
        const int row0 = u.pm * 256 + wr * 64 + fr, c0 = u.pn * 256 + wc * 32 + 8 * fq;
        const int bi = u.pm < NLAT / 256 ? (u.pm >> 4) : 4;
        const float* gp = modv + bi * 6144 + gidx * 1024;
#pragma unroll
        for (int bj = 0; bj < 2; ++bj) { const int c = c0 + bj * 128; const f32x4 g0 = *(const f32x4*)(gp + c), g1 = *(const f32x4*)(gp + c + 4);
#pragma unroll
            for (int ai = 0; ai < 2; ++ai)
#pragma unroll
                for (int m = 0; m < 4; ++m) { const int row = row0 + ai * 128 + m * 16;
                    const float* rp = (row < NLAT ? rl + (size_t)row * 1024 : rc + (size_t)(row - NLAT) * 1024) + c; float* op = out + (size_t)row * 1024 + c;
                    const f32x4 r0 = *(const f32x4*)rp, r1 = *(const f32x4*)(rp + 4);
                    *(f32x4*)op = r0 + g0 * acc[ai][bj][m][0]; *(f32x4*)(op + 4) = r1 + g1 * acc[ai][bj][m][1]; } }
    }
};
struct EpiSwiglu {
    bf16* H; int ld; int pmoff;
    __device__ __forceinline__ void operator()(EPI_ARGS) const {
        const int row0 = (u.pm - pmoff) * 256 + wr * 64 + fr, c = u.pn * 128 + wc * 32 + 8 * fq;
#pragma unroll
        for (int ai = 0; ai < 2; ++ai)
#pragma unroll
            for (int m = 0; m < 4; ++m) { f32x4 g0 = acc[ai][0][m][0], g1 = acc[ai][0][m][1]; const f32x4 u0 = acc[ai][1][m][0], u1 = acc[ai][1][m][1];
#pragma unroll
                for (int j = 0; j < 4; ++j) { g0[j] = siluf_(g0[j]) * u0[j]; g1[j] = siluf_(g1[j]) * u1[j]; }
                *(v4u*)(H + (size_t)(row0 + ai * 128 + m * 16) * ld + c) = pack8(g0, g1); }
    }
};
struct EpiPlain {
    bf16* Y;
    __device__ __forceinline__ void operator()(EPI_ARGS) const {
        const int row0 = u.pm * 256 + wr * 64 + fr, c0 = u.pn * 256 + wc * 32 + 8 * fq;
#pragma unroll
        for (int ai = 0; ai < 2; ++ai)
#pragma unroll
            for (int m = 0; m < 4; ++m)
#pragma unroll
                for (int bj = 0; bj < 2; ++bj) *(v4u*)(Y + (size_t)(row0 + ai * 128 + m * 16) * 1024 + c0 + bj * 128) = pack8(acc[ai][bj][m][0], acc[ai][bj][m][1]);
    }
};

constexpr int NPH = 25;

__global__ void __launch_bounds__(NWAVES * 64, 2) fwd_kernel(Args args) {
    extern __shared__ __attribute__((aligned(16))) unsigned char lds_raw[];
    LAS unsigned char* lds = (LAS unsigned char*)lds_raw;
    volatile LAS unsigned* MISC = (volatile LAS unsigned*)(lds + MISC_OFF);
    const int G = gridDim.x; const int bx = blockIdx.x; const int vcu = (G % 8 == 0) ? (bx % 8) * (G / 8) + bx / 8 : bx;
    const int NGW = G * NWAVES;
    for (int i = threadIdx.x; i < (LDS_BYTES - LDSCTL_OFF) / 4; i += NWAVES * 64) ((LAS unsigned*)(lds + LDSCTL_OFF))[i] = 0u;
    __syncthreads();
    XcdBarrier bar; bar.bar = (unsigned*)(args.ws + WS_CTL) + CW_BAR; bar.x = 0; bar.st = nullptr;
    if (MK_ONE_LAUNCH) bar = xcd_barrier_post((unsigned*)(args.ws + WS_CTL) + CW_BAR, MISC + 8);
    const int lo = args.ph_lo, hi = args.ph_hi;
#define IN(k) (lo <= (k) && (k) < hi)
#define SEAM(k) do { if (lo <= (k) && (k) + 1 < hi) xcd_barrier(bar); } while (0)

#define PHASE_BEGIN() int tid_ = threadIdx.x; asm volatile("" : "+v"(tid_)); unsigned char* ws = args.ws; asm volatile("" : "+s"(ws)); \
    const int tid = tid_, lane = tid & 63, wave = __builtin_amdgcn_readfirstlane(tid >> 6), gw = vcu * NWAVES + wave; (void)lane; (void)gw; \
    const float* const* in = args.in; (void)in; gu32* ctl = (gu32*)(ws + WS_CTL); (void)ctl;
#define LATX ((float*)(ws + WS_LATX))
#define XN ((bf16*)(ws + WS_XN))
#define Kb ((bf16*)(ws + WS_IP + IP_K))
#define Vb ((bf16*)(ws + WS_IP + IP_V))
#define GF ((float*)(ws + WS_IP + IP_GF))
#define GB ((float*)(ws + WS_IP + IP_GB))
#define Ub ((bf16*)(ws + WS_IP + IP_U))
#define Qb ((bf16*)(ws + WS_IP + IP_Q))
#define Rb ((bf16*)(ws + WS_IP + IP_R))
#define GAb ((bf16*)(ws + WS_IP + IP_GA))
#define GMb ((bf16*)(ws + WS_IP + IP_GM))
#define Tb ((bf16*)(ws + WS_IP + IP_T))
#define S2 ((bf16*)(ws + WS_IP + IP_S2))
#define HMID ((bf16*)(ws + WS_IP + IP_HMID))
#define OG ((bf16*)(ws + WS_OG))
#define SG ((bf16*)(ws + WS_SG))
#define O32 ((float*)(ws + WS_O32))
#define Y32 ((float*)(ws + WS_Y32))
#define MODV ((float*)(ws + WS_TAB + T_MODV))
#define LAMB ((f32x2*)(ws + WS_TAB + T_LAMB))
#define BBAR ((f32x2*)(ws + WS_TAB + T_BBAR))
#define TOKE ((int4*)(ws + WS_TAB + T_TOKE))
#define TOKW ((f32x2*)(ws + WS_TAB + T_TOKW))
#define TOKS ((int2*)(ws + WS_TAB + T_TOKS))
#define wb (ws + WS_W)
#define WMGU ((bf16*)(ws + WS_WM + WM_GU))
#define WMD ((bf16*)(ws + WS_WM + WM_D))
#define XG ((bf16*)(ws + WS_XG))
#define HM ((bf16*)(ws + WS_HM))
#define YS ((bf16*)(ws + WS_YS))

    if (IN(0)) { PHASE_BEGIN();
        {
            LAS float* sil = (LAS float*)(lds + 73728);
            LAS float* red = (LAS float*)(lds + 73728 + 20480);
            for (int i = tid; i < 5 * 1024; i += 512) { const int bi = i >> 10, k = i & 1023; const float v = bi < 4 ? in[I_C][bi * 1024 + k] : in[I_CCTX][k]; sil[i] = siluf_(v); }
            __syncthreads();
            for (int it = vcu; it < 2 * 96; it += G) {
                const int l = it / 96, n0 = (it % 96) * 64, kk = lane >> 4, q = lane & 15;
                f32x4 a[5];
#pragma unroll
                for (int bi = 0; bi < 5; ++bi) a[bi] = (f32x4){0.f, 0.f, 0.f, 0.f};
                const float* wp = in[I_WMOD] + (size_t)l * 1024 * 6144 + n0 + 4 * q;
#pragma unroll 4
                for (int i2 = 0; i2 < 32; ++i2) { const int k = wave * 128 + i2 * 4 + kk; const f32x4 w = *(const f32x4*)(wp + (size_t)k * 6144);
#pragma unroll
                    for (int bi = 0; bi < 5; ++bi) a[bi] = a[bi] + w * sil[bi * 1024 + k]; }
#pragma unroll
                for (int bi = 0; bi < 5; ++bi)
#pragma unroll
                    for (int j = 0; j < 4; ++j) { float v = a[bi][j]; v += __shfl_xor(v, 16); v += __shfl_xor(v, 32); a[bi][j] = v; }
                if (lane < 16) {
#pragma unroll
                    for (int bi = 0; bi < 5; ++bi)
#pragma unroll
                        for (int j = 0; j < 4; ++j) red[(wave * 5 + bi) * 64 + 4 * q + j] = a[bi][j]; }
                __syncthreads();
                if (tid < 320) { const int bi = tid >> 6, cc = tid & 63; float s = 0.f;
#pragma unroll
                    for (int w = 0; w < 8; ++w) s += red[(w * 5 + bi) * 64 + cc];
                    MODV[(l * 5 + bi) * 6144 + n0 + cc] = s + in[I_BMOD][l * 6144 + n0 + cc]; }
                __syncthreads();
            }
        }
        for (int i = gw * 64 + lane; i < 2 * 2 * 32 * 64; i += NGW * 64) {
            const int p = i & 63, g = (i >> 6) & 31, dir = (i >> 11) & 1, l = i >> 12;
            const float* are = in[dir ? I_AREB : I_AREF]; const float* aim = in[dir ? I_AIMB : I_AIMF]; const float* ldt = in[dir ? I_LDTB : I_LDTF];
            const double ar = are[(l * 32 + g) * 64 + p], ai = aim[(l * 32 + g) * 64 + p], dt = exp((double)ldt[l * 32 + g]);
            const double mag = exp(ar * dt), lr = mag * cos(ai * dt), li = mag * sin(ai * dt);
            LAMB[i] = (f32x2){(float)lr, (float)li};
            const double nr = lr - 1.0, ni = li, den = ar * ar + ai * ai, cr = (nr * ar + ni * ai) / den, ci = (ni * ar - nr * ai) / den;
            const float* bre = in[I_BRE] + ((size_t)(l * 32 + g) * 64 + p) * 16; const float* bim = in[I_BIM] + ((size_t)(l * 32 + g) * 64 + p) * 16;
            for (int j = 0; j < 16; ++j) { const double br = bre[j], bi2 = bim[j]; BBAR[(size_t)i * 16 + j] = (f32x2){(float)(cr * br - ci * bi2), (float)(cr * bi2 + ci * br)}; }
        }
        for (int i = gw * 64 + lane; i < 2 * 2 * 256 * 128; i += NGW * 64) {
            const int kc = i & 127, n = (i >> 7) & 255, dir = (i >> 15) & 1, l = i >> 16;
            const float* lr = in[dir ? I_LRB : I_LRF] + (size_t)l * 16 * 256 + n; float lrv[16];
#pragma unroll
            for (int j = 0; j < 16; ++j) lrv[j] = lr[j * 256];
            float o[8];
#pragma unroll
            for (int kk = 0; kk < 8; ++kk) { const float* wr_ = in[I_WIN] + ((size_t)l * 1024 + kc * 8 + kk) * INW_SRC + 768 + 16 * dir; float s = 0.f;
#pragma unroll
                for (int j4 = 0; j4 < 4; ++j4) { const f32x4 w = *(const f32x4*)(wr_ + 4 * j4); s += w[0] * lrv[4 * j4] + w[1] * lrv[4 * j4 + 1] + w[2] * lrv[4 * j4 + 2] + w[3] * lrv[4 * j4 + 3]; }
                o[kk] = s; }
            v4u w; w.x = pk2(o[0], o[1]); w.y = pk2(o[2], o[3]); w.z = pk2(o[4], o[5]); w.w = pk2(o[6], o[7]);
            *(v4u*)((bf16*)(wb + W_IN) + ((size_t)l * INW + 768 + 256 * dir + n) * 1024 + kc * 8) = w;
        }
        {
            LAS float* scr = (LAS float*)(lds + wave * 9216);
            constexpr int IT_IN = 16 * 129, IT_GLU = 8 * 16, IT_P = 8 * 32, IT_OUT = 16 * 32, IT_F = 16 * 88, IT_FD = 44 * 32;
            constexpr int IT_L = IT_IN + IT_GLU + 2 * IT_P + IT_OUT, NIT = 2 * IT_L + 2 * IT_F + IT_FD;
            for (int it = gw; it < NIT; it += NGW) {
                int r = it;
                if (r < 2 * IT_L) { const int l = r / IT_L; r -= l * IT_L;
                    if (conv_matrix(r, in[I_WIN] + (size_t)l * 1024 * INW_SRC, 1024, INW_SRC, (bf16*)(wb + W_IN) + (size_t)l * INW * 1024, 1, 0, scr, lane)) continue;
                    if (conv_matrix(r, in[I_WGLU] + (size_t)l * 512 * 512, 512, 512, (bf16*)(wb + W_GLU) + (size_t)l * 512 * 512, 0, 0, scr, lane)) continue;
                    if (conv_matrix(r, in[I_WGP] + (size_t)l * 512 * 1024, 512, 1024, (bf16*)(wb + W_GP) + (size_t)l * 1024 * 512, 0, 0, scr, lane)) continue;
                    if (conv_matrix(r, in[I_WSP] + (size_t)l * 512 * 1024, 512, 1024, (bf16*)(wb + W_SP) + (size_t)l * 1024 * 512, 0, 0, scr, lane)) continue;
                    conv_matrix(r, in[I_WOUT] + (size_t)l * 1024 * 1024, 1024, 1024, (bf16*)(wb + W_OUT) + (size_t)l * 1024 * 1024, 0, 0, scr, lane); continue; }
                r -= 2 * IT_L;
                if (conv_matrix(r, in[I_FG], 1024, FFD, (bf16*)(wb + W_FGU), 2, 0, scr, lane)) continue;
                if (conv_matrix(r, in[I_FU], 1024, FFD, (bf16*)(wb + W_FGU), 2, 128, scr, lane)) continue;
                conv_matrix(r, in[I_FD], FFD, 1024, (bf16*)(wb + W_FD), 0, 0, scr, lane);
            }
        }
    }
    SEAM(0);

    for (int l = 0; l < 2; ++l) {
        const int pb = 1 + 9 * l;
#define MODVL (MODV + (size_t)l * 5 * 6144)
#define RES_L (l == 0 ? in[I_X] : (const float*)LATX)
#define RES_C (l == 0 ? in[I_CTX] : (const float*)(LATX + (size_t)NLAT * 1024))
        const int nrows = NROW;
        const int mpan = l == 0 ? NPAN : NLAT / 256;
        if (IN(pb + 0)) { PHASE_BEGIN();
            const float* nw = in[I_N1W] + l * 1024;
            for (int row = gw; row < nrows; row += NGW) {
                const float* xr = row < NLAT ? RES_L + (size_t)row * 1024 : RES_C + (size_t)(row - NLAT) * 1024;
                const int bi = row < NLAT ? row >> 12 : 4; const float* sh = MODVL + bi * 6144; const float* sc = sh + 1024;
                f32x4 v[4]; float ss = 0.f;
#pragma unroll
                for (int j = 0; j < 4; ++j) { v[j] = *(const f32x4*)(xr + 4 * lane + 256 * j); ss += v[j][0] * v[j][0] + v[j][1] * v[j][1] + v[j][2] * v[j][2] + v[j][3] * v[j][3]; }
                const float rstd = rsqrtf(wave_sum(ss) * (1.f / 1024.f) + EPS);
#pragma unroll
                for (int j = 0; j < 4; ++j) { const int c = 4 * lane + 256 * j; const f32x4 w = *(const f32x4*)(nw + c), s1 = *(const f32x4*)(sc + c), s0 = *(const f32x4*)(sh + c);
                    f32x4 y;
#pragma unroll
                    for (int e = 0; e < 4; ++e) y[e] = v[j][e] * rstd * w[e] * (1.f + s1[e]) + s0[e];
                    v2u o; o.x = pk2(y[0], y[1]); o.y = pk2(y[2], y[3]); *(v2u*)(XN + (size_t)row * 1024 + c) = o; }
            }
        }
        SEAM(pb + 0);
        if (IN(pb + 1)) { PHASE_BEGIN();
            pg8::Order S; S.init1(G, bx, XN, (bf16*)(wb + W_IN) + (size_t)l * INW * 1024, NPAN, 18, 1024);
            EpiInProj E{Kb, Vb, Ub, Qb, Rb, GAb, GMb, GF, GB, in[I_BIASF] + l * 256, in[I_BIASB] + l * 256};
            pg8::gemm_phase<EpiInProj, pg8::Order>(lds + RING_OFF, tid, 1024, S, E);
        }
        SEAM(pb + 1);
        if (IN(pb + 2)) { PHASE_BEGIN();
            if (vcu < 16) {
                const int b = vcu >> 2, h = vcu & 3, e = tid >> 2, dq = tid & 3;
                for (int dir = 0; dir < 2; ++dir) {
                    float S[16];
#pragma unroll
                    for (int i = 0; i < 16; ++i) S[i] = 0.f;
                    const float* Gp = dir ? GB : GF;
                    for (int t = 0; t < CTXL + SEQ; ++t) {
                        int row;
                        if (dir == 0) row = t < CTXL ? NLAT + b * CTXL + t : b * SEQ + (t - CTXL);
                        else row = t < CTXL ? NLAT + b * CTXL + (CTXL - 1 - t) : b * SEQ + (SEQ - 1 - (t - CTXL));
                        const v4u k0 = *(const v4u*)(Kb + (size_t)row * 256 + h * 64 + 16 * dq), k1 = *(const v4u*)(Kb + (size_t)row * 256 + h * 64 + 16 * dq + 8);
                        const v4u q0 = *(const v4u*)(Qb + (size_t)row * 256 + h * 64 + 16 * dq), q1 = *(const v4u*)(Qb + (size_t)row * 256 + h * 64 + 16 * dq + 8);
                        f32x4 ka, kb2, kc, kd, qa, qb2, qc, qd; unpack8(k0, ka, kb2); unpack8(k1, kc, kd); unpack8(q0, qa, qb2); unpack8(q1, qc, qd);
                        const float* gp = Gp + (size_t)row * 256 + h * 64 + 16 * dq;
                        const f32x4 g0 = *(const f32x4*)gp, g1 = *(const f32x4*)(gp + 4), g2 = *(const f32x4*)(gp + 8), g3 = *(const f32x4*)(gp + 12);
                        const float v = bf2f(Vb[(size_t)row * 512 + h * 128 + e]);
                        float kk[16] = {ka[0], ka[1], ka[2], ka[3], kb2[0], kb2[1], kb2[2], kb2[3], kc[0], kc[1], kc[2], kc[3], kd[0], kd[1], kd[2], kd[3]};
                        float qq[16] = {qa[0], qa[1], qa[2], qa[3], qb2[0], qb2[1], qb2[2], qb2[3], qc[0], qc[1], qc[2], qc[3], qd[0], qd[1], qd[2], qd[3]};
                        float gg[16] = {g0[0], g0[1], g0[2], g0[3], g1[0], g1[1], g1[2], g1[3], g2[0], g2[1], g2[2], g2[3], g3[0], g3[1], g3[2], g3[3]};
                        float o = 0.f;
#pragma unroll
                        for (int i = 0; i < 16; ++i) { S[i] = __expf(gg[i]) * S[i] + kk[i] * v; o += qq[i] * S[i]; }
                        o += __shfl_xor(o, 1); o += __shfl_xor(o, 2);
                        if (dq == 0) { float* op = O32 + (size_t)row * 512 + h * 128 + e; *op = dir ? *op + o : o; }
                    }
                }
                __builtin_amdgcn_fence(__ATOMIC_RELEASE, "agent"); VM_WAIT(); __syncthreads(); __builtin_amdgcn_fence(__ATOMIC_ACQUIRE, "agent"); VM_WAIT();
                const float* gnw = in[I_GNW] + l * 128;
                for (int i = wave; i < CTXL + SEQ; i += NWAVES) {
                    const int row = i < SEQ ? b * SEQ + i : NLAT + b * CTXL + (i - SEQ);
                    const f32x2 o = *(const f32x2*)(O32 + (size_t)row * 512 + h * 128 + 2 * lane);
                    const float rstd = rsqrtf(wave_sum(o[0] * o[0] + o[1] * o[1]) * (1.f / 128.f) + EPS);
                    const unsigned rr = *(const unsigned*)(Rb + (size_t)row * 512 + h * 128 + 2 * lane);
                    *(unsigned*)(OG + (size_t)row * 512 + h * 128 + 2 * lane) = pk2(o[0] * rstd * gnw[2 * lane] * bflo(rr), o[1] * rstd * gnw[2 * lane + 1] * bfhi(rr));
                }
            } else if (vcu < 32) {
                const int item = (vcu - 16) * 8 + wave, b = item >> 5, g = item & 31;
                LAS f32x2* Ct = (LAS f32x2*)(lds + wave * 9216);
                LAS f32x2* hb = (LAS f32x2*)(lds + wave * 9216 + 8192);
                for (int i = lane; i < 1024; i += 64) { const int p = i >> 4, hh = i & 15; Ct[i] = (f32x2){in[I_CRE][((size_t)(l * 32 + g) * 16 + hh) * 64 + p], in[I_CIM][((size_t)(l * 32 + g) * 16 + hh) * 64 + p]}; }
                LDS_WAIT();
                const int hh = lane & 15, pq = lane >> 4;
                const float dsk = in[I_S5D][l * 512 + 16 * g + hh];
                for (int dir = 0; dir < 2; ++dir) {
                    const f32x2 lam = LAMB[((l * 2 + dir) * 32 + g) * 64 + lane];
                    float br[16], bim_[16];
#pragma unroll
                    for (int j = 0; j < 16; ++j) { const f32x2 v = BBAR[((size_t)((l * 2 + dir) * 32 + g) * 64 + lane) * 16 + j]; br[j] = v[0]; bim_[j] = v[1]; }
                    float hr = 0.f, hi_ = 0.f;
                    for (int t = 0; t < CTXL + SEQ; ++t) {
                        int row;
                        if (dir == 0) { if (t < CTXL) row = NLAT + b * CTXL + t; else { const int q = t - CTXL, c = q >> 6, r = q & 63; row = b * SEQ + r * 64 + c; } }
                        else { if (t < CTXL) row = NLAT + b * CTXL + (CTXL - 1 - t); else { const int q = SEQ - 1 - (t - CTXL), c = q >> 6, r = q & 63; row = b * SEQ + r * 64 + c; } }
                        const v4u u0 = *(const v4u*)(Ub + (size_t)row * 512 + 16 * g), u1 = *(const v4u*)(Ub + (size_t)row * 512 + 16 * g + 8);
                        f32x4 ua, ub, uc, ud; unpack8(u0, ua, ub); unpack8(u1, uc, ud);
                        const float uu[16] = {ua[0], ua[1], ua[2], ua[3], ub[0], ub[1], ub[2], ub[3], uc[0], uc[1], uc[2], uc[3], ud[0], ud[1], ud[2], ud[3]};
                        float sr = 0.f, si = 0.f;
#pragma unroll
                        for (int j = 0; j < 16; ++j) { sr += br[j] * uu[j]; si += bim_[j] * uu[j]; }
                        const float nr = lam[0] * hr - lam[1] * hi_ + sr, ni = lam[0] * hi_ + lam[1] * hr + si; hr = nr; hi_ = ni;
                        hb[lane] = (f32x2){hr, hi_};
                        LDS_WAIT();
                        float y = 0.f;
#pragma unroll
                        for (int pp = 0; pp < 16; ++pp) { const f32x2 c = Ct[(16 * pq + pp) * 16 + hh], hv = hb[16 * pq + pp]; y += c[0] * hv[0] - c[1] * hv[1]; }
                        y += __shfl_xor(y, 16); y += __shfl_xor(y, 32);
                        LDS_WAIT();
                        if (lane < 16) {
                            float* yp = Y32 + (size_t)row * 512 + 16 * g + hh;
                            if (dir == 0) *yp = y;
                            else { const float tot = *yp + y + dsk * bf2f(Ub[(size_t)row * 512 + 16 * g + hh]); SG[(size_t)row * 512 + 16 * g + hh] = (bf16)f2bf(geluf_(tot)); }
                        }
                    }
                }
            }
        }
        SEAM(pb + 2);
        if (IN(pb + 3)) { PHASE_BEGIN();
            pg8::Order S; S.init1(G, bx, SG, (bf16*)(wb + W_GLU) + (size_t)l * 512 * 512, mpan, 2, 512);
            S.A1 = (const char*)OG; S.B1 = (const char*)((bf16*)(wb + W_GP) + (size_t)l * 1024 * 512); S.nM1 = mpan; S.nN1 = 4; S.kind1 = 1;
            EpiD12 E{SG, S2, in[I_BGLU] + l * 512, GAb, Tb};
            pg8::gemm_phase<EpiD12, pg8::Order>(lds + RING_OFF, tid, 512, S, E);
        }
        SEAM(pb + 3);
        if (IN(pb + 4)) { PHASE_BEGIN();
            pg8::Order S; S.init1(G, bx, S2, (bf16*)(wb + W_SP) + (size_t)l * 1024 * 512, mpan, 4, 512);
            EpiD3 E{Tb, GMb, XN};
            pg8::gemm_phase<EpiD3, pg8::Order>(lds + RING_OFF, tid, 512, S, E);
        }
        SEAM(pb + 4);
        if (IN(pb + 5)) { PHASE_BEGIN();
            pg8::Order S; S.init1(G, bx, XN, (bf16*)(wb + W_OUT) + (size_t)l * 1024 * 1024, mpan, 4, 1024);
            EpiResid E{RES_L, RES_C, LATX, MODVL, 2};
            pg8::gemm_phase<EpiResid, pg8::Order>(lds + RING_OFF, tid, 1024, S, E);
        }
        SEAM(pb + 5);
        if (IN(pb + 6)) { PHASE_BEGIN();
            const float* nw = in[I_N2W] + l * 1024;
            LAS float* rw = (LAS float*)(lds);
            if (l == 1) { for (int i = tid; i < 8192; i += 512) rw[i] = in[I_ROUTER][i]; __syncthreads(); }
            const int nr2 = l == 0 ? NROW : NLAT;
            for (int row = gw; row < nr2; row += NGW) {
                const float* xr = LATX + (size_t)row * 1024;
                const int bi = row < NLAT ? row >> 12 : 4; const float* sh = MODVL + bi * 6144 + 3 * 1024; const float* sc = sh + 1024;
                f32x4 v[4]; float ss = 0.f;
#pragma unroll
                for (int j = 0; j < 4; ++j) { v[j] = *(const f32x4*)(xr + 4 * lane + 256 * j); ss += v[j][0] * v[j][0] + v[j][1] * v[j][1] + v[j][2] * v[j][2] + v[j][3] * v[j][3]; }
                const float rstd = rsqrtf(wave_sum(ss) * (1.f / 1024.f) + EPS);
                float lg[8];
#pragma unroll
                for (int e = 0; e < 8; ++e) lg[e] = 0.f;
#pragma unroll
                for (int j = 0; j < 4; ++j) { const int c = 4 * lane + 256 * j; const f32x4 w = *(const f32x4*)(nw + c), s1 = *(const f32x4*)(sc + c), s0 = *(const f32x4*)(sh + c);
                    f32x4 y;
#pragma unroll
                    for (int e = 0; e < 4; ++e) y[e] = v[j][e] * rstd * w[e] * (1.f + s1[e]) + s0[e];
                    if (l == 0) { v2u o; o.x = pk2(y[0], y[1]); o.y = pk2(y[2], y[3]); *(v2u*)(XN + (size_t)row * 1024 + c) = o; }
                    else {
#pragma unroll
                        for (int e = 0; e < 4; ++e) { const f32x4 r0 = *(const LAS f32x4*)(rw + (c + e) * 8), r1 = *(const LAS f32x4*)(rw + (c + e) * 8 + 4);
                            lg[0] += y[e] * r0[0]; lg[1] += y[e] * r0[1]; lg[2] += y[e] * r0[2]; lg[3] += y[e] * r0[3]; lg[4] += y[e] * r1[0]; lg[5] += y[e] * r1[1]; lg[6] += y[e] * r1[2]; lg[7] += y[e] * r1[3]; } } }
                if (l == 1) {
#pragma unroll
                    for (int e = 0; e < 8; ++e) lg[e] = wave_sum(lg[e]);
                    int e1 = 0; float v1 = lg[0];
#pragma unroll
                    for (int e = 1; e < 8; ++e) if (lg[e] > v1) { v1 = lg[e]; e1 = e; }
                    int e2 = -1; float v2 = -3.0e38f;
#pragma unroll
                    for (int e = 0; e < 8; ++e) if (e != e1 && lg[e] > v2) { v2 = lg[e]; e2 = e; }
                    if (lane == 0) {
                        const float w1 = 1.f / (1.f + __expf(v2 - v1));
                        const int p1 = (int)__hip_atomic_fetch_add(ctl + CW_CNT + 64 * e1, 1u, RLX_AGENT), p2 = (int)__hip_atomic_fetch_add(ctl + CW_CNT + 64 * e2, 1u, RLX_AGENT);
                        TOKE[row] = make_int4(e1, p1, e2, p2); TOKW[row] = (f32x2){w1, 1.f - w1};
                    }
                }
            }
        }
        SEAM(pb + 6);
        if (l == 0) {
            if (IN(8)) { PHASE_BEGIN();
                pg8::Order S; S.init1(G, bx, XN, (bf16*)(wb + W_FGU), NPAN, 22, 1024);
                EpiSwiglu E{HMID, FFD, 0};
                pg8::gemm_phase<EpiSwiglu, pg8::Order>(lds + RING_OFF, tid, 1024, S, E);
            }
            SEAM(8);
            if (IN(9)) { PHASE_BEGIN();
                pg8::Order S; S.init1(G, bx, HMID, (bf16*)(wb + W_FD), NPAN, 4, FFD);
                EpiResid E{LATX, LATX + (size_t)NLAT * 1024, LATX, MODVL, 5};
                pg8::gemm_phase<EpiResid, pg8::Order>(lds + RING_OFF, tid, FFD, S, E);
            }
            SEAM(9);
        }
    }

    int pbase[9];
    {
        int a = 0;
#pragma unroll
        for (int e = 0; e < 8; ++e) { pbase[e] = a; const unsigned c = hi > 17 ? __hip_atomic_load((gu32*)(args.ws + WS_CTL) + CW_CNT + 64 * e, RLX_AGENT) : 0u; a += (int)((c + 255u) >> 8); }
        pbase[8] = a;
    }
    if (IN(17)) { PHASE_BEGIN();
        {
            LAS float* scr = (LAS float*)(lds + wave * 9216);
            constexpr int IT_G = 16 * 112, IT_D = 56 * 32, IT_E = 2 * IT_G + IT_D;
            for (int it = gw; it < 8 * IT_E; it += NGW) {
                const int e = it / IT_E; int r = it - e * IT_E;
                if (conv_matrix(r, in[I_MG] + (size_t)e * 1024 * FFE, 1024, FFE, WMGU + (size_t)e * 7168 * 1024, 2, 0, scr, lane)) continue;
                if (conv_matrix(r, in[I_MU] + (size_t)e * 1024 * FFE, 1024, FFE, WMGU + (size_t)e * 7168 * 1024, 2, 128, scr, lane)) continue;
                conv_matrix(r, in[I_MD] + (size_t)e * FFE * 1024, FFE, 1024, WMD + (size_t)e * 1024 * FFE, 0, 0, scr, lane);
            }
        }
        const float* modv = MODV + (size_t)5 * 6144; const float* nw = in[I_N2W] + 1024;
        for (int row = gw; row < NLAT; row += NGW) {
            const float* xr = LATX + (size_t)row * 1024;
            const int bi = row >> 12; const float* sh = modv + bi * 6144 + 3 * 1024; const float* sc = sh + 1024;
            f32x4 v[4]; float ss = 0.f;
#pragma unroll
            for (int j = 0; j < 4; ++j) { v[j] = *(const f32x4*)(xr + 4 * lane + 256 * j); ss += v[j][0] * v[j][0] + v[j][1] * v[j][1] + v[j][2] * v[j][2] + v[j][3] * v[j][3]; }
            const float rstd = rsqrtf(wave_sum(ss) * (1.f / 1024.f) + EPS);
            const int4 te = TOKE[row];
            int s1 = 0, s2 = 0;
#pragma unroll
            for (int e = 0; e < 8; ++e) { if (te.x == e) s1 = pbase[e] * 256 + te.y; if (te.z == e) s2 = pbase[e] * 256 + te.w; }
            if (lane == 0) TOKS[row] = make_int2(s1, s2);
#pragma unroll
            for (int j = 0; j < 4; ++j) { const int c = 4 * lane + 256 * j; const f32x4 w = *(const f32x4*)(nw + c), a1 = *(const f32x4*)(sc + c), a0 = *(const f32x4*)(sh + c);
                f32x4 y;
#pragma unroll
                for (int e = 0; e < 4; ++e) y[e] = v[j][e] * rstd * w[e] * (1.f + a1[e]) + a0[e];
                v2u o; o.x = pk2(y[0], y[1]); o.y = pk2(y[2], y[3]); *(v2u*)(XG + (size_t)s1 * 1024 + c) = o; *(v2u*)(XG + (size_t)s2 * 1024 + c) = o; }
        }
    }
    SEAM(17);
    for (int g = 0; g < 3; ++g) {
        const int p0 = 64 * g, np = pbase[8] - p0 < 64 ? (pbase[8] - p0 < 0 ? 0 : pbase[8] - p0) : 64;
        if (IN(18 + 2 * g)) { PHASE_BEGIN();
            pg8::Order S; S.init1(G, bx, XG, WMGU, np, 28, 1024);
            S.pm0 = p0; S.moe = 1; S.pb1 = pbase[1]; S.pb2 = pbase[2]; S.pb3 = pbase[3]; S.pb4 = pbase[4]; S.pb5 = pbase[5]; S.pb6 = pbase[6]; S.pb7 = pbase[7]; S.estride = (size_t)7168 * 1024 * 2;
            EpiSwiglu E{HM, FFE, p0};
            pg8::gemm_phase<EpiSwiglu, pg8::Order>(lds + RING_OFF, tid, 1024, S, E);
        }
        SEAM(18 + 2 * g);
        if (IN(19 + 2 * g)) { PHASE_BEGIN();
            pg8::Order S; S.init1(G, bx, HM, WMD, np, 4, FFE);
            S.pm0 = p0; S.apm0 = p0; S.moe = 1; S.pb1 = pbase[1]; S.pb2 = pbase[2]; S.pb3 = pbase[3]; S.pb4 = pbase[4]; S.pb5 = pbase[5]; S.pb6 = pbase[6]; S.pb7 = pbase[7]; S.estride = (size_t)1024 * FFE * 2;
            EpiPlain E{YS};
            pg8::gemm_phase<EpiPlain, pg8::Order>(lds + RING_OFF, tid, FFE, S, E);
        }
        SEAM(19 + 2 * g);
    }
    if (IN(24)) { PHASE_BEGIN();
        const float* modv = MODV + (size_t)5 * 6144; const float* fw = in[I_FNW];
        for (int row = gw; row < NLAT; row += NGW) {
            const float* xr = LATX + (size_t)row * 1024; const int bi = row >> 12; const float* g2 = modv + bi * 6144 + 5 * 1024;
            const int2 sl = TOKS[row]; const f32x2 tw = TOKW[row];
            f32x4 v[4]; float ss = 0.f;
#pragma unroll
            for (int j = 0; j < 4; ++j) { const int c = 4 * lane + 256 * j; const f32x4 x = *(const f32x4*)(xr + c), gg = *(const f32x4*)(g2 + c);
                const v2u y1 = *(const v2u*)(YS + (size_t)sl.x * 1024 + c), y2 = *(const v2u*)(YS + (size_t)sl.y * 1024 + c);
                const f32x4 a = (f32x4){bflo(y1.x), bfhi(y1.x), bflo(y1.y), bfhi(y1.y)}, bq = (f32x4){bflo(y2.x), bfhi(y2.x), bflo(y2.y), bfhi(y2.y)};
                v[j] = x + gg * (a * tw[0] + bq * tw[1]);
                ss += v[j][0] * v[j][0] + v[j][1] * v[j][1] + v[j][2] * v[j][2] + v[j][3] * v[j][3]; }
            const float rstd = rsqrtf(wave_sum(ss) * (1.f / 1024.f) + EPS);
#pragma unroll
            for (int j = 0; j < 4; ++j) { const int c = 4 * lane + 256 * j; const f32x4 w = *(const f32x4*)(fw + c); *(f32x4*)(args.out + (size_t)row * 1024 + c) = v[j] * rstd * w; }
        }
    }
#undef IN
#undef SEAM
}

extern "C" void kernel_launch(void* const* d_in, const int* in_sizes, int n_in, void* d_out, int out_size, void* d_ws, size_t ws_size, hipStream_t stream) {
    static int grid = 0;
    if (grid == 0) {
        if (n_in != N_IN || out_size != NLAT * D || ws_size < WS_END) { fprintf(stderr, "kernel_launch: unexpected shapes (n_in %d, out %d, ws %zu)\n", n_in, out_size, ws_size); grid = -1; return; }
        int dev = 0, cus = 0, per_cu = 0;
        if (hipGetDevice(&dev) != hipSuccess || hipDeviceGetAttribute(&cus, hipDeviceAttributeMultiprocessorCount, dev) != hipSuccess) { grid = -1; return; }
        if (hipFuncSetAttribute((const void*)fwd_kernel, hipFuncAttributeMaxDynamicSharedMemorySize, LDS_BYTES) != hipSuccess) { fprintf(stderr, "kernel_launch: hipFuncSetAttribute failed\n"); grid = -1; return; }
        if (hipOccupancyMaxActiveBlocksPerMultiprocessor(&per_cu, (const void*)fwd_kernel, NWAVES * 64, LDS_BYTES) != hipSuccess || per_cu < 1) fprintf(stderr, "kernel_launch: occupancy query reports %d\n", per_cu);
        (void)hipGetLastError();
        grid = cus;
    }
    if (grid < 0) return;
    if (hipMemsetAsync((char*)d_ws + WS_CTL, 0, CTL_ZERO_BYTES, stream) != hipSuccess) return;
    Args a{};
    for (int i = 0; i < N_IN; ++i) a.in[i] = (const float*)d_in[i];
    a.out = (float*)d_out; a.ws = (unsigned char*)d_ws;
#if MK_ONE_LAUNCH
    a.ph_lo = 0; a.ph_hi = NPH;
    hipLaunchKernelGGL(fwd_kernel, dim3(grid), dim3(NWAVES * 64), LDS_BYTES, stream, a);
#else
    for (int p = 0; p < NPH; ++p) { a.ph_lo = p; a.ph_hi = p + 1; hipLaunchKernelGGL(fwd_kernel, dim3(grid), dim3(NWAVES * 64), LDS_BYTES, stream, a); }
#endif
}
```

```cpp
#include <hip/hip_runtime.h>
#include <cstdio>
#include <cstdint>

#ifndef MK_ONE_LAUNCH
#define MK_ONE_LAUNCH 1
#endif

namespace pg8 {
#define PG8_LAS __attribute__((address_space(3)))
typedef unsigned short bf16_t;
typedef short bf16x8 __attribute__((ext_vector_type(8)));
typedef float f32x4 __attribute__((ext_vector_type(4)));
typedef unsigned u32x4 __attribute__((ext_vector_type(4)));
constexpr int BM = 256, BK = 64, HALF = 128, HTB = HALF * BK * 2, STAGE_BYTES = 8 * HTB, NXCD = 8, WGM = 8;

__host__ __device__ __forceinline__ int lds_byte(int r, int c) { const int st = (r >> 4) * 2 + (c >> 5), rr = r & 15, cc = c & 31, ob = rr * 64 + cc * 2; return st * 1024 + (ob ^ (((ob >> 9) & 1) << 5)); }
__host__ __device__ __forceinline__ void stage_rc(int b, int& R, int& C) { const int st = b / 1024, sb = b % 1024, swz = sb ^ (((sb >> 9) & 1) << 5); R = (st >> 1) * 16 + swz / 64; C = (st & 1) * 32 + (swz % 64) / 2; }
__host__ __device__ __forceinline__ int perm32(int rho) { const int n = rho >> 4, i = rho & 15; return 8 * (i >> 2) + 4 * n + (i & 3); }

struct Unit { int pm, pn, kind; const char* A; const char* B; };

struct Order {
    int G, c;
    int n0;
    const char* A0; const char* B0; int nM0, nN0, kind0;
    const char* A1; const char* B1; int nM1, nN1, kind1;
    size_t tstep;
    int pm0;
    int apm0;
    int moe; int pb1, pb2, pb3, pb4, pb5, pb6, pb7; size_t estride;
    __device__ __forceinline__ void init1(int G_, int c_, const void* A, const void* B, int nM, int nN, int K) {
        G = G_; c = c_; A0 = (const char*)A; B0 = (const char*)B; nM0 = nM; nN0 = nN; kind0 = 0; n0 = nM * nN; A1 = A0; B1 = B0; nM1 = 0; nN1 = 1; kind1 = 1;
        tstep = (size_t)256 * K * 2; pm0 = 0; apm0 = 0; moe = 0; pb1 = pb2 = pb3 = pb4 = pb5 = pb6 = pb7 = 0; estride = 0; }
    __device__ __forceinline__ bool next(int i, Unit& u) const {
        long L = (long)i * G + c; const bool s = L >= n0; if (s) L -= n0;
        const int nM = s ? nM1 : nM0, nN = s ? nN1 : nN0, nwg = nM * nN; if (L >= nwg) return false;
        int wgid = (int)L; { const int q = nwg / NXCD, r = nwg % NXCD, xcd = wgid % NXCD, off = wgid / NXCD; wgid = (xcd < r ? xcd * (q + 1) : r * (q + 1) + (xcd - r) * q) + off; }
        const int nig = WGM * nN, gid = wgid / nig, fm = gid * WGM, gsz = (nM - fm) < WGM ? (nM - fm) : WGM;
        const int pm = pm0 + fm + ((wgid % nig) % gsz), pn = (wgid % nig) / gsz;
        u.pm = pm; u.pn = pn; u.kind = s ? kind1 : kind0;
        u.A = (s ? A1 : A0) + (size_t)(pm - apm0) * tstep;
        const char* b = (s ? B1 : B0) + (size_t)pn * tstep;
        if (moe) { const int e = (pm >= pb1) + (pm >= pb2) + (pm >= pb3) + (pm >= pb4) + (pm >= pb5) + (pm >= pb6) + (pm >= pb7); b += (size_t)e * estride; }
        u.B = b; return true;
    }
    __device__ __forceinline__ void a_ready(const Unit&) const {}
    __device__ __forceinline__ void done(const Unit&) const {}
};

__device__ __forceinline__ unsigned cvt_pk_bf16(float lo, float hi) { unsigned r; asm volatile("v_cvt_pk_bf16_f32 %0, %1, %2" : "=v"(r) : "v"(lo), "v"(hi)); return r; }

template <class Epi, class Sched, bool ALIGN_EPI = true, bool SP2 = true>
__device__ __forceinline__ void gemm_phase(PG8_LAS unsigned char* lds, const int tid, const int K, const Sched& S, const Epi& E) {
    const int wid = __builtin_amdgcn_readfirstlane(tid >> 6), lane = tid & 63, wr = wid >> 2, wc = wid & 3, fr = lane & 15, fq = lane >> 4;
    const int nt = K / BK;
    unsigned voffA[2], voffB[2];
#pragma unroll
    for (int i = 0; i < 2; ++i) { int R, C; stage_rc(tid * 16 + i * 8192, R, C); const int Rb = ((R & ~31) + perm32(R & 31));
        voffA[i] = (unsigned)(R * K + C) * 2u; voffB[i] = (unsigned)(Rb * K + C) * 2u; }
    const size_t kstep = (size_t)(BK * 2);
    const size_t hstep = (size_t)HALF * K * 2;
    const unsigned ldsw = (unsigned)wid * 1024u;
    const int aoff = lds_byte(wr * 64 + fr, fq * 8), boff = lds_byte(wc * 32 + fr, fq * 8);
#define PG8_SA(b, h) (((b) * 2 + (h)) * HTB)
#define PG8_SB(b, h) ((4 + (b) * 2 + (h)) * HTB)
#define PG8_STAGE(bufoff, gbase, voff) do { _Pragma("unroll") for (int _i = 0; _i < 2; ++_i) \
        __builtin_amdgcn_global_load_lds((const unsigned*)((const char*)(gbase) + (voff)[_i]), (PG8_LAS unsigned*)(lds + (bufoff) + ldsw + _i * 8192), 16, 0, 0); } while (0)
#define PG8_LDA(dst, b, h) do { _Pragma("unroll") for (int m = 0; m < 4; ++m) _Pragma("unroll") for (int k = 0; k < 2; ++k) dst[m][k] = *(const PG8_LAS bf16x8*)(lds + PG8_SA(b, h) + aoff + m * 2048 + k * 1024); } while (0)
#define PG8_LDB(dst, b, h) do { _Pragma("unroll") for (int n = 0; n < 2; ++n) _Pragma("unroll") for (int k = 0; k < 2; ++k) dst[n][k] = *(const PG8_LAS bf16x8*)(lds + PG8_SB(b, h) + boff + n * 2048 + k * 1024); } while (0)
#define PG8_MMA(ai, bj, At, Bt) do { __builtin_amdgcn_s_setprio(1); _Pragma("unroll") for (int m = 0; m < 4; ++m) _Pragma("unroll") for (int n = 0; n < 2; ++n) _Pragma("unroll") for (int k = 0; k < 2; ++k) \
        acc[ai][bj][m][n] = __builtin_amdgcn_mfma_f32_16x16x32_bf16(Bt[n][k], At[m][k], acc[ai][bj][m][n], 0, 0, 0); __builtin_amdgcn_s_setprio(0); } while (0)
#define PG8_WAIT_V(n) asm volatile("s_waitcnt vmcnt(" #n ")" ::: "memory")
#define PG8_WAIT_L(n) asm volatile("s_waitcnt lgkmcnt(" #n ")" ::: "memory")
#define PG8_BAR __builtin_amdgcn_s_barrier()
#define PG8_SCHED __builtin_amdgcn_sched_barrier(0)
    Unit cur, nxt; int ui = 0;
    if (!S.next(0, cur)) return;
    f32x4 acc[2][2][4][2];
#pragma unroll
    for (int a = 0; a < 2; ++a)
#pragma unroll
        for (int b = 0; b < 2; ++b)
#pragma unroll
            for (int m = 0; m < 4; ++m)
#pragma unroll
                for (int n = 0; n < 2; ++n) acc[a][b][m][n] = (f32x4){0.f, 0.f, 0.f, 0.f};
    bf16x8 At[4][2], B0[2][2], B1[2][2];
    const char* cA = cur.A; const char* cB = cur.B;
    S.a_ready(cur);
    if constexpr (SP2) {
        PG8_STAGE(PG8_SB(0, 0), cB, voffB); PG8_STAGE(PG8_SB(0, 1), cB + hstep, voffB); PG8_STAGE(PG8_SA(0, 0), cA, voffA); PG8_STAGE(PG8_SA(0, 1), cA + hstep, voffA);
        if (wr == 1) PG8_BAR;
        PG8_WAIT_V(2); PG8_BAR;
        PG8_STAGE(PG8_SB(1, 0), cB + kstep, voffB); PG8_STAGE(PG8_SA(1, 0), cA + kstep, voffA); PG8_STAGE(PG8_SB(1, 1), cB + hstep + kstep, voffB);
        PG8_WAIT_V(6); PG8_BAR;
    } else {
        PG8_STAGE(PG8_SB(0, 0), cB, voffB); PG8_STAGE(PG8_SA(0, 0), cA, voffA); PG8_STAGE(PG8_SB(0, 1), cB + hstep, voffB); PG8_STAGE(PG8_SA(0, 1), cA + hstep, voffA);
        if (wr == 1) PG8_BAR;
        PG8_WAIT_V(4); PG8_BAR;
        PG8_STAGE(PG8_SB(1, 0), cB + kstep, voffB); PG8_STAGE(PG8_SA(1, 0), cA + kstep, voffA); PG8_STAGE(PG8_SB(1, 1), cB + hstep + kstep, voffB);
        PG8_WAIT_V(6); PG8_BAR;
    }
    for (;;) {
        const bool has_next = S.next(ui + 1, nxt);
        const char* nA = has_next ? nxt.A : cA; const char* nB = has_next ? nxt.B : cB;
        for (int t = 0; t < nt; t += 2) {
            const bool last = (t == nt - 2);
            const char* a1 = cA + (size_t)(t + 1) * kstep;
            const char* a2 = last ? nA : cA + (size_t)(t + 2) * kstep; const char* b2 = last ? nB : cB + (size_t)(t + 2) * kstep;
            const char* a3 = a2 + kstep; const char* b3 = b2 + kstep;
            if (last && has_next) S.a_ready(nxt);
            if constexpr (SP2) {
            PG8_LDB(B0, 0, 0); PG8_LDB(B1, 0, 1); PG8_SCHED; PG8_LDA(At, 0, 0); PG8_STAGE(PG8_SA(1, 1), a1 + hstep, voffA);
            PG8_WAIT_V(8); PG8_WAIT_L(0); PG8_BAR; PG8_MMA(0, 0, At, B0); PG8_MMA(0, 1, At, B1); PG8_BAR; PG8_SCHED;
            PG8_LDA(At, 0, 1); PG8_STAGE(PG8_SB(0, 0), b2, voffB); PG8_STAGE(PG8_SB(0, 1), b2 + hstep, voffB); PG8_STAGE(PG8_SA(0, 0), a2, voffA);
            PG8_WAIT_V(8); PG8_WAIT_L(0); PG8_BAR; PG8_MMA(1, 0, At, B0); PG8_MMA(1, 1, At, B1); PG8_BAR; PG8_SCHED;
            PG8_LDB(B0, 1, 0); PG8_LDB(B1, 1, 1); PG8_SCHED; PG8_LDA(At, 1, 0); PG8_STAGE(PG8_SA(0, 1), a2 + hstep, voffA);
            PG8_WAIT_V(8); PG8_WAIT_L(0); PG8_BAR; PG8_MMA(0, 0, At, B0); PG8_MMA(0, 1, At, B1); PG8_BAR; PG8_SCHED;
            PG8_LDA(At, 1, 1); PG8_STAGE(PG8_SB(1, 0), b3, voffB); PG8_STAGE(PG8_SB(1, 1), b3 + hstep, voffB); PG8_STAGE(PG8_SA(1, 0), a3, voffA);
            PG8_WAIT_V(8); PG8_WAIT_L(0); PG8_BAR; PG8_MMA(1, 0, At, B0); PG8_MMA(1, 1, At, B1); PG8_BAR; PG8_SCHED;
            } else {
            PG8_LDB(B0, 0, 0); PG8_SCHED; PG8_LDA(At, 0, 0); PG8_STAGE(PG8_SA(1, 1), a1 + hstep, voffA);
            PG8_WAIT_L(8); PG8_BAR; PG8_WAIT_L(0); PG8_MMA(0, 0, At, B0); PG8_BAR; PG8_SCHED;
            PG8_LDB(B1, 0, 1); PG8_STAGE(PG8_SB(0, 0), b2, voffB);
            PG8_BAR; PG8_WAIT_L(0); PG8_MMA(0, 1, At, B1); PG8_BAR;
            PG8_LDA(At, 0, 1); PG8_STAGE(PG8_SA(0, 0), a2, voffA);
            PG8_BAR; PG8_WAIT_L(0); PG8_MMA(1, 0, At, B0); PG8_BAR; PG8_SCHED;
            PG8_STAGE(PG8_SB(0, 1), b2 + hstep, voffB);
            PG8_WAIT_V(6); PG8_BAR; PG8_MMA(1, 1, At, B1); PG8_BAR;
            PG8_LDB(B0, 1, 0); PG8_SCHED; PG8_LDA(At, 1, 0); PG8_STAGE(PG8_SA(0, 1), a2 + hstep, voffA);
            PG8_WAIT_L(8); PG8_BAR; PG8_WAIT_L(0); PG8_MMA(0, 0, At, B0); PG8_BAR; PG8_SCHED;
            PG8_LDB(B1, 1, 1); PG8_STAGE(PG8_SB(1, 0), b3, voffB);
            PG8_BAR; PG8_WAIT_L(0); PG8_MMA(0, 1, At, B1); PG8_BAR;
            PG8_LDA(At, 1, 1); PG8_STAGE(PG8_SA(1, 0), a3, voffA);
            PG8_BAR; PG8_WAIT_L(0); PG8_MMA(1, 0, At, B0); PG8_BAR; PG8_SCHED;
            PG8_STAGE(PG8_SB(1, 1), b3 + hstep, voffB);
            PG8_WAIT_V(6); PG8_BAR; PG8_MMA(1, 1, At, B1); PG8_BAR;
            }
        }
        if constexpr (ALIGN_EPI) { if (wr == 0) PG8_BAR; }
        E(acc, cur, wr, wc, fr, fq); S.done(cur);
        if (!has_next) break;
#pragma unroll
        for (int a = 0; a < 2; ++a)
#pragma unroll
            for (int b = 0; b < 2; ++b)
#pragma unroll
                for (int m = 0; m < 4; ++m)
#pragma unroll
                    for (int n = 0; n < 2; ++n) acc[a][b][m][n] = (f32x4){0.f, 0.f, 0.f, 0.f};
        cur = nxt; cA = nA; cB = nB; ++ui;
        if constexpr (ALIGN_EPI) { if (wr == 1) PG8_BAR; }
    }
    PG8_WAIT_V(0);
    if constexpr (!ALIGN_EPI) { if (wr == 0) PG8_BAR; }
    PG8_BAR;
#undef PG8_SA
#undef PG8_SB
#undef PG8_STAGE
#undef PG8_LDA
#undef PG8_LDB
#undef PG8_MMA
#undef PG8_WAIT_V
#undef PG8_WAIT_L
#undef PG8_BAR
#undef PG8_SCHED
}
}

constexpr int NWAVES = 8;
constexpr int D = 1024, NBATCH = 4, SEQ = 4096, CTXL = 256;
constexpr int NLAT = NBATCH * SEQ, NCTX = NBATCH * CTXL, NROW = NLAT + NCTX, NPAN = NROW / 256;
constexpr int INW_SRC = 4128, INW = 4608;
constexpr int FFD = 2816, FFE = 3584, NEXP = 8;
constexpr float EPS = 1e-6f;

constexpr size_t MiB = 1u << 20;
constexpr size_t WS_CTL = 0, CTL_ZERO_BYTES = 1 * MiB;
constexpr size_t WS_TAB = 1 * MiB;
constexpr size_t WS_LATX = 8 * MiB;
constexpr size_t WS_W = 76 * MiB;
constexpr size_t WS_XN = 120 * MiB;
constexpr size_t WS_IP = 154 * MiB;
constexpr size_t WS_DS = 324 * MiB;
constexpr size_t WS_S5F = 392 * MiB;
constexpr size_t WS_OG = 401 * MiB;
constexpr size_t WS_SG = 418 * MiB;
constexpr size_t WS_O32 = 435 * MiB;
constexpr size_t WS_Y32 = 469 * MiB;
constexpr size_t WS_WM = 76 * MiB;
constexpr size_t WS_XG = 244 * MiB;
constexpr size_t WS_HM = 312 * MiB;
constexpr size_t WS_YS = 424 * MiB;
constexpr size_t WS_END = 504 * MiB;
constexpr size_t IP_K = 0, IP_V = IP_K + (size_t)NROW * 256 * 2, IP_GF = IP_V + (size_t)NROW * 512 * 2, IP_GB = IP_GF + (size_t)NROW * 256 * 4,
                 IP_U = IP_GB + (size_t)NROW * 256 * 4, IP_Q = IP_U + (size_t)NROW * 512 * 2, IP_R = IP_Q + (size_t)NROW * 256 * 2,
                 IP_GA = IP_R + (size_t)NROW * 512 * 2, IP_GM = IP_GA + (size_t)NROW * 1024 * 2, IP_END = IP_GM + (size_t)NROW * 1024 * 2;
static_assert(IP_END <= 170 * MiB, "in-proj region");
constexpr size_t IP_T = IP_K;
constexpr size_t IP_S2 = IP_U;
constexpr size_t IP_HMID = 0;
static_assert((size_t)NROW * 1024 * 2 <= IP_GB, "T overlay");
static_assert((size_t)NROW * FFD * 2 <= 170 * MiB, "HMID overlay");
constexpr size_t W_IN = 0;
constexpr size_t W_GLU = 18 * MiB;
constexpr size_t W_GP = 19 * MiB;
constexpr size_t W_SP = 21 * MiB;
constexpr size_t W_OUT = 23 * MiB;
constexpr size_t W_FGU = 27 * MiB;
constexpr size_t W_FD = 38 * MiB;
constexpr size_t WM_GU = 0;
constexpr size_t WM_D = 112 * MiB;
constexpr size_t T_MODV = 0;
constexpr size_t T_LAMB = 256 * 1024;
constexpr size_t T_BBAR = 512 * 1024;
constexpr size_t T_TOKE = 2 * MiB;
constexpr size_t T_TOKW = 2 * MiB + 256 * 1024;
constexpr size_t T_TOKS = 2 * MiB + 512 * 1024;
constexpr int CW_TMO = 0, CW_CODE = 1;
constexpr int CW_BAR = 4096;
constexpr int CW_CNT = 16384;

constexpr int RING_OFF = 0, RING_BYTES = 131072;
constexpr int LDSCTL_OFF = RING_BYTES, MISC_OFF = LDSCTL_OFF + 320;
constexpr int LDS_BYTES = 147456;

#define GAS __attribute__((address_space(1)))
#define LAS __attribute__((address_space(3)))
typedef unsigned short bf16;
typedef unsigned v4u __attribute__((ext_vector_type(4)));
typedef unsigned v2u __attribute__((ext_vector_type(2)));
typedef float f32x4 __attribute__((ext_vector_type(4)));
typedef float f32x2 __attribute__((ext_vector_type(2)));
typedef short bf16x8 __attribute__((ext_vector_type(8)));
typedef GAS unsigned gu32;
#define RLX_AGENT __ATOMIC_RELAXED, __HIP_MEMORY_SCOPE_AGENT
#define LDS_WAIT() asm volatile("s_waitcnt lgkmcnt(0)" ::: "memory")
#define VM_WAIT() asm volatile("s_waitcnt vmcnt(0)" ::: "memory")
__device__ __forceinline__ unsigned f2bf(float f) { unsigned u = __builtin_bit_cast(unsigned, f); return (u + 0x7fffu + ((u >> 16) & 1u)) >> 16; }
__device__ __forceinline__ unsigned pk2(float lo, float hi) { return f2bf(lo) | (f2bf(hi) << 16); }
__device__ __forceinline__ float bf2f(unsigned b) { return __builtin_bit_cast(float, b << 16); }
__device__ __forceinline__ float bflo(unsigned w) { return __builtin_bit_cast(float, w << 16); }
__device__ __forceinline__ float bfhi(unsigned w) { return __builtin_bit_cast(float, w & 0xffff0000u); }
__device__ __forceinline__ float sigmoidf_(float x) { return __builtin_amdgcn_rcpf(1.0f + __expf(-x)); }
__device__ __forceinline__ float siluf_(float x) { return x * __builtin_amdgcn_rcpf(1.0f + __expf(-x)); }
__device__ __forceinline__ float geluf_(float x) { const float t = 1.5957691216057308f * (x + 0.044715f * x * x * x); return x * __builtin_amdgcn_rcpf(1.0f + __expf(-t)); }
__device__ __forceinline__ float logsigmoidf_(float z) { return fminf(z, 0.f) - __logf(1.0f + __expf(-fabsf(z))); }

#define XB_TMO      128
#define XB_XCNT(j)  (256  + 64 * (j))
#define XB_XSUB(j)  (1280 + 64 * (j))
#define XB_XGEN(j)  (2304 + 64 * (j))
#define XB_TOP      3328
#define XB_TOPGEN   3392
#define XCD_BAR_WORDS 3456
#define XB_SPIN_CAP (1u << 18)
__device__ __forceinline__ unsigned xb_ld(unsigned* p)              { return __hip_atomic_load(p, __ATOMIC_RELAXED, __HIP_MEMORY_SCOPE_AGENT); }
__device__ __forceinline__ unsigned xb_add(unsigned* p, unsigned v) { return __hip_atomic_fetch_add(p, v, __ATOMIC_RELAXED, __HIP_MEMORY_SCOPE_AGENT); }
__device__ __forceinline__ unsigned xb_xcc_id() { return (unsigned)__builtin_amdgcn_s_getreg((3 << 11) | 20) & 0xFu; }
#define XB_SPIN(cond, bar) do { unsigned _sp = 0; while (cond) { __builtin_amdgcn_s_sleep(1); \
    if ((++_sp & 255u) == 0u) { if (xb_ld(&(bar)[XB_TMO])) break; if (_sp > XB_SPIN_CAP) { atomicAdd(&(bar)[XB_TMO], 1u); break; } } } } while (0)
struct XcdBarrier { unsigned* bar; unsigned x; volatile LAS unsigned* st; };
__device__ __forceinline__ XcdBarrier xcd_barrier_post(unsigned* bar, volatile LAS unsigned* st) {
    XcdBarrier b; b.bar = bar; b.x = xb_xcc_id(); b.st = st;
    if (threadIdx.x == 0) (void)xb_add(&bar[XB_XCNT(b.x)], 1u);
    return b;
}
__device__ __forceinline__ void xcd_barrier_complete(unsigned* bar, unsigned x, unsigned& nloc, unsigned& nx) {
    const unsigned G = gridDim.x * gridDim.y * gridDim.z;
    unsigned sum, cnt, mine, sp = 0u;
    for (;;) {
        sum = 0u; cnt = 0u; mine = 0u;
#pragma unroll
        for (unsigned j = 0; j < 16; ++j) { const unsigned c = xb_ld(&bar[XB_XCNT(j)]); sum += c; cnt += (c > 0u) ? 1u : 0u; mine = (j == x) ? c : mine; }
        if (sum == G) break;
        __builtin_amdgcn_s_sleep(1);
        if ((++sp & 255u) == 0u) { if (xb_ld(&bar[XB_TMO])) break; if (sp > XB_SPIN_CAP) { atomicAdd(&bar[XB_TMO], 1u); break; } }
    }
    nloc = mine > 0u ? mine : 1u; nx = cnt > 0u ? cnt : 1u;
}
__device__ __forceinline__ void xcd_barrier(const XcdBarrier& b) {
    asm volatile("s_waitcnt vmcnt(0)" ::: "memory");
    __syncthreads();
    if (threadIdx.x == 0) {
        unsigned* bar = b.bar;
        __builtin_amdgcn_s_waitcnt(0);
        unsigned nloc = b.st[0], nx = b.st[1];
        if (nloc == 0u) { xcd_barrier_complete(bar, b.x, nloc, nx); b.st[0] = nloc; b.st[1] = nx; }
        const unsigned old = xb_add(&bar[XB_XSUB(b.x)], 1u);
        const unsigned gen = old / nloc;
        if (old + 1u == (gen + 1u) * nloc) {
            __builtin_amdgcn_fence(__ATOMIC_RELEASE, "agent");
            asm volatile("s_waitcnt vmcnt(0)" ::: "memory");
            const unsigned og = xb_add(&bar[XB_TOP], 1u);
            const unsigned tg = og / nx;
            if (og + 1u == (tg + 1u) * nx) xb_add(&bar[XB_TOPGEN], 1u);
            else XB_SPIN(xb_ld(&bar[XB_TOPGEN]) == tg, bar);
            __builtin_amdgcn_fence(__ATOMIC_ACQUIRE, "agent");
            xb_add(&bar[XB_XGEN(b.x)], 1u);
            asm volatile("s_waitcnt vmcnt(0)" ::: "memory");
        } else {
            XB_SPIN(xb_ld(&bar[XB_XGEN(b.x)]) == gen, bar);
            __builtin_amdgcn_fence(__ATOMIC_ACQUIRE, "agent");
            asm volatile("s_waitcnt vmcnt(0)" ::: "memory");
        }
    }
    __syncthreads();
}

enum InIdx { I_X = 0, I_C, I_CTX, I_CCTX, I_WMOD, I_BMOD, I_N1W, I_N2W, I_FNW, I_WIN, I_LRF, I_LRB, I_BIASF, I_BIASB, I_GNW,
             I_AREF, I_AIMF, I_LDTF, I_AREB, I_AIMB, I_LDTB, I_BRE, I_BIM, I_CRE, I_CIM, I_S5D, I_WGLU, I_BGLU, I_WGP, I_WSP, I_WOUT,
             I_FG, I_FU, I_FD, I_ROUTER, I_MG, I_MU, I_MD, N_IN };
struct Args { const float* in[N_IN]; float* out; unsigned char* ws; int ph_lo, ph_hi; };

__device__ __forceinline__ float wave_sum(float v) {
#pragma unroll
    for (int o = 1; o < 64; o <<= 1) v += __shfl_xor(v, o);
    return v;
}

__device__ __forceinline__ void transpose_item(const float* W, int ldw, int k0, int n0, bf16* WT, int ldt, int drow0, LAS float* scr, int lane) {
#pragma unroll 8
    for (int i = 0; i < 32; ++i) { const int kk = 2 * i + (lane >> 5); scr[kk * 33 + (lane & 31)] = W[(size_t)(k0 + kk) * ldw + n0 + (lane & 31)]; }
    LDS_WAIT(); asm volatile("" ::: "memory");
    const int c = lane & 7;
#pragma unroll
    for (int j = 0; j < 4; ++j) { const int n = (lane >> 3) + 8 * j; const LAS float* s = scr + (8 * c) * 33 + n;
        v4u o; o.x = pk2(s[0 * 33], s[1 * 33]); o.y = pk2(s[2 * 33], s[3 * 33]); o.z = pk2(s[4 * 33], s[5 * 33]); o.w = pk2(s[6 * 33], s[7 * 33]);
        *(GAS v4u*)(WT + (size_t)(drow0 + n) * ldt + k0 + 8 * c) = o; }
    LDS_WAIT(); asm volatile("" ::: "memory");
}
__device__ __forceinline__ bool conv_matrix(int& r, const float* W, int K, int N, bf16* WT, int mode, int roff, LAS float* scr, int lane) {
    const int nblk = N / 32, items = (K / 64) * nblk;
    if (r >= items) { r -= items; return false; }
    const int kb = r / nblk, nb = r % nblk, k0 = 64 * kb, n0 = 32 * nb;
    int drow0;
    if (mode == 0) drow0 = n0 + roff;
    else if (mode == 1) { if (n0 == 768) return true; drow0 = n0 < 768 ? n0 : n0 + 480; }
    else drow0 = (n0 >> 7) * 256 + (n0 & 127) + roff;
    transpose_item(W, N, k0, n0, WT, K, drow0, scr, lane);
    return true;
}

using pg8::Unit; using pg8::cvt_pk_bf16;
typedef pg8::f32x4 accv;
#define EPI_ARGS const accv (&acc)[2][2][4][2], const Unit& u, int wr, int wc, int fr, int fq
__device__ __forceinline__ v4u pack8(f32x4 a, f32x4 b) { v4u w; w.x = cvt_pk_bf16(a[0], a[1]); w.y = cvt_pk_bf16(a[2], a[3]); w.z = cvt_pk_bf16(b[0], b[1]); w.w = cvt_pk_bf16(b[2], b[3]); return w; }
__device__ __forceinline__ void unpack8(v4u w, f32x4& a, f32x4& b) { a = (f32x4){bflo(w.x), bfhi(w.x), bflo(w.y), bfhi(w.y)}; b = (f32x4){bflo(w.z), bfhi(w.z), bflo(w.w), bfhi(w.w)}; }

struct EpiInProj {
    bf16 *Kb, *Vb, *Ub, *Qb, *Rb, *GAb, *GMb; float *GF, *GB; const float *bias_f, *bias_b;
    __device__ __forceinline__ void operator()(EPI_ARGS) const {
        const int pn = u.pn, row0 = u.pm * 256 + wr * 64 + fr, cw = wc * 32 + 8 * fq;
        if (pn == 3 || pn == 4) {
            float* dst = pn == 3 ? GF : GB; const float* bias = pn == 3 ? bias_f : bias_b;
#pragma unroll
            for (int bj = 0; bj < 2; ++bj) { const int c = cw + bj * 128; const f32x4 b0 = *(const f32x4*)(bias + c), b1 = *(const f32x4*)(bias + c + 4);
#pragma unroll
                for (int ai = 0; ai < 2; ++ai)
#pragma unroll
                    for (int m = 0; m < 4; ++m) { float* p = dst + (size_t)(row0 + ai * 128 + m * 16) * 256 + c; f32x4 v0 = acc[ai][bj][m][0] + b0, v1 = acc[ai][bj][m][1] + b1;
#pragma unroll
                        for (int j = 0; j < 4; ++j) { v0[j] = logsigmoidf_(v0[j]) * 0.0625f; v1[j] = logsigmoidf_(v1[j]) * 0.0625f; }
                        *(f32x4*)p = v0; *(f32x4*)(p + 4) = v1; } }
            return;
        }
        bf16* dst; int ld, cb, act;
        if (pn == 0) { dst = Kb; ld = 256; cb = 0; act = 0; }
        else if (pn <= 2) { dst = Vb; ld = 512; cb = (pn - 1) * 256; act = 0; }
        else if (pn <= 6) { dst = Ub; ld = 512; cb = (pn - 5) * 256; act = 0; }
        else if (pn == 7) { dst = Qb; ld = 256; cb = 0; act = 1; }
        else if (pn <= 9) { dst = Rb; ld = 512; cb = (pn - 8) * 256; act = 2; }
        else if (pn <= 13) { dst = GAb; ld = 1024; cb = (pn - 10) * 256; act = 3; }
        else { dst = GMb; ld = 1024; cb = (pn - 14) * 256; act = 3; }
#pragma unroll
        for (int ai = 0; ai < 2; ++ai)
#pragma unroll
            for (int m = 0; m < 4; ++m) { bf16* rowp = dst + (size_t)(row0 + ai * 128 + m * 16) * ld + cb + cw;
#pragma unroll
                for (int bj = 0; bj < 2; ++bj) { f32x4 v0 = acc[ai][bj][m][0], v1 = acc[ai][bj][m][1];
                    if (act == 1) { v0 = v0 * 0.125f; v1 = v1 * 0.125f; }
                    else if (act == 2) {
#pragma unroll
                        for (int j = 0; j < 4; ++j) { v0[j] = siluf_(v0[j]); v1[j] = siluf_(v1[j]); } }
                    else if (act == 3) {
#pragma unroll
                        for (int j = 0; j < 4; ++j) { v0[j] = sigmoidf_(v0[j]); v1[j] = sigmoidf_(v1[j]); } }
                    *(v4u*)(rowp + bj * 128) = pack8(v0, v1); } }
    }
};
struct EpiD12 {
    const bf16* SG; bf16* S2; const float* bglu; const bf16* GA; bf16* T;
    __device__ __forceinline__ void operator()(EPI_ARGS) const {
        const int row0 = u.pm * 256 + wr * 64 + fr, c0 = u.pn * 256 + wc * 32 + 8 * fq;
#pragma unroll
        for (int ai = 0; ai < 2; ++ai)
#pragma unroll
            for (int m = 0; m < 4; ++m) { const size_t row = (size_t)(row0 + ai * 128 + m * 16);
#pragma unroll
                for (int bj = 0; bj < 2; ++bj) { const int c = c0 + bj * 128; f32x4 v0 = acc[ai][bj][m][0], v1 = acc[ai][bj][m][1], s0, s1;
                    if (u.kind == 0) { const f32x4 b0 = *(const f32x4*)(bglu + c), b1 = *(const f32x4*)(bglu + c + 4); unpack8(*(const v4u*)(SG + row * 512 + c), s0, s1);
#pragma unroll
                        for (int j = 0; j < 4; ++j) { v0[j] = s0[j] * sigmoidf_(v0[j] + b0[j]); v1[j] = s1[j] * sigmoidf_(v1[j] + b1[j]); }
                        *(v4u*)(S2 + row * 512 + c) = pack8(v0, v1); }
                    else { unpack8(*(const v4u*)(GA + row * 1024 + c), s0, s1); *(v4u*)(T + row * 1024 + c) = pack8(v0 * s0, v1 * s1); } } }
    }
};
struct EpiD3 {
    const bf16* T; const bf16* GM; bf16* MB;
    __device__ __forceinline__ void operator()(EPI_ARGS) const {
        const int row0 = u.pm * 256 + wr * 64 + fr, c0 = u.pn * 256 + wc * 32 + 8 * fq;
#pragma unroll
        for (int ai = 0; ai < 2; ++ai)
#pragma unroll
            for (int m = 0; m < 4; ++m) { const size_t row = (size_t)(row0 + ai * 128 + m * 16);
#pragma unroll
                for (int bj = 0; bj < 2; ++bj) { const int c = c0 + bj * 128; f32x4 t0, t1, g0, g1; unpack8(*(const v4u*)(T + row * 1024 + c), t0, t1); unpack8(*(const v4u*)(GM + row * 1024 + c), g0, g1);
                    *(v4u*)(MB + row * 1024 + c) = pack8(t0 + g0 * acc[ai][bj][m][0], t1 + g1 * acc[ai][bj][m][1]); } }
    }
};
struct EpiResid {
    const float* rl; const float* rc; float* out; const float* modv; int gidx;
    __device__ __forceinline__ void operator()(EPI_ARGS) const {
        const int row0 = u.pm * 256 + wr * 64 + fr, c0 = u.pn * 256 + wc * 32 + 8 * fq;
        const int bi = u.pm < NLAT / 256 ? (u.pm >> 4) : 4;
        const float* gp = modv + bi * 6144 + gidx * 1024;
#pragma unroll
        for (int bj = 0; bj < 2; ++bj) { const int c = c0 + bj * 128; const f32x4 g0 = *(const f32x4*)(gp + c), g1 = *(const f32x4*)(gp + c + 4);
#pragma unroll
            for (int ai = 0; ai < 2; ++ai)
#pragma unroll
                for (int m = 0; m < 4; ++m) { const int row = row0 + ai * 128 + m * 16;
                    const float* rp = (row < NLAT ? rl + (size_t)row * 1024 : rc + (size_t)(row - NLAT) * 1024) + c; float* op = out + (size_t)row * 1024 + c;
                    const f32x4 r0 = *(const f32x4*)rp, r1 = *(const f32x4*)(rp + 4);
                    *(f32x4*)op = r0 + g0 * acc[ai][bj][m][0]; *(f32x4*)(op + 4) = r1 + g1 * acc[ai][bj][m][1]; } }
    }
};
struct EpiSwiglu {
    bf16* H; int ld; int pmoff;
    __device__ __forceinline__ void operator()(EPI_ARGS) const {
        const int row0 = (u.pm - pmoff) * 256 + wr * 64 + fr, c = u.pn * 128 + wc * 32 + 8 * fq;
#pragma unroll
        for (int ai = 0; ai < 2; ++ai)
#pragma unroll
            for (int m = 0; m < 4; ++m) { f32x4 g0 = acc[ai][0][m][0], g1 = acc[ai][0][m][1]; const f32x4 u0 = acc[ai][1][m][0], u1 = acc[ai][1][m][1];
#pragma unroll
                for (int j = 0; j < 4; ++j) { g0[j] = siluf_(g0[j]) * u0[j]; g1[j] = siluf_(g1[j]) * u1[j]; }
                *(v4u*)(H + (size_t)(row0 + ai * 128 + m * 16) * ld + c) = pack8(g0, g1); }
    }
};
struct EpiPlain {
    bf16* Y;
    __device__ __forceinline__ void operator()(EPI_ARGS) const {
        const int row0 = u.pm * 256 + wr * 64 + fr, c0 = u.pn * 256 + wc * 32 + 8 * fq;
#pragma unroll
        for (int ai = 0; ai < 2; ++ai)
#pragma unroll
            for (int m = 0; m < 4; ++m)
#pragma unroll
                for (int bj = 0; bj < 2; ++bj) *(v4u*)(Y + (size_t)(row0 + ai * 128 + m * 16) * 1024 + c0 + bj * 128) = pack8(acc[ai][bj][m][0], acc[ai][bj][m][1]);
    }
};

constexpr int NPH = 25;

__global__ void __launch_bounds__(NWAVES * 64, 2) fwd_kernel(Args args) {
    extern __shared__ __attribute__((aligned(16))) unsigned char lds_raw[];
    LAS unsigned char* lds = (LAS unsigned char*)lds_raw;
    volatile LAS unsigned* MISC = (volatile LAS unsigned*)(lds + MISC_OFF);
    const int G = gridDim.x; const int bx = blockIdx.x; const int vcu = (G % 8 == 0) ? (bx % 8) * (G / 8) + bx / 8 : bx;
    const int NGW = G * NWAVES;
    for (int i = threadIdx.x; i < (LDS_BYTES - LDSCTL_OFF) / 4; i += NWAVES * 64) ((LAS unsigned*)(lds + LDSCTL_OFF))[i] = 0u;
    __syncthreads();
    XcdBarrier bar; bar.bar = (unsigned*)(args.ws + WS_CTL) + CW_BAR; bar.x = 0; bar.st = nullptr;
    if (MK_ONE_LAUNCH) bar = xcd_barrier_post((unsigned*)(args.ws + WS_CTL) + CW_BAR, MISC + 8);
    const int lo = args.ph_lo, hi = args.ph_hi;
#define IN(k) (lo <= (k) && (k) < hi)
#define SEAM(k) do { if (lo <= (k) && (k) + 1 < hi) xcd_barrier(bar); } while (0)

#define PHASE_BEGIN() int tid_ = threadIdx.x; asm volatile("" : "+v"(tid_)); unsigned char* ws = args.ws; asm volatile("" : "+s"(ws)); \
    const int tid = tid_, lane = tid & 63, wave = __builtin_amdgcn_readfirstlane(tid >> 6), gw = vcu * NWAVES + wave; (void)lane; (void)gw; \
    const float* const* in = args.in; (void)in; gu32* ctl = (gu32*)(ws + WS_CTL); (void)ctl;
#define LATX ((float*)(ws + WS_LATX))
#define XN ((bf16*)(ws + WS_XN))
#define Kb ((bf16*)(ws + WS_IP + IP_K))
#define Vb ((bf16*)(ws + WS_IP + IP_V))
#define GF ((float*)(ws + WS_IP + IP_GF))
#define GB ((float*)(ws + WS_IP + IP_GB))
#define Ub ((bf16*)(ws + WS_IP + IP_U))
#define Qb ((bf16*)(ws + WS_IP + IP_Q))
#define Rb ((bf16*)(ws + WS_IP + IP_R))
#define GAb ((bf16*)(ws + WS_IP + IP_GA))
#define GMb ((bf16*)(ws + WS_IP + IP_GM))
#define Tb ((bf16*)(ws + WS_IP + IP_T))
#define S2 ((bf16*)(ws + WS_IP + IP_S2))
#define HMID ((bf16*)(ws + WS_IP + IP_HMID))
#define OG ((bf16*)(ws + WS_OG))
#define SG ((bf16*)(ws + WS_SG))
#define O32 ((float*)(ws + WS_O32))
#define Y32 ((float*)(ws + WS_Y32))
#define MODV ((float*)(ws + WS_TAB + T_MODV))
#define LAMB ((f32x2*)(ws + WS_TAB + T_LAMB))
#define BBAR ((f32x2*)(ws + WS_TAB + T_BBAR))
#define TOKE ((int4*)(ws + WS_TAB + T_TOKE))
#define TOKW ((f32x2*)(ws + WS_TAB + T_TOKW))
#define TOKS ((int2*)(ws + WS_TAB + T_TOKS))
#define wb (ws + WS_W)
#define WMGU ((bf16*)(ws + WS_WM + WM_GU))
#define WMD ((bf16*)(ws + WS_WM + WM_D))
#define XG ((bf16*)(ws + WS_XG))
#define HM ((bf16*)(ws + WS_HM))
#define YS ((bf16*)(ws + WS_YS))

    if (IN(0)) { PHASE_BEGIN();
        {
            LAS float* sil = (LAS float*)(lds + 73728);
            LAS float* red = (LAS float*)(lds + 73728 + 20480);
            for (int i = tid; i < 5 * 1024; i += 512) { const int bi = i >> 10, k = i & 1023; const float v = bi < 4 ? in[I_C][bi * 1024 + k] : in[I_CCTX][k]; sil[i] = siluf_(v); }
            __syncthreads();
            for (int it = vcu; it < 2 * 96; it += G) {
                const int l = it / 96, n0 = (it % 96) * 64, kk = lane >> 4, q = lane & 15;
                f32x4 a[5];
#pragma unroll
                for (int bi = 0; bi < 5; ++bi) a[bi] = (f32x4){0.f, 0.f, 0.f, 0.f};
                const float* wp = in[I_WMOD] + (size_t)l * 1024 * 6144 + n0 + 4 * q;
#pragma unroll 4
                for (int i2 = 0; i2 < 32; ++i2) { const int k = wave * 128 + i2 * 4 + kk; const f32x4 w = *(const f32x4*)(wp + (size_t)k * 6144);
#pragma unroll
                    for (int bi = 0; bi < 5; ++bi) a[bi] = a[bi] + w * sil[bi * 1024 + k]; }
#pragma unroll
                for (int bi = 0; bi < 5; ++bi)
#pragma unroll
                    for (int j = 0; j < 4; ++j) { float v = a[bi][j]; v += __shfl_xor(v, 16); v += __shfl_xor(v, 32); a[bi][j] = v; }
                if (lane < 16) {
#pragma unroll
                    for (int bi = 0; bi < 5; ++bi)
#pragma unroll
                        for (int j = 0; j < 4; ++j) red[(wave * 5 + bi) * 64 + 4 * q + j] = a[bi][j]; }
                __syncthreads();
                if (tid < 320) { const int bi = tid >> 6, cc = tid & 63; float s = 0.f;
#pragma unroll
                    for (int w = 0; w < 8; ++w) s += red[(w * 5 + bi) * 64 + cc];
                    MODV[(l * 5 + bi) * 6144 + n0 + cc] = s + in[I_BMOD][l * 6144 + n0 + cc]; }
                __syncthreads();
            }
        }
        for (int i = gw * 64 + lane; i < 2 * 2 * 32 * 64; i += NGW * 64) {
            const int p = i & 63, g = (i >> 6) & 31, dir = (i >> 11) & 1, l = i >> 12;
            const float* are = in[dir ? I_AREB : I_AREF]; const float* aim = in[dir ? I_AIMB : I_AIMF]; const float* ldt = in[dir ? I_LDTB : I_LDTF];
            const double ar = are[(l * 32 + g) * 64 + p], ai = aim[(l * 32 + g) * 64 + p], dt = exp((double)ldt[l * 32 + g]);
            const double mag = exp(ar * dt), lr = mag * cos(ai * dt), li = mag * sin(ai * dt);
            LAMB[i] = (f32x2){(float)lr, (float)li};
            const double nr = lr - 1.0, ni = li, den = ar * ar + ai * ai, cr = (nr * ar + ni * ai) / den, ci = (ni * ar - nr * ai) / den;
            const float* bre = in[I_BRE] + ((size_t)(l * 32 + g) * 64 + p) * 16; const float* bim = in[I_BIM] + ((size_t)(l * 32 + g) * 64 + p) * 16;
            for (int j = 0; j < 16; ++j) { const double br = bre[j], bi2 = bim[j]; BBAR[(size_t)i * 16 + j] = (f32x2){(float)(cr * br - ci * bi2), (float)(cr * bi2 + ci * br)}; }
        }
        for (int i = gw * 64 + lane; i < 2 * 2 * 256 * 128; i += NGW * 64) {
            const int kc = i & 127, n = (i >> 7) & 255, dir = (i >> 15) & 1, l = i >> 16;
            const float* lr = in[dir ? I_LRB : I_LRF] + (size_t)l * 16 * 256 + n; float lrv[16];
#pragma unroll
            for (int j = 0; j < 16; ++j) lrv[j] = lr[j * 256];
            float o[8];
#pragma unroll
            for (int kk = 0; kk < 8; ++kk) { const float* wr_ = in[I_WIN] + ((size_t)l * 1024 + kc * 8 + kk) * INW_SRC + 768 + 16 * dir; float s = 0.f;
#pragma unroll
                for (int j4 = 0; j4 < 4; ++j4) { const f32x4 w = *(const f32x4*)(wr_ + 4 * j4); s += w[0] * lrv[4 * j4] + w[1] * lrv[4 * j4 + 1] + w[2] * lrv[4 * j4 + 2] + w[3] * lrv[4 * j4 + 3]; }
                o[kk] = s; }
            v4u w; w.x = pk2(o[0], o[1]); w.y = pk2(o[2], o[3]); w.z = pk2(o[4], o[5]); w.w = pk2(o[6], o[7]);
            *(v4u*)((bf16*)(wb + W_IN) + ((size_t)l * INW + 768 + 256 * dir + n) * 1024 + kc * 8) = w;
        }
        {
            LAS float* scr = (LAS float*)(lds + wave * 9216);
            constexpr int IT_IN = 16 * 129, IT_GLU = 8 * 16, IT_P = 8 * 32, IT_OUT = 16 * 32, IT_F = 16 * 88, IT_FD = 44 * 32;
            constexpr int IT_L = IT_IN + IT_GLU + 2 * IT_P + IT_OUT, NIT = 2 * IT_L + 2 * IT_F + IT_FD;
            for (int it = gw; it < NIT; it += NGW) {
                int r = it;
                if (r < 2 * IT_L) { const int l = r / IT_L; r -= l * IT_L;
                    if (conv_matrix(r, in[I_WIN] + (size_t)l * 1024 * INW_SRC, 1024, INW_SRC, (bf16*)(wb + W_IN) + (size_t)l * INW * 1024, 1, 0, scr, lane)) continue;
                    if (conv_matrix(r, in[I_WGLU] + (size_t)l * 512 * 512, 512, 512, (bf16*)(wb + W_GLU) + (size_t)l * 512 * 512, 0, 0, scr, lane)) continue;
                    if (conv_matrix(r, in[I_WGP] + (size_t)l * 512 * 1024, 512, 1024, (bf16*)(wb + W_GP) + (size_t)l * 1024 * 512, 0, 0, scr, lane)) continue;
                    if (conv_matrix(r, in[I_WSP] + (size_t)l * 512 * 1024, 512, 1024, (bf16*)(wb + W_SP) + (size_t)l * 1024 * 512, 0, 0, scr, lane)) continue;
                    conv_matrix(r, in[I_WOUT] + (size_t)l * 1024 * 1024, 1024, 1024, (bf16*)(wb + W_OUT) + (size_t)l * 1024 * 1024, 0, 0, scr, lane); continue; }
                r -= 2 * IT_L;
                if (conv_matrix(r, in[I_FG], 1024, FFD, (bf16*)(wb + W_FGU), 2, 0, scr, lane)) continue;
                if (conv_matrix(r, in[I_FU], 1024, FFD, (bf16*)(wb + W_FGU), 2, 128, scr, lane)) continue;
                conv_matrix(r, in[I_FD], FFD, 1024, (bf16*)(wb + W_FD), 0, 0, scr, lane);
            }
        }
    }
    SEAM(0);

    for (int l = 0; l < 2; ++l) {
        const int pb = 1 + 9 * l;
#define MODVL (MODV + (size_t)l * 5 * 6144)
#define RES_L (l == 0 ? in[I_X] : (const float*)LATX)
#define RES_C (l == 0 ? in[I_CTX] : (const float*)(LATX + (size_t)NLAT * 1024))
        const int nrows = NROW;
        const int mpan = l == 0 ? NPAN : NLAT / 256;
        if (IN(pb + 0)) { PHASE_BEGIN();
            const float* nw = in[I_N1W] + l * 1024;
            for (int row = gw; row < nrows; row += NGW) {
                const float* xr = row < NLAT ? RES_L + (size_t)row * 1024 : RES_C + (size_t)(row - NLAT) * 1024;
                const int bi = row < NLAT ? row >> 12 : 4; const float* sh = MODVL + bi * 6144; const float* sc = sh + 1024;
                f32x4 v[4]; float ss = 0.f;
#pragma unroll
                for (int j = 0; j < 4; ++j) { v[j] = *(const f32x4*)(xr + 4 * lane + 256 * j); ss += v[j][0] * v[j][0] + v[j][1] * v[j][1] + v[j][2] * v[j][2] + v[j][3] * v[j][3]; }
                const float rstd = rsqrtf(wave_sum(ss) * (1.f / 1024.f) + EPS);
#pragma unroll
                for (int j = 0; j < 4; ++j) { const int c = 4 * lane + 256 * j; const f32x4 w = *(const f32x4*)(nw + c), s1 = *(const f32x4*)(sc + c), s0 = *(const f32x4*)(sh + c);
                    f32x4 y;
#pragma unroll
                    for (int e = 0; e < 4; ++e) y[e] = v[j][e] * rstd * w[e] * (1.f + s1[e]) + s0[e];
                    v2u o; o.x = pk2(y[0], y[1]); o.y = pk2(y[2], y[3]); *(v2u*)(XN + (size_t)row * 1024 + c) = o; }
            }
        }
        SEAM(pb + 0);
        if (IN(pb + 1)) { PHASE_BEGIN();
            pg8::Order S; S.init1(G, bx, XN, (bf16*)(wb + W_IN) + (size_t)l * INW * 1024, NPAN, 18, 1024);
            EpiInProj E{Kb, Vb, Ub, Qb, Rb, GAb, GMb, GF, GB, in[I_BIASF] + l * 256, in[I_BIASB] + l * 256};
            pg8::gemm_phase<EpiInProj, pg8::Order>(lds + RING_OFF, tid, 1024, S, E);
        }
        SEAM(pb + 1);
        if (IN(pb + 2)) { PHASE_BEGIN();
            if (vcu < 16) {
                const int b = vcu >> 2, h = vcu & 3, e = tid >> 2, dq = tid & 3;
                for (int dir = 0; dir < 2; ++dir) {
                    float S[16];
#pragma unroll
                    for (int i = 0; i < 16; ++i) S[i] = 0.f;
                    const float* Gp = dir ? GB : GF;
                    for (int t = 0; t < CTXL + SEQ; ++t) {
                        int row;
                        if (dir == 0) row = t < CTXL ? NLAT + b * CTXL + t : b * SEQ + (t - CTXL);
                        else row = t < CTXL ? NLAT + b * CTXL + (CTXL - 1 - t) : b * SEQ + (SEQ - 1 - (t - CTXL));
                        const v4u k0 = *(const v4u*)(Kb + (size_t)row * 256 + h * 64 + 16 * dq), k1 = *(const v4u*)(Kb + (size_t)row * 256 + h * 64 + 16 * dq + 8);
                        const v4u q0 = *(const v4u*)(Qb + (size_t)row * 256 + h * 64 + 16 * dq), q1 = *(const v4u*)(Qb + (size_t)row * 256 + h * 64 + 16 * dq + 8);
                        f32x4 ka, kb2, kc, kd, qa, qb2, qc, qd; unpack8(k0, ka, kb2); unpack8(k1, kc, kd); unpack8(q0, qa, qb2); unpack8(q1, qc, qd);
                        const float* gp = Gp + (size_t)row * 256 + h * 64 + 16 * dq;
                        const f32x4 g0 = *(const f32x4*)gp, g1 = *(const f32x4*)(gp + 4), g2 = *(const f32x4*)(gp + 8), g3 = *(const f32x4*)(gp + 12);
                        const float v = bf2f(Vb[(size_t)row * 512 + h * 128 + e]);
                        float kk[16] = {ka[0], ka[1], ka[2], ka[3], kb2[0], kb2[1], kb2[2], kb2[3], kc[0], kc[1], kc[2], kc[3], kd[0], kd[1], kd[2], kd[3]};
                        float qq[16] = {qa[0], qa[1], qa[2], qa[3], qb2[0], qb2[1], qb2[2], qb2[3], qc[0], qc[1], qc[2], qc[3], qd[0], qd[1], qd[2], qd[3]};
                        float gg[16] = {g0[0], g0[1], g0[2], g0[3], g1[0], g1[1], g1[2], g1[3], g2[0], g2[1], g2[2], g2[3], g3[0], g3[1], g3[2], g3[3]};
                        float o = 0.f;
#pragma unroll
                        for (int i = 0; i < 16; ++i) { S[i] = __expf(gg[i]) * S[i] + kk[i] * v; o += qq[i] * S[i]; }
                        o += __shfl_xor(o, 1); o += __shfl_xor(o, 2);
                        if (dq == 0) { float* op = O32 + (size_t)row * 512 + h * 128 + e; *op = dir ? *op + o : o; }
                    }
                }
                __builtin_amdgcn_fence(__ATOMIC_RELEASE, "agent"); VM_WAIT(); __syncthreads(); __builtin_amdgcn_fence(__ATOMIC_ACQUIRE, "agent"); VM_WAIT();
                const float* gnw = in[I_GNW] + l * 128;
                for (int i = wave; i < CTXL + SEQ; i += NWAVES) {
                    const int row = i < SEQ ? b * SEQ + i : NLAT + b * CTXL + (i - SEQ);
                    const f32x2 o = *(const f32x2*)(O32 + (size_t)row * 512 + h * 128 + 2 * lane);
                    const float rstd = rsqrtf(wave_sum(o[0] * o[0] + o[1] * o[1]) * (1.f / 128.f) + EPS);
                    const unsigned rr = *(const unsigned*)(Rb + (size_t)row * 512 + h * 128 + 2 * lane);
                    *(unsigned*)(OG + (size_t)row * 512 + h * 128 + 2 * lane) = pk2(o[0] * rstd * gnw[2 * lane] * bflo(rr), o[1] * rstd * gnw[2 * lane + 1] * bfhi(rr));
                }
            } else if (vcu < 32) {
                const int item = (vcu - 16) * 8 + wave, b = item >> 5, g = item & 31;
                LAS f32x2* Ct = (LAS f32x2*)(lds + wave * 9216);
                LAS f32x2* hb = (LAS f32x2*)(lds + wave * 9216 + 8192);
                for (int i = lane; i < 1024; i += 64) { const int p = i >> 4, hh = i & 15; Ct[i] = (f32x2){in[I_CRE][((size_t)(l * 32 + g) * 16 + hh) * 64 + p], in[I_CIM][((size_t)(l * 32 + g) * 16 + hh) * 64 + p]}; }
                LDS_WAIT();
                const int hh = lane & 15, pq = lane >> 4;
                const float dsk = in[I_S5D][l * 512 + 16 * g + hh];
                for (int dir = 0; dir < 2; ++dir) {
                    const f32x2 lam = LAMB[((l * 2 + dir) * 32 + g) * 64 + lane];
                    float br[16], bim_[16];
#pragma unroll
                    for (int j = 0; j < 16; ++j) { const f32x2 v = BBAR[((size_t)((l * 2 + dir) * 32 + g) * 64 + lane) * 16 + j]; br[j] = v[0]; bim_[j] = v[1]; }
                    float hr = 0.f, hi_ = 0.f;
                    for (int t = 0; t < CTXL + SEQ; ++t) {
                        int row;
                        if (dir == 0) { if (t < CTXL) row = NLAT + b * CTXL + t; else { const int q = t - CTXL, c = q >> 6, r = q & 63; row = b * SEQ + r * 64 + c; } }
                        else { if (t < CTXL) row = NLAT + b * CTXL + (CTXL - 1 - t); else { const int q = SEQ - 1 - (t - CTXL), c = q >> 6, r = q & 63; row = b * SEQ + r * 64 + c; } }
                        const v4u u0 = *(const v4u*)(Ub + (size_t)row * 512 + 16 * g), u1 = *(const v4u*)(Ub + (size_t)row * 512 + 16 * g + 8);
                        f32x4 ua, ub, uc, ud; unpack8(u0, ua, ub); unpack8(u1, uc, ud);
                        const float uu[16] = {ua[0], ua[1], ua[2], ua[3], ub[0], ub[1], ub[2], ub[3], uc[0], uc[1], uc[2], uc[3], ud[0], ud[1], ud[2], ud[3]};
                        float sr = 0.f, si = 0.f;
#pragma unroll
                        for (int j = 0; j < 16; ++j) { sr += br[j] * uu[j]; si += bim_[j] * uu[j]; }
                        const float nr = lam[0] * hr - lam[1] * hi_ + sr, ni = lam[0] * hi_ + lam[1] * hr + si; hr = nr; hi_ = ni;
                        hb[lane] = (f32x2){hr, hi_};
                        LDS_WAIT();
                        float y = 0.f;
#pragma unroll
                        for (int pp = 0; pp < 16; ++pp) { const f32x2 c = Ct[(16 * pq + pp) * 16 + hh], hv = hb[16 * pq + pp]; y += c[0] * hv[0] - c[1] * hv[1]; }
                        y += __shfl_xor(y, 16); y += __shfl_xor(y, 32);
                        LDS_WAIT();
                        if (lane < 16) {
                            float* yp = Y32 + (size_t)row * 512 + 16 * g + hh;
                            if (dir == 0) *yp = y;
                            else { const float tot = *yp + y + dsk * bf2f(Ub[(size_t)row * 512 + 16 * g + hh]); SG[(size_t)row * 512 + 16 * g + hh] = (bf16)f2bf(geluf_(tot)); }
                        }
                    }
                }
            }
        }
        SEAM(pb + 2);
        if (IN(pb + 3)) { PHASE_BEGIN();
            pg8::Order S; S.init1(G, bx, SG, (bf16*)(wb + W_GLU) + (size_t)l * 512 * 512, mpan, 2, 512);
            S.A1 = (const char*)OG; S.B1 = (const char*)((bf16*)(wb + W_GP) + (size_t)l * 1024 * 512); S.nM1 = mpan; S.nN1 = 4; S.kind1 = 1;
            EpiD12 E{SG, S2, in[I_BGLU] + l * 512, GAb, Tb};
            pg8::gemm_phase<EpiD12, pg8::Order>(lds + RING_OFF, tid, 512, S, E);
        }
        SEAM(pb + 3);
        if (IN(pb + 4)) { PHASE_BEGIN();
            pg8::Order S; S.init1(G, bx, S2, (bf16*)(wb + W_SP) + (size_t)l * 1024 * 512, mpan, 4, 512);
            EpiD3 E{Tb, GMb, XN};
            pg8::gemm_phase<EpiD3, pg8::Order>(lds + RING_OFF, tid, 512, S, E);
        }
        SEAM(pb + 4);
        if (IN(pb + 5)) { PHASE_BEGIN();
            pg8::Order S; S.init1(G, bx, XN, (bf16*)(wb + W_OUT) + (size_t)l * 1024 * 1024, mpan, 4, 1024);
            EpiResid E{RES_L, RES_C, LATX, MODVL, 2};
            pg8::gemm_phase<EpiResid, pg8::Order>(lds + RING_OFF, tid, 1024, S, E);
        }
        SEAM(pb + 5);
        if (IN(pb + 6)) { PHASE_BEGIN();
            const float* nw = in[I_N2W] + l * 1024;
            LAS float* rw = (LAS float*)(lds);
            if (l == 1) { for (int i = tid; i < 8192; i += 512) rw[i] = in[I_ROUTER][i]; __syncthreads(); }
            const int nr2 = l == 0 ? NROW : NLAT;
            for (int row = gw; row < nr2; row += NGW) {
                const float* xr = LATX + (size_t)row * 1024;
                const int bi = row < NLAT ? row >> 12 : 4; const float* sh = MODVL + bi * 6144 + 3 * 1024; const float* sc = sh + 1024;
                f32x4 v[4]; float ss = 0.f;
#pragma unroll
                for (int j = 0; j < 4; ++j) { v[j] = *(const f32x4*)(xr + 4 * lane + 256 * j); ss += v[j][0] * v[j][0] + v[j][1] * v[j][1] + v[j][2] * v[j][2] + v[j][3] * v[j][3]; }
                const float rstd = rsqrtf(wave_sum(ss) * (1.f / 1024.f) + EPS);
                float lg[8];
#pragma unroll
                for (int e = 0; e < 8; ++e) lg[e] = 0.f;
#pragma unroll
                for (int j = 0; j < 4; ++j) { const int c = 4 * lane + 256 * j; const f32x4 w = *(const f32x4*)(nw + c), s1 = *(const f32x4*)(sc + c), s0 = *(const f32x4*)(sh + c);
                    f32x4 y;
#pragma unroll
                    for (int e = 0; e < 4; ++e) y[e] = v[j][e] * rstd * w[e] * (1.f + s1[e]) + s0[e];
                    if (l == 0) { v2u o; o.x = pk2(y[0], y[1]); o.y = pk2(y[2], y[3]); *(v2u*)(XN + (size_t)row * 1024 + c) = o; }
                    else {
#pragma unroll
                        for (int e = 0; e < 4; ++e) { const f32x4 r0 = *(const LAS f32x4*)(rw + (c + e) * 8), r1 = *(const LAS f32x4*)(rw + (c + e) * 8 + 4);
                            lg[0] += y[e] * r0[0]; lg[1] += y[e] * r0[1]; lg[2] += y[e] * r0[2]; lg[3] += y[e] * r0[3]; lg[4] += y[e] * r1[0]; lg[5] += y[e] * r1[1]; lg[6] += y[e] * r1[2]; lg[7] += y[e] * r1[3]; } } }
                if (l == 1) {
#pragma unroll
                    for (int e = 0; e < 8; ++e) lg[e] = wave_sum(lg[e]);
                    int e1 = 0; float v1 = lg[0];
#pragma unroll
                    for (int e = 1; e < 8; ++e) if (lg[e] > v1) { v1 = lg[e]; e1 = e; }
                    int e2 = -1; float v2 = -3.0e38f;
#pragma unroll
                    for (int e = 0; e < 8; ++e) if (e != e1 && lg[e] > v2) { v2 = lg[e]; e2 = e; }
                    if (lane == 0) {
                        const float w1 = 1.f / (1.f + __expf(v2 - v1));
                        const int p1 = (int)__hip_atomic_fetch_add(ctl + CW_CNT + 64 * e1, 1u, RLX_AGENT), p2 = (int)__hip_atomic_fetch_add(ctl + CW_CNT + 64 * e2, 1u, RLX_AGENT);
                        TOKE[row] = make_int4(e1, p1, e2, p2); TOKW[row] = (f32x2){w1, 1.f - w1};
                    }
                }
            }
        }
        SEAM(pb + 6);
        if (l == 0) {
            if (IN(8)) { PHASE_BEGIN();
                pg8::Order S; S.init1(G, bx, XN, (bf16*)(wb + W_FGU), NPAN, 22, 1024);
                EpiSwiglu E{HMID, FFD, 0};
                pg8::gemm_phase<EpiSwiglu, pg8::Order>(lds + RING_OFF, tid, 1024, S, E);
            }
            SEAM(8);
            if (IN(9)) { PHASE_BEGIN();
                pg8::Order S; S.init1(G, bx, HMID, (bf16*)(wb + W_FD), NPAN, 4, FFD);
                EpiResid E{LATX, LATX + (size_t)NLAT * 1024, LATX, MODVL, 5};
                pg8::gemm_phase<EpiResid, pg8::Order>(lds + RING_OFF, tid, FFD, S, E);
            }
            SEAM(9);
        }
    }

    int pbase[9];
    {
        int a = 0;
#pragma unroll
        for (int e = 0; e < 8; ++e) { pbase[e] = a; const unsigned c = hi > 17 ? __hip_atomic_load((gu32*)(args.ws + WS_CTL) + CW_CNT + 64 * e, RLX_AGENT) : 0u; a += (int)((c + 255u) >> 8); }
        pbase[8] = a;
    }
    if (IN(17)) { PHASE_BEGIN();
        {
            LAS float* scr = (LAS float*)(lds + wave * 9216);
            constexpr int IT_G = 16 * 112, IT_D = 56 * 32, IT_E = 2 * IT_G + IT_D;
            for (int it = gw; it < 8 * IT_E; it += NGW) {
                const int e = it / IT_E; int r = it - e * IT_E;
                if (conv_matrix(r, in[I_MG] + (size_t)e * 1024 * FFE, 1024, FFE, WMGU + (size_t)e * 7168 * 1024, 2, 0, scr, lane)) continue;
                if (conv_matrix(r, in[I_MU] + (size_t)e * 1024 * FFE, 1024, FFE, WMGU + (size_t)e * 7168 * 1024, 2, 128, scr, lane)) continue;
                conv_matrix(r, in[I_MD] + (size_t)e * FFE * 1024, FFE, 1024, WMD + (size_t)e * 1024 * FFE, 0, 0, scr, lane);
            }
        }
        const float* modv = MODV + (size_t)5 * 6144; const float* nw = in[I_N2W] + 1024;
        for (int row = gw; row < NLAT; row += NGW) {
            const float* xr = LATX + (size_t)row * 1024;
            const int bi = row >> 12; const float* sh = modv + bi * 6144 + 3 * 1024; const float* sc = sh + 1024;
            f32x4 v[4]; float ss = 0.f;
#pragma unroll
            for (int j = 0; j < 4; ++j) { v[j] = *(const f32x4*)(xr + 4 * lane + 256 * j); ss += v[j][0] * v[j][0] + v[j][1] * v[j][1] + v[j][2] * v[j][2] + v[j][3] * v[j][3]; }
            const float rstd = rsqrtf(wave_sum(ss) * (1.f / 1024.f) + EPS);
            const int4 te = TOKE[row];
            int s1 = 0, s2 = 0;
#pragma unroll
            for (int e = 0; e < 8; ++e) { if (te.x == e) s1 = pbase[e] * 256 + te.y; if (te.z == e) s2 = pbase[e] * 256 + te.w; }
            if (lane == 0) TOKS[row] = make_int2(s1, s2);
#pragma unroll
            for (int j = 0; j < 4; ++j) { const int c = 4 * lane + 256 * j; const f32x4 w = *(const f32x4*)(nw + c), a1 = *(const f32x4*)(sc + c), a0 = *(const f32x4*)(sh + c);
                f32x4 y;
#pragma unroll
                for (int e = 0; e < 4; ++e) y[e] = v[j][e] * rstd * w[e] * (1.f + a1[e]) + a0[e];
                v2u o; o.x = pk2(y[0], y[1]); o.y = pk2(y[2], y[3]); *(v2u*)(XG + (size_t)s1 * 1024 + c) = o; *(v2u*)(XG + (size_t)s2 * 1024 + c) = o; }
        }
    }
    SEAM(17);
    for (int g = 0; g < 3; ++g) {
        const int p0 = 64 * g, np = pbase[8] - p0 < 64 ? (pbase[8] - p0 < 0 ? 0 : pbase[8] - p0) : 64;
        if (IN(18 + 2 * g)) { PHASE_BEGIN();
            pg8::Order S; S.init1(G, bx, XG, WMGU, np, 28, 1024);
            S.pm0 = p0; S.moe = 1; S.pb1 = pbase[1]; S.pb2 = pbase[2]; S.pb3 = pbase[3]; S.pb4 = pbase[4]; S.pb5 = pbase[5]; S.pb6 = pbase[6]; S.pb7 = pbase[7]; S.estride = (size_t)7168 * 1024 * 2;
            EpiSwiglu E{HM, FFE, p0};
            pg8::gemm_phase<EpiSwiglu, pg8::Order>(lds + RING_OFF, tid, 1024, S, E);
        }
        SEAM(18 + 2 * g);
        if (IN(19 + 2 * g)) { PHASE_BEGIN();
            pg8::Order S; S.init1(G, bx, HM, WMD, np, 4, FFE);
            S.pm0 = p0; S.apm0 = p0; S.moe = 1; S.pb1 = pbase[1]; S.pb2 = pbase[2]; S.pb3 = pbase[3]; S.pb4 = pbase[4]; S.pb5 = pbase[5]; S.pb6 = pbase[6]; S.pb7 = pbase[7]; S.estride = (size_t)1024 * FFE * 2;
            EpiPlain E{YS};
            pg8::gemm_phase<EpiPlain, pg8::Order>(lds + RING_OFF, tid, FFE, S, E);
        }
        SEAM(19 + 2 * g);
    }
    if (IN(24)) { PHASE_BEGIN();
        const float* modv = MODV + (size_t)5 * 6144; const float* fw = in[I_FNW];
        for (int row = gw; row < NLAT; row += NGW) {
            const float* xr = LATX + (size_t)row * 1024; const int bi = row >> 12; const float* g2 = modv + bi * 6144 + 5 * 1024;
            const int2 sl = TOKS[row]; const f32x2 tw = TOKW[row];
            f32x4 v[4]; float ss = 0.f;
#pragma unroll
            for (int j = 0; j < 4; ++j) { const int c = 4 * lane + 256 * j; const f32x4 x = *(const f32x4*)(xr + c), gg = *(const f32x4*)(g2 + c);
                const v2u y1 = *(const v2u*)(YS + (size_t)sl.x * 1024 + c), y2 = *(const v2u*)(YS + (size_t)sl.y * 1024 + c);
                const f32x4 a = (f32x4){bflo(y1.x), bfhi(y1.x), bflo(y1.y), bfhi(y1.y)}, bq = (f32x4){bflo(y2.x), bfhi(y2.x), bflo(y2.y), bfhi(y2.y)};
                v[j] = x + gg * (a * tw[0] + bq * tw[1]);
                ss += v[j][0] * v[j][0] + v[j][1] * v[j][1] + v[j][2] * v[j][2] + v[j][3] * v[j][3]; }
            const float rstd = rsqrtf(wave_sum(ss) * (1.f / 1024.f) + EPS);
#pragma unroll
            for (int j = 0; j < 4; ++j) { const int c = 4 * lane + 256 * j; const f32x4 w = *(const f32x4*)(fw + c); *(f32x4*)(args.out + (size_t)row * 1024 + c) = v[j] * rstd * w; }
        }
    }
#undef IN
#undef SEAM
}

extern "C" void kernel_launch(void* const* d_in, const int* in_sizes, int n_in, void* d_out, int out_size, void* d_ws, size_t ws_size, hipStream_t stream) {
    static int grid = 0;
    if (grid == 0) {
        if (n_in != N_IN || out_size != NLAT * D || ws_size < WS_END) { fprintf(stderr, "kernel_launch: unexpected shapes (n_in %d, out %d, ws %zu)\n", n_in, out_size, ws_size); grid = -1; return; }
        int dev = 0, cus = 0, per_cu = 0;
        if (hipGetDevice(&dev) != hipSuccess || hipDeviceGetAttribute(&cus, hipDeviceAttributeMultiprocessorCount, dev) != hipSuccess) { grid = -1; return; }
        if (hipFuncSetAttribute((const void*)fwd_kernel, hipFuncAttributeMaxDynamicSharedMemorySize, LDS_BYTES) != hipSuccess) { fprintf(stderr, "kernel_launch: hipFuncSetAttribute failed\n"); grid = -1; return; }
        if (hipOccupancyMaxActiveBlocksPerMultiprocessor(&per_cu, (const void*)fwd_kernel, NWAVES * 64, LDS_BYTES) != hipSuccess || per_cu < 1) fprintf(stderr, "kernel_launch: occupancy query reports %d\n", per_cu);
        (void)hipGetLastError();
        grid = cus;
    }
    if (grid < 0) return;
    if (hipMemsetAsync((char*)d_ws + WS_CTL, 0, CTL_ZERO_BYTES, stream) != hipSuccess) return;
    Args a{};
    for (int i = 0; i < N_IN; ++i) a.in[i] = (const float*)d_in[i];
    a.out = (float*)d_out; a.ws = (unsigned char*)d_ws;
#if MK_ONE_LAUNCH
    a.ph_lo = 0; a.ph_hi = NPH;
    hipLaunchKernelGGL(fwd_kernel, dim3(grid), dim3(NWAVES * 64), LDS_BYTES, stream, a);
#else
    for (int p = 0; p < NPH; ++p) { a.ph_lo = p; a.ph_hi = p + 1; hipLaunchKernelGGL(fwd_kernel, dim3(grid), dim3(NWAVES * 64), LDS_BYTES, stream, a); }
#endif
}
```

```cpp
#include <hip/hip_runtime.h>
#include <cstdio>
#include <cstdint>

#ifndef MK_ONE_LAUNCH
#define MK_ONE_LAUNCH 1
#endif

namespace pg8 {
#define PG8_LAS __attribute__((address_space(3)))
typedef unsigned short bf16_t;
typedef short bf16x8 __attribute__((ext_vector_type(8)));
typedef float f32x4 __attribute__((ext_vector_type(4)));
typedef unsigned u32x4 __attribute__((ext_vector_type(4)));
constexpr int BM = 256, BK = 64, HALF = 128, HTB = HALF * BK * 2, STAGE_BYTES = 8 * HTB, NXCD = 8, WGM = 8;

__host__ __device__ __forceinline__ int lds_byte(int r, int c) { const int st = (r >> 4) * 2 + (c >> 5), rr = r & 15, cc = c & 31, ob = rr * 64 + cc * 2; return st * 1024 + (ob ^ (((ob >> 9) & 1) << 5)); }
__host__ __device__ __forceinline__ void stage_rc(int b, int& R, int& C) { const int st = b / 1024, sb = b % 1024, swz = sb ^ (((sb >> 9) & 1) << 5); R = (st >> 1) * 16 + swz / 64; C = (st & 1) * 32 + (swz % 64) / 2; }
__host__ __device__ __forceinline__ int perm32(int rho) { const int n = rho >> 4, i = rho & 15; return 8 * (i >> 2) + 4 * n + (i & 3); }

struct Unit { int pm, pn, kind; const char* A; const char* B; };

struct Order {
    int G, c;
    int n0;
    const char* A0; const char* B0; int nM0, nN0, kind0;
    const char* A1; const char* B1; int nM1, nN1, kind1;
    size_t tstep;
    int pm0;
    int apm0;
    int moe; int pb1, pb2, pb3, pb4, pb5, pb6, pb7; size_t estride;
    __device__ __forceinline__ void init1(int G_, int c_, const void* A, const void* B, int nM, int nN, int K) {
        G = G_; c = c_; A0 = (const char*)A; B0 = (const char*)B; nM0 = nM; nN0 = nN; kind0 = 0; n0 = nM * nN; A1 = A0; B1 = B0; nM1 = 0; nN1 = 1; kind1 = 1;
        tstep = (size_t)256 * K * 2; pm0 = 0; apm0 = 0; moe = 0; pb1 = pb2 = pb3 = pb4 = pb5 = pb6 = pb7 = 0; estride = 0; }
    __device__ __forceinline__ bool next(int i, Unit& u) const {
        long L = (long)i * G + c; const bool s = L >= n0; if (s) L -= n0;
        const int nM = s ? nM1 : nM0, nN = s ? nN1 : nN0, nwg = nM * nN; if (L >= nwg) return false;
        int wgid = (int)L; { const int q = nwg / NXCD, r = nwg % NXCD, xcd = wgid % NXCD, off = wgid / NXCD; wgid = (xcd < r ? xcd * (q + 1) : r * (q + 1) + (xcd - r) * q) + off; }
        const int nig = WGM * nN, gid = wgid / nig, fm = gid * WGM, gsz = (nM - fm) < WGM ? (nM - fm) : WGM;
        const int pm = pm0 + fm + ((wgid % nig) % gsz), pn = (wgid % nig) / gsz;
        u.pm = pm; u.pn = pn; u.kind = s ? kind1 : kind0;
        u.A = (s ? A1 : A0) + (size_t)(pm - apm0) * tstep;
        const char* b = (s ? B1 : B0) + (size_t)pn * tstep;
        if (moe) { const int e = (pm >= pb1) + (pm >= pb2) + (pm >= pb3) + (pm >= pb4) + (pm >= pb5) + (pm >= pb6) + (pm >= pb7); b += (size_t)e * estride; }
        u.B = b; return true;
    }
    __device__ __forceinline__ void a_ready(const Unit&) const {}
    __device__ __forceinline__ void done(const Unit&) const {}
};

__device__ __forceinline__ unsigned cvt_pk_bf16(float lo, float hi) { unsigned r; asm volatile("v_cvt_pk_bf16_f32 %0, %1, %2" : "=v"(r) : "v"(lo), "v"(hi)); return r; }

template <class Epi, class Sched, bool ALIGN_EPI = true, bool SP2 = true>
__device__ __forceinline__ void gemm_phase(PG8_LAS unsigned char* lds, const int tid, const int K, const Sched& S, const Epi& E) {
    const int wid = __builtin_amdgcn_readfirstlane(tid >> 6), lane = tid & 63, wr = wid >> 2, wc = wid & 3, fr = lane & 15, fq = lane >> 4;
    const int nt = K / BK;
    unsigned voffA[2], voffB[2];
#pragma unroll
    for (int i = 0; i < 2; ++i) { int R, C; stage_rc(tid * 16 + i * 8192, R, C); const int Rb = ((R & ~31) + perm32(R & 31));
        voffA[i] = (unsigned)(R * K + C) * 2u; voffB[i] = (unsigned)(Rb * K + C) * 2u; }
    const size_t kstep = (size_t)(BK * 2);
    const size_t hstep = (size_t)HALF * K * 2;
    const unsigned ldsw = (unsigned)wid * 1024u;
    const int aoff = lds_byte(wr * 64 + fr, fq * 8), boff = lds_byte(wc * 32 + fr, fq * 8);
#define PG8_SA(b, h) (((b) * 2 + (h)) * HTB)
#define PG8_SB(b, h) ((4 + (b) * 2 + (h)) * HTB)
#define PG8_STAGE(bufoff, gbase, voff) do { _Pragma("unroll") for (int _i = 0; _i < 2; ++_i) \
        __builtin_amdgcn_global_load_lds((const unsigned*)((const char*)(gbase) + (voff)[_i]), (PG8_LAS unsigned*)(lds + (bufoff) + ldsw + _i * 8192), 16, 0, 0); } while (0)
#define PG8_LDA(dst, b, h) do { _Pragma("unroll") for (int m = 0; m < 4; ++m) _Pragma("unroll") for (int k = 0; k < 2; ++k) dst[m][k] = *(const PG8_LAS bf16x8*)(lds + PG8_SA(b, h) + aoff + m * 2048 + k * 1024); } while (0)
#define PG8_LDB(dst, b, h) do { _Pragma("unroll") for (int n = 0; n < 2; ++n) _Pragma("unroll") for (int k = 0; k < 2; ++k) dst[n][k] = *(const PG8_LAS bf16x8*)(lds + PG8_SB(b, h) + boff + n * 2048 + k * 1024); } while (0)
#define PG8_MMA(ai, bj, At, Bt) do { __builtin_amdgcn_s_setprio(1); _Pragma("unroll") for (int m = 0; m < 4; ++m) _Pragma("unroll") for (int n = 0; n < 2; ++n) _Pragma("unroll") for (int k = 0; k < 2; ++k) \
        acc[ai][bj][m][n] = __builtin_amdgcn_mfma_f32_16x16x32_bf16(Bt[n][k], At[m][k], acc[ai][bj][m][n], 0, 0, 0); __builtin_amdgcn_s_setprio(0); } while (0)
#define PG8_WAIT_V(n) asm volatile("s_waitcnt vmcnt(" #n ")" ::: "memory")
#define PG8_WAIT_L(n) asm volatile("s_waitcnt lgkmcnt(" #n ")" ::: "memory")
#define PG8_BAR __builtin_amdgcn_s_barrier()
#define PG8_SCHED __builtin_amdgcn_sched_barrier(0)
    Unit cur, nxt; int ui = 0;
    if (!S.next(0, cur)) return;
    f32x4 acc[2][2][4][2];
#pragma unroll
    for (int a = 0; a < 2; ++a)
#pragma unroll
        for (int b = 0; b < 2; ++b)
#pragma unroll
            for (int m = 0; m < 4; ++m)
#pragma unroll
                for (int n = 0; n < 2; ++n) acc[a][b][m][n] = (f32x4){0.f, 0.f, 0.f, 0.f};
    bf16x8 At[4][2], B0[2][2], B1[2][2];
    const char* cA = cur.A; const char* cB = cur.B;
    S.a_ready(cur);
    if constexpr (SP2) {
        PG8_STAGE(PG8_SB(0, 0), cB, voffB); PG8_STAGE(PG8_SB(0, 1), cB + hstep, voffB); PG8_STAGE(PG8_SA(0, 0), cA, voffA); PG8_STAGE(PG8_SA(0, 1), cA + hstep, voffA);
        if (wr == 1) PG8_BAR;
        PG8_WAIT_V(2); PG8_BAR;
        PG8_STAGE(PG8_SB(1, 0), cB + kstep, voffB); PG8_STAGE(PG8_SA(1, 0), cA + kstep, voffA); PG8_STAGE(PG8_SB(1, 1), cB + hstep + kstep, voffB);
        PG8_WAIT_V(6); PG8_BAR;
    } else {
        PG8_STAGE(PG8_SB(0, 0), cB, voffB); PG8_STAGE(PG8_SA(0, 0), cA, voffA); PG8_STAGE(PG8_SB(0, 1), cB + hstep, voffB); PG8_STAGE(PG8_SA(0, 1), cA + hstep, voffA);
        if (wr == 1) PG8_BAR;
        PG8_WAIT_V(4); PG8_BAR;
        PG8_STAGE(PG8_SB(1, 0), cB + kstep, voffB); PG8_STAGE(PG8_SA(1, 0), cA + kstep, voffA); PG8_STAGE(PG8_SB(1, 1), cB + hstep + kstep, voffB);
        PG8_WAIT_V(6); PG8_BAR;
    }
    for (;;) {
        const bool has_next = S.next(ui + 1, nxt);
        const char* nA = has_next ? nxt.A : cA; const char* nB = has_next ? nxt.B : cB;
        for (int t = 0; t < nt; t += 2) {
            const bool last = (t == nt - 2);
            const char* a1 = cA + (size_t)(t + 1) * kstep;
            const char* a2 = last ? nA : cA + (size_t)(t + 2) * kstep; const char* b2 = last ? nB : cB + (size_t)(t + 2) * kstep;
            const char* a3 = a2 + kstep; const char* b3 = b2 + kstep;
            if (last && has_next) S.a_ready(nxt);
            if constexpr (SP2) {
            PG8_LDB(B0, 0, 0); PG8_LDB(B1, 0, 1); PG8_SCHED; PG8_LDA(At, 0, 0); PG8_STAGE(PG8_SA(1, 1), a1 + hstep, voffA);
            PG8_WAIT_V(8); PG8_WAIT_L(0); PG8_BAR; PG8_MMA(0, 0, At, B0); PG8_MMA(0, 1, At, B1); PG8_BAR; PG8_SCHED;
            PG8_LDA(At, 0, 1); PG8_STAGE(PG8_SB(0, 0), b2, voffB); PG8_STAGE(PG8_SB(0, 1), b2 + hstep, voffB); PG8_STAGE(PG8_SA(0, 0), a2, voffA);
            PG8_WAIT_V(8); PG8_WAIT_L(0); PG8_BAR; PG8_MMA(1, 0, At, B0); PG8_MMA(1, 1, At, B1); PG8_BAR; PG8_SCHED;
            PG8_LDB(B0, 1, 0); PG8_LDB(B1, 1, 1); PG8_SCHED; PG8_LDA(At, 1, 0); PG8_STAGE(PG8_SA(0, 1), a2 + hstep, voffA);
            PG8_WAIT_V(8); PG8_WAIT_L(0); PG8_BAR; PG8_MMA(0, 0, At, B0); PG8_MMA(0, 1, At, B1); PG8_BAR; PG8_SCHED;
            PG8_LDA(At, 1, 1); PG8_STAGE(PG8_SB(1, 0), b3, voffB); PG8_STAGE(PG8_SB(1, 1), b3 + hstep, voffB); PG8_STAGE(PG8_SA(1, 0), a3, voffA);
            PG8_WAIT_V(8); PG8_WAIT_L(0); PG8_BAR; PG8_MMA(1, 0, At, B0); PG8_MMA(1, 1, At, B1); PG8_BAR; PG8_SCHED;
            } else {
            PG8_LDB(B0, 0, 0); PG8_SCHED; PG8_LDA(At, 0, 0); PG8_STAGE(PG8_SA(1, 1), a1 + hstep, voffA);
            PG8_WAIT_L(8); PG8_BAR; PG8_WAIT_L(0); PG8_MMA(0, 0, At, B0); PG8_BAR; PG8_SCHED;
            PG8_LDB(B1, 0, 1); PG8_STAGE(PG8_SB(0, 0), b2, voffB);
            PG8_BAR; PG8_WAIT_L(0); PG8_MMA(0, 1, At, B1); PG8_BAR;
            PG8_LDA(At, 0, 1); PG8_STAGE(PG8_SA(0, 0), a2, voffA);
            PG8_BAR; PG8_WAIT_L(0); PG8_MMA(1, 0, At, B0); PG8_BAR; PG8_SCHED;
            PG8_STAGE(PG8_SB(0, 1), b2 + hstep, voffB);
            PG8_WAIT_V(6); PG8_BAR; PG8_MMA(1, 1, At, B1); PG8_BAR;
            PG8_LDB(B0, 1, 0); PG8_SCHED; PG8_LDA(At, 1, 0); PG8_STAGE(PG8_SA(0, 1), a2 + hstep, voffA);
            PG8_WAIT_L(8); PG8_BAR; PG8_WAIT_L(0); PG8_MMA(0, 0, At, B0); PG8_BAR; PG8_SCHED;
            PG8_LDB(B1, 1, 1); PG8_STAGE(PG8_SB(1, 0), b3, voffB);
            PG8_BAR; PG8_WAIT_L(0); PG8_MMA(0, 1, At, B1); PG8_BAR;
            PG8_LDA(At, 1, 1); PG8_STAGE(PG8_SA(1, 0), a3, voffA);
            PG8_BAR; PG8_WAIT_L(0); PG8_MMA(1, 0, At, B0); PG8_BAR; PG8_SCHED;
            PG8_STAGE(PG8_SB(1, 1), b3 + hstep, voffB);
            PG8_WAIT_V(6); PG8_BAR; PG8_MMA(1, 1, At, B1); PG8_BAR;
            }
        }
        if constexpr (ALIGN_EPI) { if (wr == 0) PG8_BAR; }
        E(acc, cur, wr, wc, fr, fq); S.done(cur);
        if (!has_next) break;
#pragma unroll
        for (int a = 0; a < 2; ++a)
#pragma unroll
            for (int b = 0; b < 2; ++b)
#pragma unroll
                for (int m = 0; m < 4; ++m)
#pragma unroll
                    for (int n = 0; n < 2; ++n) acc[a][b][m][n] = (f32x4){0.f, 0.f, 0.f, 0.f};
        cur = nxt; cA = nA; cB = nB; ++ui;
        if constexpr (ALIGN_EPI) { if (wr == 1) PG8_BAR; }
    }
    PG8_WAIT_V(0);
    if constexpr (!ALIGN_EPI) { if (wr == 0) PG8_BAR; }
    PG8_BAR;
#undef PG8_SA
#undef PG8_SB
#undef PG8_STAGE
#undef PG8_LDA
#undef PG8_LDB
#undef PG8_MMA
#undef PG8_WAIT_V
#undef PG8_WAIT_L
#undef PG8_BAR
#undef PG8_SCHED
}
}

constexpr int NWAVES = 8;
constexpr int D = 1024, NBATCH = 4, SEQ = 4096, CTXL = 256;
constexpr int NLAT = NBATCH * SEQ, NCTX = NBATCH * CTXL, NROW = NLAT + NCTX, NPAN = NROW / 256;
constexpr int INW_SRC = 4128, INW = 4608;
constexpr int FFD = 2816, FFE = 3584, NEXP = 8;
constexpr float EPS = 1e-6f;

constexpr size_t MiB = 1u << 20;
constexpr size_t WS_CTL = 0, CTL_ZERO_BYTES = 1 * MiB;
constexpr size_t WS_TAB = 1 * MiB;
constexpr size_t WS_LATX = 8 * MiB;
constexpr size_t WS_W = 76 * MiB;
constexpr size_t WS_XN = 120 * MiB;
constexpr size_t WS_IP = 154 * MiB;
constexpr size_t WS_DS = 324 * MiB;
constexpr size_t WS_S5F = 392 * MiB;
constexpr size_t WS_OG = 401 * MiB;
constexpr size_t WS_SG = 418 * MiB;
constexpr size_t WS_O32 = 435 * MiB;
constexpr size_t WS_Y32 = 469 * MiB;
constexpr size_t WS_S5H = 469 * MiB;
constexpr size_t WS_WM = 76 * MiB;
constexpr size_t WS_XG = 244 * MiB;
constexpr size_t WS_HM = 312 * MiB;
constexpr size_t WS_YS = 424 * MiB;
constexpr size_t WS_END = 504 * MiB;
constexpr size_t IP_K = 0, IP_V = IP_K + (size_t)NROW * 256 * 2, IP_GF = IP_V + (size_t)NROW * 512 * 2, IP_GB = IP_GF + (size_t)NROW * 256 * 4,
                 IP_U = IP_GB + (size_t)NROW * 256 * 4, IP_Q = IP_U + (size_t)NROW * 512 * 2, IP_R = IP_Q + (size_t)NROW * 256 * 2,
                 IP_GA = IP_R + (size_t)NROW * 512 * 2, IP_GM = IP_GA + (size_t)NROW * 1024 * 2, IP_END = IP_GM + (size_t)NROW * 1024 * 2;
static_assert(IP_END <= 170 * MiB, "in-proj region");
constexpr size_t IP_T = IP_K;
constexpr size_t IP_S2 = IP_U;
constexpr size_t IP_HMID = 0;
static_assert((size_t)NROW * 1024 * 2 <= IP_GB, "T overlay");
static_assert((size_t)NROW * FFD * 2 <= 170 * MiB, "HMID overlay");
constexpr size_t W_IN = 0;
constexpr size_t W_GLU = 18 * MiB;
constexpr size_t W_GP = 19 * MiB;
constexpr size_t W_SP = 21 * MiB;
constexpr size_t W_OUT = 23 * MiB;
constexpr size_t W_FGU = 27 * MiB;
constexpr size_t W_FD = 38 * MiB;
constexpr size_t WM_GU = 0;
constexpr size_t WM_D = 112 * MiB;
constexpr size_t T_MODV = 0;
constexpr size_t T_LAMB = 256 * 1024;
constexpr size_t T_BBAR = 512 * 1024;
constexpr size_t T_TOKE = 2 * MiB;
constexpr size_t T_TOKW = 2 * MiB + 256 * 1024;
constexpr size_t T_TOKS = 2 * MiB + 512 * 1024;
constexpr size_t T_BMT = 3 * MiB;
constexpr size_t T_CMT = 3 * MiB + 512 * 1024;
constexpr int CW_TMO = 0, CW_CODE = 1;
constexpr int CW_BAR = 4096;
constexpr int CW_CNT = 16384;

constexpr int RING_OFF = 0, RING_BYTES = 131072;
constexpr int LDSCTL_OFF = RING_BYTES, MISC_OFF = LDSCTL_OFF + 320;
constexpr int LDS_BYTES = 147456;

#define GAS __attribute__((address_space(1)))
#define LAS __attribute__((address_space(3)))
typedef unsigned short bf16;
typedef unsigned v4u __attribute__((ext_vector_type(4)));
typedef unsigned v2u __attribute__((ext_vector_type(2)));
typedef float f32x4 __attribute__((ext_vector_type(4)));
typedef float f32x2 __attribute__((ext_vector_type(2)));
typedef short bf16x8 __attribute__((ext_vector_type(8)));
typedef GAS unsigned gu32;
#define RLX_AGENT __ATOMIC_RELAXED, __HIP_MEMORY_SCOPE_AGENT
#define LDS_WAIT() asm volatile("s_waitcnt lgkmcnt(0)" ::: "memory")
#define VM_WAIT() asm volatile("s_waitcnt vmcnt(0)" ::: "memory")
__device__ __forceinline__ unsigned f2bf(float f) { unsigned u = __builtin_bit_cast(unsigned, f); return (u + 0x7fffu + ((u >> 16) & 1u)) >> 16; }
__device__ __forceinline__ unsigned pk2(float lo, float hi) { return f2bf(lo) | (f2bf(hi) << 16); }
__device__ __forceinline__ float bf2f(unsigned b) { return __builtin_bit_cast(float, b << 16); }
__device__ __forceinline__ float bflo(unsigned w) { return __builtin_bit_cast(float, w << 16); }
__device__ __forceinline__ float bfhi(unsigned w) { return __builtin_bit_cast(float, w & 0xffff0000u); }
__device__ __forceinline__ float sigmoidf_(float x) { return __builtin_amdgcn_rcpf(1.0f + __expf(-x)); }
__device__ __forceinline__ float siluf_(float x) { return x * __builtin_amdgcn_rcpf(1.0f + __expf(-x)); }
__device__ __forceinline__ float geluf_(float x) { const float t = 1.5957691216057308f * (x + 0.044715f * x * x * x); return x * __builtin_amdgcn_rcpf(1.0f + __expf(-t)); }
__device__ __forceinline__ float logsigmoidf_(float z) { return fminf(z, 0.f) - __logf(1.0f + __expf(-fabsf(z))); }

#define XB_TMO      128
#define XB_XCNT(j)  (256  + 64 * (j))
#define XB_XSUB(j)  (1280 + 64 * (j))
#define XB_XGEN(j)  (2304 + 64 * (j))
#define XB_TOP      3328
#define XB_TOPGEN   3392
#define XCD_BAR_WORDS 3456
#define XB_SPIN_CAP (1u << 18)
__device__ __forceinline__ unsigned xb_ld(unsigned* p)              { return __hip_atomic_load(p, __ATOMIC_RELAXED, __HIP_MEMORY_SCOPE_AGENT); }
__device__ __forceinline__ unsigned xb_add(unsigned* p, unsigned v) { return __hip_atomic_fetch_add(p, v, __ATOMIC_RELAXED, __HIP_MEMORY_SCOPE_AGENT); }
__device__ __forceinline__ unsigned xb_xcc_id() { return (unsigned)__builtin_amdgcn_s_getreg((3 << 11) | 20) & 0xFu; }
#define XB_SPIN(cond, bar) do { unsigned _sp = 0; while (cond) { __builtin_amdgcn_s_sleep(1); \
    if ((++_sp & 255u) == 0u) { if (xb_ld(&(bar)[XB_TMO])) break; if (_sp > XB_SPIN_CAP) { atomicAdd(&(bar)[XB_TMO], 1u); break; } } } } while (0)
struct XcdBarrier { unsigned* bar; unsigned x; volatile LAS unsigned* st; };
__device__ __forceinline__ XcdBarrier xcd_barrier_post(unsigned* bar, volatile LAS unsigned* st) {
    XcdBarrier b; b.bar = bar; b.x = xb_xcc_id(); b.st = st;
    if (threadIdx.x == 0) (void)xb_add(&bar[XB_XCNT(b.x)], 1u);
    return b;
}
__device__ __forceinline__ void xcd_barrier_complete(unsigned* bar, unsigned x, unsigned& nloc, unsigned& nx) {
    const unsigned G = gridDim.x * gridDim.y * gridDim.z;
    unsigned sum, cnt, mine, sp = 0u;
    for (;;) {
        sum = 0u; cnt = 0u; mine = 0u;
#pragma unroll
        for (unsigned j = 0; j < 16; ++j) { const unsigned c = xb_ld(&bar[XB_XCNT(j)]); sum += c; cnt += (c > 0u) ? 1u : 0u; mine = (j == x) ? c : mine; }
        if (sum == G) break;
        __builtin_amdgcn_s_sleep(1);
        if ((++sp & 255u) == 0u) { if (xb_ld(&bar[XB_TMO])) break; if (sp > XB_SPIN_CAP) { atomicAdd(&bar[XB_TMO], 1u); break; } }
    }
    nloc = mine > 0u ? mine : 1u; nx = cnt > 0u ? cnt : 1u;
}
__device__ __forceinline__ void xcd_barrier(const XcdBarrier& b) {
    asm volatile("s_waitcnt vmcnt(0)" ::: "memory");
    __syncthreads();
    if (threadIdx.x == 0) {
        unsigned* bar = b.bar;
        __builtin_amdgcn_s_waitcnt(0);
        unsigned nloc = b.st[0], nx = b.st[1];
        if (nloc == 0u) { xcd_barrier_complete(bar, b.x, nloc, nx); b.st[0] = nloc; b.st[1] = nx; }
        const unsigned old = xb_add(&bar[XB_XSUB(b.x)], 1u);
        const unsigned gen = old / nloc;
        if (old + 1u == (gen + 1u) * nloc) {
            __builtin_amdgcn_fence(__ATOMIC_RELEASE, "agent");
            asm volatile("s_waitcnt vmcnt(0)" ::: "memory");
            const unsigned og = xb_add(&bar[XB_TOP], 1u);
            const unsigned tg = og / nx;
            if (og + 1u == (tg + 1u) * nx) xb_add(&bar[XB_TOPGEN], 1u);
            else XB_SPIN(xb_ld(&bar[XB_TOPGEN]) == tg, bar);
            __builtin_amdgcn_fence(__ATOMIC_ACQUIRE, "");
            xb_add(&bar[XB_XGEN(b.x)], 1u);
            asm volatile("s_waitcnt vmcnt(0)" ::: "memory");
        } else {
            XB_SPIN(xb_ld(&bar[XB_XGEN(b.x)]) == gen, bar);
            __builtin_amdgcn_fence(__ATOMIC_ACQUIRE, "");
            asm volatile("s_waitcnt vmcnt(0)" ::: "memory");
        }
    }
    __syncthreads();
}

enum InIdx { I_X = 0, I_C, I_CTX, I_CCTX, I_WMOD, I_BMOD, I_N1W, I_N2W, I_FNW, I_WIN, I_LRF, I_LRB, I_BIASF, I_BIASB, I_GNW,
             I_AREF, I_AIMF, I_LDTF, I_AREB, I_AIMB, I_LDTB, I_BRE, I_BIM, I_CRE, I_CIM, I_S5D, I_WGLU, I_BGLU, I_WGP, I_WSP, I_WOUT,
             I_FG, I_FU, I_FD, I_ROUTER, I_MG, I_MU, I_MD, N_IN };
struct Args { const float* in[N_IN]; float* out; unsigned char* ws; int ph_lo, ph_hi; };

__device__ __forceinline__ float wave_sum(float v) {
#pragma unroll
    for (int o = 1; o < 64; o <<= 1) v += __shfl_xor(v, o);
    return v;
}

__device__ __forceinline__ void transpose_item(const float* W, int ldw, int k0, int n0, bf16* WT, int ldt, int drow0, LAS float* scr, int lane) {
#pragma unroll 8
    for (int i = 0; i < 32; ++i) { const int kk = 2 * i + (lane >> 5); scr[kk * 33 + (lane & 31)] = W[(size_t)(k0 + kk) * ldw + n0 + (lane & 31)]; }
    LDS_WAIT(); asm volatile("" ::: "memory");
    const int c = lane & 7;
#pragma unroll
    for (int j = 0; j < 4; ++j) { const int n = (lane >> 3) + 8 * j; const LAS float* s = scr + (8 * c) * 33 + n;
        v4u o; o.x = pk2(s[0 * 33], s[1 * 33]); o.y = pk2(s[2 * 33], s[3 * 33]); o.z = pk2(s[4 * 33], s[5 * 33]); o.w = pk2(s[6 * 33], s[7 * 33]);
        *(GAS v4u*)(WT + (size_t)(drow0 + n) * ldt + k0 + 8 * c) = o; }
    LDS_WAIT(); asm volatile("" ::: "memory");
}
__device__ __forceinline__ bool conv_matrix(int& r, const float* W, int K, int N, bf16* WT, int mode, int roff, LAS float* scr, int lane) {
    const int nblk = N / 32, items = (K / 64) * nblk;
    if (r >= items) { r -= items; return false; }
    const int kb = r / nblk, nb = r % nblk, k0 = 64 * kb, n0 = 32 * nb;
    int drow0;
    if (mode == 0) drow0 = n0 + roff;
    else if (mode == 1) { if (n0 == 768) return true; drow0 = n0 < 768 ? n0 : n0 + 480; }
    else drow0 = (n0 >> 7) * 256 + (n0 & 127) + roff;
    transpose_item(W, N, k0, n0, WT, K, drow0, scr, lane);
    return true;
}

using pg8::Unit; using pg8::cvt_pk_bf16;
typedef pg8::f32x4 accv;
#define EPI_ARGS const accv (&acc)[2][2][4][2], const Unit& u, int wr, int wc, int fr, int fq
__device__ __forceinline__ v4u pack8(f32x4 a, f32x4 b) { v4u w; w.x = cvt_pk_bf16(a[0], a[1]); w.y = cvt_pk_bf16(a[2], a[3]); w.z = cvt_pk_bf16(b[0], b[1]); w.w = cvt_pk_bf16(b[2], b[3]); return w; }
__device__ __forceinline__ void unpack8(v4u w, f32x4& a, f32x4& b) { a = (f32x4){bflo(w.x), bfhi(w.x), bflo(w.y), bfhi(w.y)}; b = (f32x4){bflo(w.z), bfhi(w.z), bflo(w.w), bfhi(w.w)}; }

struct EpiInProj {
    bf16 *Kb, *Vb, *Ub, *Qb, *Rb, *GAb, *GMb; float *GF, *GB; const float *bias_f, *bias_b;
    __device__ __forceinline__ void operator()(EPI_ARGS) const {
        const int pn = u.pn, row0 = u.pm * 256 + wr * 64 + fr, cw = wc * 32 + 8 * fq;
        if (pn == 3 || pn == 4) {
            float* dst = pn == 3 ? GF : GB; const float* bias = pn == 3 ? bias_f : bias_b;
#pragma unroll
            for (int bj = 0; bj < 2; ++bj) { const int c = cw + bj * 128; const f32x4 b0 = *(const f32x4*)(bias + c), b1 = *(const f32x4*)(bias + c + 4);
#pragma unroll
                for (int ai = 0; ai < 2; ++ai)
#pragma unroll
                    for (int m = 0; m < 4; ++m) { float* p = dst + (size_t)(row0 + ai * 128 + m * 16) * 256 + c; f32x4 v0 = acc[ai][bj][m][0] + b0, v1 = acc[ai][bj][m][1] + b1;
#pragma unroll
                        for (int j = 0; j < 4; ++j) { v0[j] = logsigmoidf_(v0[j]) * 0.0625f; v1[j] = logsigmoidf_(v1[j]) * 0.0625f; }
                        *(f32x4*)p = v0; *(f32x4*)(p + 4) = v1; } }
            return;
        }
        bf16* dst; int ld, cb, act;
        if (pn == 0) { dst = Kb; ld = 256; cb = 0; act = 0; }
        else if (pn <= 2) { dst = Vb; ld = 512; cb = (pn - 1) * 256; act = 0; }
        else if (pn <= 6) { dst = Ub; ld = 512; cb = (pn - 5) * 256; act = 0; }
        else if (pn == 7) { dst = Qb; ld = 256; cb = 0; act = 1; }
        else if (pn <= 9) { dst = Rb; ld = 512; cb = (pn - 8) * 256; act = 2; }
        else if (pn <= 13) { dst = GAb; ld = 1024; cb = (pn - 10) * 256; act = 3; }
        else { dst = GMb; ld = 1024; cb = (pn - 14) * 256; act = 3; }
#pragma unroll
        for (int ai = 0; ai < 2; ++ai)
#pragma unroll
            for (int m = 0; m < 4; ++m) { bf16* rowp = dst + (size_t)(row0 + ai * 128 + m * 16) * ld + cb + cw;
#pragma unroll
                for (int bj = 0; bj < 2; ++bj) { f32x4 v0 = acc[ai][bj][m][0], v1 = acc[ai][bj][m][1];
                    if (act == 1) { v0 = v0 * 0.125f; v1 = v1 * 0.125f; }
                    else if (act == 2) {
#pragma unroll
                        for (int j = 0; j < 4; ++j) { v0[j] = siluf_(v0[j]); v1[j] = siluf_(v1[j]); } }
                    else if (act == 3) {
#pragma unroll
                        for (int j = 0; j < 4; ++j) { v0[j] = sigmoidf_(v0[j]); v1[j] = sigmoidf_(v1[j]); } }
                    *(v4u*)(rowp + bj * 128) = pack8(v0, v1); } }
    }
};
struct EpiD12 {
    const bf16* SG; bf16* S2; const float* bglu; const bf16* GA; bf16* T;
    __device__ __forceinline__ void operator()(EPI_ARGS) const {
        const int row0 = u.pm * 256 + wr * 64 + fr, c0 = u.pn * 256 + wc * 32 + 8 * fq;
#pragma unroll
        for (int ai = 0; ai < 2; ++ai)
#pragma unroll
            for (int m = 0; m < 4; ++m) { const size_t row = (size_t)(row0 + ai * 128 + m * 16);
#pragma unroll
                for (int bj = 0; bj < 2; ++bj) { const int c = c0 + bj * 128; f32x4 v0 = acc[ai][bj][m][0], v1 = acc[ai][bj][m][1], s0, s1;
                    if (u.kind == 0) { const f32x4 b0 = *(const f32x4*)(bglu + c), b1 = *(const f32x4*)(bglu + c + 4); unpack8(*(const v4u*)(SG + row * 512 + c), s0, s1);
#pragma unroll
                        for (int j = 0; j < 4; ++j) { v0[j] = s0[j] * sigmoidf_(v0[j] + b0[j]); v1[j] = s1[j] * sigmoidf_(v1[j] + b1[j]); }
                        *(v4u*)(S2 + row * 512 + c) = pack8(v0, v1); }
                    else { unpack8(*(const v4u*)(GA + row * 1024 + c), s0, s1); *(v4u*)(T + row * 1024 + c) = pack8(v0 * s0, v1 * s1); } } }
    }
};
struct EpiD3 {
    const bf16* T; const bf16* GM; bf16* MB;
    __device__ __forceinline__ void operator()(EPI_ARGS) const {
        const int row0 = u.pm * 256 + wr * 64 + fr, c0 = u.pn * 256 + wc * 32 + 8 * fq;
#pragma unroll
        for (int ai = 0; ai < 2; ++ai)
#pragma unroll
            for (int m = 0; m < 4; ++m) { const size_t row = (size_t)(row0 + ai * 128 + m * 16);
#pragma unroll
                for (int bj = 0; bj < 2; ++bj) { const int c = c0 + bj * 128; f32x4 t0, t1, g0, g1; unpack8(*(const v4u*)(T + row * 1024 + c), t0, t1); unpack8(*(const v4u*)(GM + row * 1024 + c), g0, g1);
                    *(v4u*)(MB + row * 1024 + c) = pack8(t0 + g0 * acc[ai][bj][m][0], t1 + g1 * acc[ai][bj][m][1]); } }
    }
};
struct EpiResid {
    const float* rl; const float* rc; float* out; const float* modv; int gidx;
    __device__ __forceinline__ void operator()(EPI_ARGS) const {
        const int row0 = u.pm * 256 + wr * 64 + fr, c0 = u.pn * 256 + wc * 32 + 8 * fq;
        const int bi = u.pm < NLAT / 256 ? (u.pm >> 4) : 4;
        const float* gp = modv + bi * 6144 + gidx * 1024;
#pragma unroll
        for (int bj = 0; bj < 2; ++bj) { const int c = c0 + bj * 128; const f32x4 g0 = *(const f32x4*)(gp + c), g1 = *(const f32x4*)(gp + c + 4);
#pragma unroll
            for (int ai = 0; ai < 2; ++ai)
#pragma unroll
                for (int m = 0; m < 4; ++m) { const int row = row0 + ai * 128 + m * 16;
                    const float* rp = (row < NLAT ? rl + (size_t)row * 1024 : rc + (size_t)(row - NLAT) * 1024) + c; float* op = out + (size_t)row * 1024 + c;
                    const f32x4 r0 = *(const f32x4*)rp, r1 = *(const f32x4*)(rp + 4);
                    *(f32x4*)op = r0 + g0 * acc[ai][bj][m][0]; *(f32x4*)(op + 4) = r1 + g1 * acc[ai][bj][m][1]; } }
    }
};
struct EpiSwiglu {
    bf16* H; int ld; int pmoff;
    __device__ __forceinline__ void operator()(EPI_ARGS) const {
        const int row0 = (u.pm - pmoff) * 256 + wr * 64 + fr, c = u.pn * 128 + wc * 32 + 8 * fq;
#pragma unroll
        for (int ai = 0; ai < 2; ++ai)
#pragma unroll
            for (int m = 0; m < 4; ++m) { f32x4 g0 = acc[ai][0][m][0], g1 = acc[ai][0][m][1]; const f32x4 u0 = acc[ai][1][m][0], u1 = acc[ai][1][m][1];
#pragma unroll
                for (int j = 0; j < 4; ++j) { g0[j] = siluf_(g0[j]) * u0[j]; g1[j] = siluf_(g1[j]) * u1[j]; }
                *(v4u*)(H + (size_t)(row0 + ai * 128 + m * 16) * ld + c) = pack8(g0, g1); }
    }
};
struct EpiPlain {
    bf16* Y;
    __device__ __forceinline__ void operator()(EPI_ARGS) const {
        const int row0 = u.pm * 256 + wr * 64 + fr, c0 = u.pn * 256 + wc * 32 + 8 * fq;
#pragma unroll
        for (int ai = 0; ai < 2; ++ai)
#pragma unroll
            for (int m = 0; m < 4; ++m)
#pragma unroll
                for (int bj = 0; bj < 2; ++bj) *(v4u*)(Y + (size_t)(row0 + ai * 128 + m * 16) * 1024 + c0 + bj * 128) = pack8(acc[ai][bj][m][0], acc[ai][bj][m][1]);
    }
};

#define PHASE_BEGIN() int tid_ = threadIdx.x; asm volatile("" : "+v"(tid_)); unsigned char* ws = args.ws; asm volatile("" : "+s"(ws)); \
    const int tid = tid_, lane = tid & 63, wave = __builtin_amdgcn_readfirstlane(tid >> 6), gw = vcu * NWAVES + wave; (void)lane; (void)gw; \
    const float* const* in = args.in; (void)in; gu32* ctl = (gu32*)(ws + WS_CTL); (void)ctl;
#define LATX ((float*)(ws + WS_LATX))
#define XN ((bf16*)(ws + WS_XN))
#define Kb ((bf16*)(ws + WS_IP + IP_K))
#define Vb ((bf16*)(ws + WS_IP + IP_V))
#define GF ((float*)(ws + WS_IP + IP_GF))
#define GB ((float*)(ws + WS_IP + IP_GB))
#define Ub ((bf16*)(ws + WS_IP + IP_U))
#define Qb ((bf16*)(ws + WS_IP + IP_Q))
#define Rb ((bf16*)(ws + WS_IP + IP_R))
#define GAb ((bf16*)(ws + WS_IP + IP_GA))
#define GMb ((bf16*)(ws + WS_IP + IP_GM))
#define Tb ((bf16*)(ws + WS_IP + IP_T))
#define S2 ((bf16*)(ws + WS_IP + IP_S2))
#define HMID ((bf16*)(ws + WS_IP + IP_HMID))
#define OG ((bf16*)(ws + WS_OG))
#define SG ((bf16*)(ws + WS_SG))
#define O32 ((float*)(ws + WS_O32))
#define Y32 ((float*)(ws + WS_Y32))
#define MODV ((float*)(ws + WS_TAB + T_MODV))
#define LAMB ((f32x2*)(ws + WS_TAB + T_LAMB))
#define BBAR ((f32x2*)(ws + WS_TAB + T_BBAR))
#define BMT ((bf16*)(ws + WS_TAB + T_BMT))
#define CMT ((bf16*)(ws + WS_TAB + T_CMT))
#define S5F ((f32x2*)(ws + WS_S5F))
#define S5H ((f32x2*)(ws + WS_S5H))
#define TOKE ((int4*)(ws + WS_TAB + T_TOKE))
#define TOKW ((f32x2*)(ws + WS_TAB + T_TOKW))
#define TOKS ((int2*)(ws + WS_TAB + T_TOKS))
#define wb (ws + WS_W)
#define WMGU ((bf16*)(ws + WS_WM + WM_GU))
#define WMD ((bf16*)(ws + WS_WM + WM_D))
#define XG ((bf16*)(ws + WS_XG))
#define HM ((bf16*)(ws + WS_HM))
#define YS ((bf16*)(ws + WS_YS))


typedef float f32x16 __attribute__((ext_vector_type(16)));
#define MFMA32(a, b, c) __builtin_amdgcn_mfma_f32_32x32x16_bf16((a), (b), (c), 0, 0, 0)
#define MFMA16(a, b, c) __builtin_amdgcn_mfma_f32_16x16x32_bf16((a), (b), (c), 0, 0, 0)
__device__ __forceinline__ void cmul(float& ar, float& ai, float br, float bi) { const float r = ar * br - ai * bi, i = ar * bi + ai * br; ar = r; ai = i; }
template <int DIR> __device__ __forceinline__ void s5_scan(f32x16 (&tre)[2], f32x16 (&tim)[2], const float lr, const float li, float& sr, float& si) {
#pragma unroll
    for (int q = 0; q < 32; ++q) { const int idx = DIR ? 31 - q : q, mt = idx >> 4, i = idx & 15;
        const float nr = lr * sr - li * si + tre[mt][i], ni = lr * si + li * sr + tim[mt][i]; sr = nr; si = ni; tre[mt][i] = sr; tim[mt][i] = si; }
}
template <int DIR> __device__ __forceinline__ void s5_fix(f32x16 (&tre)[2], f32x16 (&tim)[2], const float lr, const float li, const float xr, const float xi) {
    float fr = lr, fi = li;
#pragma unroll
    for (int q = 0; q < 32; ++q) { const int idx = DIR ? 31 - q : q, mt = idx >> 4, i = idx & 15;
        tre[mt][i] += fr * xr - fi * xi; tim[mt][i] += fr * xi + fi * xr; cmul(fr, fi, lr, li); }
}
__device__ __forceinline__ void ts_rows(int b, int ts, int& rb, int& rs) { if (ts < 4) { rb = NLAT + b * CTXL + 64 * ts; rs = 1; } else { rb = b * SEQ + (ts - 4); rs = 64; } }
__device__ __forceinline__ int chain_pos(int dir, int ts) { return dir == 0 ? ts : (ts < 4 ? 3 - ts : 71 - ts); }

template <int MODE> __device__ __forceinline__ void s5_unit(unsigned char* ws, const float* const* in, LAS unsigned char* hbuf_raw, const int l, const int b, const int ts, const int g, const int lane) {
    const int r = lane & 31, hh = lane >> 5;
    int rb, rs; ts_rows(b, ts, rb, rs);
    bf16x8 ua[2];
#pragma unroll
    for (int mt = 0; mt < 2; ++mt) { const int tokA = 32 * ((r >> 2) & 1) + 16 * mt + (r & 3) + 4 * (r >> 3);
        ua[mt] = *(const bf16x8*)(Ub + (size_t)(rb + tokA * rs) * 512 + 16 * g + 8 * hh); }
    f32x4 yacc[4];
#pragma unroll
    for (int i = 0; i < 4; ++i) yacc[i] = (f32x4){0.f, 0.f, 0.f, 0.f};
    LAS unsigned* hbuf = (LAS unsigned*)hbuf_raw;
#pragma unroll
    for (int dir = 0; dir < 2; ++dir) {
        const int cpos = chain_pos(dir, ts);
#pragma unroll
        for (int ph = 0; ph < 2; ++ph) {
            const bf16* bm = BMT + ((size_t)((((l * 2 + dir) * 32 + g) * 2 + ph) * 2)) * 512 + r * 16 + 8 * hh;
            const bf16x8 bre = *(const bf16x8*)bm, bim = *(const bf16x8*)(bm + 512);
            f32x16 tre[2], tim[2];
#pragma unroll
            for (int mt = 0; mt < 2; ++mt) { f32x16 z;
#pragma unroll
                for (int i = 0; i < 16; ++i) z[i] = 0.f;
                tre[mt] = MFMA32(ua[mt], bre, z); tim[mt] = MFMA32(ua[mt], bim, z); }
            const int p = 32 * ph + r;
            const f32x2 lam = LAMB[((l * 2 + dir) * 32 + g) * 64 + p];
            const size_t fidx = ((size_t)((dir * 4 + b) * 32 + g) * 68 + cpos) * 64 + p;
            const bool first = (hh == dir);
            float sr = 0.f, si = 0.f;
            if (MODE == 1) { const f32x2 h0 = S5H[fidx]; if (first) { sr = h0[0]; si = h0[1]; } }
            if (dir == 0) s5_scan<0>(tre, tim, lam[0], lam[1], sr, si); else s5_scan<1>(tre, tim, lam[0], lam[1], sr, si);
            const float orr = __shfl_xor(sr, 32), oi = __shfl_xor(si, 32);
            if (MODE == 0) {
                float l32r = lam[0], l32i = lam[1];
#pragma unroll
                for (int q = 0; q < 5; ++q) cmul(l32r, l32i, l32r, l32i);
                const float fr_ = first ? sr : orr, fi_ = first ? si : oi, sr_ = first ? orr : sr, si_ = first ? oi : si;
                const f32x2 fv = (f32x2){l32r * fr_ - l32i * fi_ + sr_, l32r * fi_ + l32i * fr_ + si_};
                asm volatile("s_waitcnt lgkmcnt(0)" ::: "memory");
                if (hh == 0) S5F[fidx] = fv;
            } else {
                const float xr = first ? 0.f : orr, xi = first ? 0.f : oi;
                if (dir == 0) s5_fix<0>(tre, tim, lam[0], lam[1], xr, xi); else s5_fix<1>(tre, tim, lam[0], lam[1], xr, xi);
#pragma unroll
                for (int mt = 0; mt < 2; ++mt)
#pragma unroll
                    for (int i = 0; i < 16; ++i) hbuf[(32 * hh + 16 * mt + i) * 36 + r] = cvt_pk_bf16(tre[mt][i], tim[mt][i]);
                LDS_WAIT();
#pragma unroll
                for (int ks = 0; ks < 2; ++ks) {
                    const bf16x8 cb = *(const bf16x8*)(CMT + ((size_t)((l * 32 + g) * 16 + (lane & 15)) * 2 + ph) * 64 + 32 * ks + 8 * (lane >> 4));
#pragma unroll
                    for (int m4 = 0; m4 < 4; ++m4) { const bf16x8 ha = *(const LAS bf16x8*)(hbuf + (16 * m4 + (lane & 15)) * 36 + 16 * ks + 4 * (lane >> 4)); yacc[m4] = MFMA16(ha, cb, yacc[m4]); }
                }
                LDS_WAIT();
            }
        }
    }
    if (MODE == 1) {
        const int hc = lane & 15; const float dsk = in[I_S5D][l * 512 + 16 * g + hc];
#pragma unroll
        for (int m4 = 0; m4 < 4; ++m4)
#pragma unroll
            for (int i = 0; i < 4; ++i) { const int tok = 16 * m4 + 4 * (lane >> 4) + i; const size_t o = (size_t)(rb + tok * rs) * 512 + 16 * g + hc;
                SG[o] = (bf16)f2bf(geluf_(yacc[m4][i] + dsk * bf2f(Ub[o]))); }
    }
}

constexpr int NPH = 29;

__global__ void __launch_bounds__(NWAVES * 64, 2) fwd_kernel(Args args) {
    extern __shared__ __attribute__((aligned(16))) unsigned char lds_raw[];
    LAS unsigned char* lds = (LAS unsigned char*)lds_raw;
    volatile LAS unsigned* MISC = (volatile LAS unsigned*)(lds + MISC_OFF);
    const int G = gridDim.x; const int bx = blockIdx.x; const int vcu = (G % 8 == 0) ? (bx % 8) * (G / 8) + bx / 8 : bx;
    const int NGW = G * NWAVES;
    for (int i = threadIdx.x; i < (LDS_BYTES - LDSCTL_OFF) / 4; i += NWAVES * 64) ((LAS unsigned*)(lds + LDSCTL_OFF))[i] = 0u;
    __syncthreads();
    XcdBarrier bar; bar.bar = (unsigned*)(args.ws + WS_CTL) + CW_BAR; bar.x = 0; bar.st = nullptr;
    if (MK_ONE_LAUNCH) bar = xcd_barrier_post((unsigned*)(args.ws + WS_CTL) + CW_BAR, MISC + 8);
    const int lo = args.ph_lo, hi = args.ph_hi;
#define IN(k) (lo <= (k) && (k) < hi)
#define SEAM(k) do { if (lo <= (k) && (k) + 1 < hi) xcd_barrier(bar); } while (0)

    if (IN(0)) { PHASE_BEGIN();
        {
            LAS float* sil = (LAS float*)(lds + 73728);
            LAS float* red = (LAS float*)(lds + 73728 + 20480);
            for (int i = tid; i < 5 * 1024; i += 512) { const int bi = i >> 10, k = i & 1023; const float v = bi < 4 ? in[I_C][bi * 1024 + k] : in[I_CCTX][k]; sil[i] = siluf_(v); }
            __syncthreads();
            for (int it = vcu; it < 2 * 96; it += G) {
                const int l = it / 96, n0 = (it % 96) * 64, kk = lane >> 4, q = lane & 15;
                f32x4 a[5];
#pragma unroll
                for (int bi = 0; bi < 5; ++bi) a[bi] = (f32x4){0.f, 0.f, 0.f, 0.f};
                const float* wp = in[I_WMOD] + (size_t)l * 1024 * 6144 + n0 + 4 * q;
#pragma unroll 4
                for (int i2 = 0; i2 < 32; ++i2) { const int k = wave * 128 + i2 * 4 + kk; const f32x4 w = *(const f32x4*)(wp + (size_t)k * 6144);
#pragma unroll
                    for (int bi = 0; bi < 5; ++bi) a[bi] = a[bi] + w * sil[bi * 1024 + k]; }
#pragma unroll
                for (int bi = 0; bi < 5; ++bi)
#pragma unroll
                    for (int j = 0; j < 4; ++j) { float v = a[bi][j]; v += __shfl_xor(v, 16); v += __shfl_xor(v, 32); a[bi][j] = v; }
                if (lane < 16) {
#pragma unroll
                    for (int bi = 0; bi < 5; ++bi)
#pragma unroll
                        for (int j = 0; j < 4; ++j) red[(wave * 5 + bi) * 64 + 4 * q + j] = a[bi][j]; }
                __syncthreads();
                if (tid < 320) { const int bi = tid >> 6, cc = tid & 63; float s = 0.f;
#pragma unroll
                    for (int w = 0; w < 8; ++w) s += red[(w * 5 + bi) * 64 + cc];
                    MODV[(l * 5 + bi) * 6144 + n0 + cc] = s + in[I_BMOD][l * 6144 + n0 + cc]; }
                __syncthreads();
            }
        }
        for (int i = gw * 64 + lane; i < 2 * 2 * 32 * 64; i += NGW * 64) {
            const int p = i & 63, g = (i >> 6) & 31, dir = (i >> 11) & 1, l = i >> 12;
            const float* are = in[dir ? I_AREB : I_AREF]; const float* aim = in[dir ? I_AIMB : I_AIMF]; const float* ldt = in[dir ? I_LDTB : I_LDTF];
            const double ar = are[(l * 32 + g) * 64 + p], ai = aim[(l * 32 + g) * 64 + p], dt = exp((double)ldt[l * 32 + g]);
            const double mag = exp(ar * dt), lr = mag * cos(ai * dt), li = mag * sin(ai * dt);
            LAMB[i] = (f32x2){(float)lr, (float)li};
            const double nr = lr - 1.0, ni = li, den = ar * ar + ai * ai, cr = (nr * ar + ni * ai) / den, ci = (ni * ar - nr * ai) / den;
            const float* bre = in[I_BRE] + ((size_t)(l * 32 + g) * 64 + p) * 16; const float* bim = in[I_BIM] + ((size_t)(l * 32 + g) * 64 + p) * 16;
            bf16* bm = BMT + ((size_t)(((l * 2 + dir) * 32 + g) * 2 + (p >> 5)) * 2) * 512 + (p & 31) * 16;
            for (int j = 0; j < 16; ++j) { const double br = bre[j], bi2 = bim[j]; const float vr = (float)(cr * br - ci * bi2), vi = (float)(cr * bi2 + ci * br);
                BBAR[(size_t)i * 16 + j] = (f32x2){vr, vi}; bm[j] = (bf16)f2bf(vr); bm[512 + j] = (bf16)f2bf(vi); }
        }
        for (int i = gw * 64 + lane; i < 2 * 32 * 16 * 2 * 64; i += NGW * 64) {
            const int k = i & 63, ph = (i >> 6) & 1, hh = (i >> 7) & 15, g = (i >> 11) & 31, l = i >> 16, p = 32 * ph + (k >> 1);
            const size_t ci = ((size_t)(l * 32 + g) * 16 + hh) * 64 + p;
            CMT[i] = (bf16)f2bf((k & 1) ? -in[I_CIM][ci] : in[I_CRE][ci]);
        }
        for (int i = gw * 64 + lane; i < 2 * 2 * 256 * 128; i += NGW * 64) {
            const int kc = i & 127, n = (i >> 7) & 255, dir = (i >> 15) & 1, l = i >> 16;
            const float* lr = in[dir ? I_LRB : I_LRF] + (size_t)l * 16 * 256 + n; float lrv[16];
#pragma unroll
            for (int j = 0; j < 16; ++j) lrv[j] = lr[j * 256];
            float o[8];
#pragma unroll
            for (int kk = 0; kk < 8; ++kk) { const float* wr_ = in[I_WIN] + ((size_t)l * 1024 + kc * 8 + kk) * INW_SRC + 768 + 16 * dir; float s = 0.f;
#pragma unroll
                for (int j4 = 0; j4 < 4; ++j4) { const f32x4 w = *(const f32x4*)(wr_ + 4 * j4); s += w[0] * lrv[4 * j4] + w[1] * lrv[4 * j4 + 1] + w[2] * lrv[4 * j4 + 2] + w[3] * lrv[4 * j4 + 3]; }
                o[kk] = s; }
            v4u w; w.x = pk2(o[0], o[1]); w.y = pk2(o[2], o[3]); w.z = pk2(o[4], o[5]); w.w = pk2(o[6], o[7]);
            *(v4u*)((bf16*)(wb + W_IN) + ((size_t)l * INW + 768 + 256 * dir + n) * 1024 + kc * 8) = w;
        }
        {
            LAS float* scr = (LAS float*)(lds + wave * 9216);
            constexpr int IT_IN = 16 * 129, IT_GLU = 8 * 16, IT_P = 8 * 32, IT_OUT = 16 * 32, IT_F = 16 * 88, IT_FD = 44 * 32;
            constexpr int IT_L = IT_IN + IT_GLU + 2 * IT_P + IT_OUT, NIT = 2 * IT_L + 2 * IT_F + IT_FD;
            for (int it = gw; it < NIT; it += NGW) {
                int r = it;
                if (r < 2 * IT_L) { const int l = r / IT_L; r -= l * IT_L;
                    if (conv_matrix(r, in[I_WIN] + (size_t)l * 1024 * INW_SRC, 1024, INW_SRC, (bf16*)(wb + W_IN) + (size_t)l * INW * 1024, 1, 0, scr, lane)) continue;
                    if (conv_matrix(r, in[I_WGLU] + (size_t)l * 512 * 512, 512, 512, (bf16*)(wb + W_GLU) + (size_t)l * 512 * 512, 0, 0, scr, lane)) continue;
                    if (conv_matrix(r, in[I_WGP] + (size_t)l * 512 * 1024, 512, 1024, (bf16*)(wb + W_GP) + (size_t)l * 1024 * 512, 0, 0, scr, lane)) continue;
                    if (conv_matrix(r, in[I_WSP] + (size_t)l * 512 * 1024, 512, 1024, (bf16*)(wb + W_SP) + (size_t)l * 1024 * 512, 0, 0, scr, lane)) continue;
                    conv_matrix(r, in[I_WOUT] + (size_t)l * 1024 * 1024, 1024, 1024, (bf16*)(wb + W_OUT) + (size_t)l * 1024 * 1024, 0, 0, scr, lane); continue; }
                r -= 2 * IT_L;
                if (conv_matrix(r, in[I_FG], 1024, FFD, (bf16*)(wb + W_FGU), 2, 0, scr, lane)) continue;
                if (conv_matrix(r, in[I_FU], 1024, FFD, (bf16*)(wb + W_FGU), 2, 128, scr, lane)) continue;
                conv_matrix(r, in[I_FD], FFD, 1024, (bf16*)(wb + W_FD), 0, 0, scr, lane);
            }
        }
    }
    SEAM(0);

    for (int l = 0; l < 2; ++l) {
        const int pb = 1 + 11 * l;
#define MODVL (MODV + (size_t)l * 5 * 6144)
#define RES_L (l == 0 ? in[I_X] : (const float*)LATX)
#define RES_C (l == 0 ? in[I_CTX] : (const float*)(LATX + (size_t)NLAT * 1024))
        const int nrows = NROW;
        const int mpan = l == 0 ? NPAN : NLAT / 256;
        if (IN(pb + 0)) { PHASE_BEGIN();
            const float* nw = in[I_N1W] + l * 1024;
            for (int row = gw; row < nrows; row += NGW) {
                const float* xr = row < NLAT ? RES_L + (size_t)row * 1024 : RES_C + (size_t)(row - NLAT) * 1024;
                const int bi = row < NLAT ? row >> 12 : 4; const float* sh = MODVL + bi * 6144; const float* sc = sh + 1024;
                f32x4 v[4]; float ss = 0.f;
#pragma unroll
                for (int j = 0; j < 4; ++j) { v[j] = *(const f32x4*)(xr + 4 * lane + 256 * j); ss += v[j][0] * v[j][0] + v[j][1] * v[j][1] + v[j][2] * v[j][2] + v[j][3] * v[j][3]; }
                const float rstd = rsqrtf(wave_sum(ss) * (1.f / 1024.f) + EPS);
#pragma unroll
                for (int j = 0; j < 4; ++j) { const int c = 4 * lane + 256 * j; const f32x4 w = *(const f32x4*)(nw + c), s1 = *(const f32x4*)(sc + c), s0 = *(const f32x4*)(sh + c);
                    f32x4 y;
#pragma unroll
                    for (int e = 0; e < 4; ++e) y[e] = v[j][e] * rstd * w[e] * (1.f + s1[e]) + s0[e];
                    v2u o; o.x = pk2(y[0], y[1]); o.y = pk2(y[2], y[3]); *(v2u*)(XN + (size_t)row * 1024 + c) = o; }
            }
        }
        SEAM(pb + 0);
        if (IN(pb + 1)) { PHASE_BEGIN();
            pg8::Order S; S.init1(G, bx, XN, (bf16*)(wb + W_IN) + (size_t)l * INW * 1024, NPAN, 18, 1024);
            EpiInProj E{Kb, Vb, Ub, Qb, Rb, GAb, GMb, GF, GB, in[I_BIASF] + l * 256, in[I_BIASB] + l * 256};
            pg8::gemm_phase<EpiInProj, pg8::Order>(lds + RING_OFF, tid, 1024, S, E);
        }
        SEAM(pb + 1);
        if (IN(pb + 2)) { PHASE_BEGIN();
            for (int wu = gw; wu < 4 * 68 * 32; wu += NGW) {
                const int g = wu & 31, ts = (wu >> 5) % 68, b = (wu >> 5) / 68;
                s5_unit<0>(ws, in, lds + wave * 9216, l, b, ts, g, lane);
            }
        }
        SEAM(pb + 2);
        if (IN(pb + 3)) { PHASE_BEGIN();
            for (int i = gw * 64 + lane; i < 2 * 4 * 32 * 64; i += NGW * 64) {
                const int p = i & 63, g = (i >> 6) & 31, dir = i >> 13;
                const f32x2 lam = LAMB[((l * 2 + dir) * 32 + g) * 64 + p];
                float ar = lam[0], ai = lam[1];
#pragma unroll
                for (int q = 0; q < 6; ++q) cmul(ar, ai, ar, ai);
                const f32x2* f = S5F + (size_t)(i >> 6) * 68 * 64 + p; f32x2* fo = S5H + (size_t)(i >> 6) * 68 * 64 + p;
                float hr = 0.f, hi_ = 0.f;
                for (int c = 0; c < 68; ++c) { const f32x2 t = f[c * 64]; fo[c * 64] = (f32x2){hr, hi_}; const float nr = ar * hr - ai * hi_ + t[0], ni = ar * hi_ + ai * hr + t[1]; hr = nr; hi_ = ni; }
            }
        }
        SEAM(pb + 3);
        if (IN(pb + 4)) { PHASE_BEGIN();
            if (vcu < 16) {
                const int b = vcu >> 2, h = vcu & 3, e = tid >> 2, dq = tid & 3;
                for (int dir = 0; dir < 2; ++dir) {
                    float S[16];
#pragma unroll
                    for (int i = 0; i < 16; ++i) S[i] = 0.f;
                    const float* Gp = dir ? GB : GF;
                    for (int t = 0; t < CTXL + SEQ; ++t) {
                        int row;
                        if (dir == 0) row = t < CTXL ? NLAT + b * CTXL + t : b * SEQ + (t - CTXL);
                        else row = t < CTXL ? NLAT + b * CTXL + (CTXL - 1 - t) : b * SEQ + (SEQ - 1 - (t - CTXL));
                        const v4u k0 = *(const v4u*)(Kb + (size_t)row * 256 + h * 64 + 16 * dq), k1 = *(const v4u*)(Kb + (size_t)row * 256 + h * 64 + 16 * dq + 8);
                        const v4u q0 = *(const v4u*)(Qb + (size_t)row * 256 + h * 64 + 16 * dq), q1 = *(const v4u*)(Qb + (size_t)row * 256 + h * 64 + 16 * dq + 8);
                        f32x4 ka, kb2, kc, kd, qa, qb2, qc, qd; unpack8(k0, ka, kb2); unpack8(k1, kc, kd); unpack8(q0, qa, qb2); unpack8(q1, qc, qd);
                        const float* gp = Gp + (size_t)row * 256 + h * 64 + 16 * dq;
                        const f32x4 g0 = *(const f32x4*)gp, g1 = *(const f32x4*)(gp + 4), g2 = *(const f32x4*)(gp + 8), g3 = *(const f32x4*)(gp + 12);
                        const float v = bf2f(Vb[(size_t)row * 512 + h * 128 + e]);
                        float kk[16] = {ka[0], ka[1], ka[2], ka[3], kb2[0], kb2[1], kb2[2], kb2[3], kc[0], kc[1], kc[2], kc[3], kd[0], kd[1], kd[2], kd[3]};
                        float qq[16] = {qa[0], qa[1], qa[2], qa[3], qb2[0], qb2[1], qb2[2], qb2[3], qc[0], qc[1], qc[2], qc[3], qd[0], qd[1], qd[2], qd[3]};
                        float gg[16] = {g0[0], g0[1], g0[2], g0[3], g1[0], g1[1], g1[2], g1[3], g2[0], g2[1], g2[2], g2[3], g3[0], g3[1], g3[2], g3[3]};
                        float o = 0.f;
#pragma unroll
                        for (int i = 0; i < 16; ++i) { S[i] = __expf(gg[i]) * S[i] + kk[i] * v; o += qq[i] * S[i]; }
                        o += __shfl_xor(o, 1); o += __shfl_xor(o, 2);
                        if (dq == 0) { float* op = O32 + (size_t)row * 512 + h * 128 + e; *op = dir ? *op + o : o; }
                    }
                }
                __builtin_amdgcn_fence(__ATOMIC_RELEASE, "agent"); VM_WAIT(); __syncthreads(); __builtin_amdgcn_fence(__ATOMIC_ACQUIRE, ""); VM_WAIT();
                const float* gnw = in[I_GNW] + l * 128;
                for (int i = wave; i < CTXL + SEQ; i += NWAVES) {
                    const int row = i < SEQ ? b * SEQ + i : NLAT + b * CTXL + (i - SEQ);
                    const f32x2 o = *(const f32x2*)(O32 + (size_t)row * 512 + h * 128 + 2 * lane);
                    const float rstd = rsqrtf(wave_sum(o[0] * o[0] + o[1] * o[1]) * (1.f / 128.f) + EPS);
                    const unsigned rr = *(const unsigned*)(Rb + (size_t)row * 512 + h * 128 + 2 * lane);
                    *(unsigned*)(OG + (size_t)row * 512 + h * 128 + 2 * lane) = pk2(o[0] * rstd * gnw[2 * lane] * bflo(rr), o[1] * rstd * gnw[2 * lane + 1] * bfhi(rr));
                }
            } else {
                const int skip = l == 1 ? 4 : 0, nts = 68 - skip;
                for (int wu = vcu - 16; wu < 4 * nts * 4; wu += G - 16) {
                    const int g = 8 * (wu & 3) + wave, ts = skip + (wu >> 2) % nts, b = (wu >> 2) / nts;
                    s5_unit<1>(ws, in, lds + wave * 9216, l, b, ts, g, lane);
                }
            }
        }
        SEAM(pb + 4);
        if (IN(pb + 5)) { PHASE_BEGIN();
            pg8::Order S; S.init1(G, bx, SG, (bf16*)(wb + W_GLU) + (size_t)l * 512 * 512, mpan, 2, 512);
            S.A1 = (const char*)OG; S.B1 = (const char*)((bf16*)(wb + W_GP) + (size_t)l * 1024 * 512); S.nM1 = mpan; S.nN1 = 4; S.kind1 = 1;
            EpiD12 E{SG, S2, in[I_BGLU] + l * 512, GAb, Tb};
            pg8::gemm_phase<EpiD12, pg8::Order>(lds + RING_OFF, tid, 512, S, E);
        }
        SEAM(pb + 5);
        if (IN(pb + 6)) { PHASE_BEGIN();
            pg8::Order S; S.init1(G, bx, S2, (bf16*)(wb + W_SP) + (size_t)l * 1024 * 512, mpan, 4, 512);
            EpiD3 E{Tb, GMb, XN};
            pg8::gemm_phase<EpiD3, pg8::Order>(lds + RING_OFF, tid, 512, S, E);
        }
        SEAM(pb + 6);
        if (IN(pb + 7)) { PHASE_BEGIN();
            pg8::Order S; S.init1(G, bx, XN, (bf16*)(wb + W_OUT) + (size_t)l * 1024 * 1024, mpan, 4, 1024);
            EpiResid E{RES_L, RES_C, LATX, MODVL, 2};
            pg8::gemm_phase<EpiResid, pg8::Order>(lds + RING_OFF, tid, 1024, S, E);
        }
        SEAM(pb + 7);
        if (IN(pb + 8)) { PHASE_BEGIN();
            const float* nw = in[I_N2W] + l * 1024;
            LAS float* rw = (LAS float*)(lds);
            if (l == 1) { for (int i = tid; i < 8192; i += 512) rw[i] = in[I_ROUTER][i]; __syncthreads(); }
            const int nr2 = l == 0 ? NROW : NLAT;
            for (int row = gw; row < nr2; row += NGW) {
                const float* xr = LATX + (size_t)row * 1024;
                const int bi = row < NLAT ? row >> 12 : 4; const float* sh = MODVL + bi * 6144 + 3 * 1024; const float* sc = sh + 1024;
                f32x4 v[4]; float ss = 0.f;
#pragma unroll
                for (int j = 0; j < 4; ++j) { v[j] = *(const f32x4*)(xr + 4 * lane + 256 * j); ss += v[j][0] * v[j][0] + v[j][1] * v[j][1] + v[j][2] * v[j][2] + v[j][3] * v[j][3]; }
                const float rstd = rsqrtf(wave_sum(ss) * (1.f / 1024.f) + EPS);
                float lg[8];
#pragma unroll
                for (int e = 0; e < 8; ++e) lg[e] = 0.f;
#pragma unroll
                for (int j = 0; j < 4; ++j) { const int c = 4 * lane + 256 * j; const f32x4 w = *(const f32x4*)(nw + c), s1 = *(const f32x4*)(sc + c), s0 = *(const f32x4*)(sh + c);
                    f32x4 y;
#pragma unroll
                    for (int e = 0; e < 4; ++e) y[e] = v[j][e] * rstd * w[e] * (1.f + s1[e]) + s0[e];
                    if (l == 0) { v2u o; o.x = pk2(y[0], y[1]); o.y = pk2(y[2], y[3]); *(v2u*)(XN + (size_t)row * 1024 + c) = o; }
                    else {
#pragma unroll
                        for (int e = 0; e < 4; ++e) { const f32x4 r0 = *(const LAS f32x4*)(rw + (c + e) * 8), r1 = *(const LAS f32x4*)(rw + (c + e) * 8 + 4);
                            lg[0] += y[e] * r0[0]; lg[1] += y[e] * r0[1]; lg[2] += y[e] * r0[2]; lg[3] += y[e] * r0[3]; lg[4] += y[e] * r1[0]; lg[5] += y[e] * r1[1]; lg[6] += y[e] * r1[2]; lg[7] += y[e] * r1[3]; } } }
                if (l == 1) {
#pragma unroll
                    for (int e = 0; e < 8; ++e) lg[e] = wave_sum(lg[e]);
                    int e1 = 0; float v1 = lg[0];
#pragma unroll
                    for (int e = 1; e < 8; ++e) if (lg[e] > v1) { v1 = lg[e]; e1 = e; }
                    int e2 = -1; float v2 = -3.0e38f;
#pragma unroll
                    for (int e = 0; e < 8; ++e) if (e != e1 && lg[e] > v2) { v2 = lg[e]; e2 = e; }
                    if (lane == 0) {
                        const float w1 = 1.f / (1.f + __expf(v2 - v1));
                        const int p1 = (int)__hip_atomic_fetch_add(ctl + CW_CNT + 64 * e1, 1u, RLX_AGENT), p2 = (int)__hip_atomic_fetch_add(ctl + CW_CNT + 64 * e2, 1u, RLX_AGENT);
                        TOKE[row] = make_int4(e1, p1, e2, p2); TOKW[row] = (f32x2){w1, 1.f - w1};
                    }
                }
            }
        }
        SEAM(pb + 8);
        if (l == 0) {
            if (IN(10)) { PHASE_BEGIN();
                pg8::Order S; S.init1(G, bx, XN, (bf16*)(wb + W_FGU), NPAN, 22, 1024);
                EpiSwiglu E{HMID, FFD, 0};
                pg8::gemm_phase<EpiSwiglu, pg8::Order>(lds + RING_OFF, tid, 1024, S, E);
            }
            SEAM(10);
            if (IN(11)) { PHASE_BEGIN();
                pg8::Order S; S.init1(G, bx, HMID, (bf16*)(wb + W_FD), NPAN, 4, FFD);
                EpiResid E{LATX, LATX + (size_t)NLAT * 1024, LATX, MODVL, 5};
                pg8::gemm_phase<EpiResid, pg8::Order>(lds + RING_OFF, tid, FFD, S, E);
            }
            SEAM(11);
        }
    }

    int pbase[9];
    {
        int a = 0;
#pragma unroll
        for (int e = 0; e < 8; ++e) { pbase[e] = a; const unsigned c = hi > 21 ? __hip_atomic_load((gu32*)(args.ws + WS_CTL) + CW_CNT + 64 * e, RLX_AGENT) : 0u; a += (int)((c + 255u) >> 8); }
        pbase[8] = a;
    }
    if (IN(21)) { PHASE_BEGIN();
        {
            LAS float* scr = (LAS float*)(lds + wave * 9216);
            constexpr int IT_G = 16 * 112, IT_D = 56 * 32, IT_E = 2 * IT_G + IT_D;
            for (int it = gw; it < 8 * IT_E; it += NGW) {
                const int e = it / IT_E; int r = it - e * IT_E;
                if (conv_matrix(r, in[I_MG] + (size_t)e * 1024 * FFE, 1024, FFE, WMGU + (size_t)e * 7168 * 1024, 2, 0, scr, lane)) continue;
                if (conv_matrix(r, in[I_MU] + (size_t)e * 1024 * FFE, 1024, FFE, WMGU + (size_t)e * 7168 * 1024, 2, 128, scr, lane)) continue;
                conv_matrix(r, in[I_MD] + (size_t)e * FFE * 1024, FFE, 1024, WMD + (size_t)e * 1024 * FFE, 0, 0, scr, lane);
            }
        }
        const float* modv = MODV + (size_t)5 * 6144; const float* nw = in[I_N2W] + 1024;
        for (int row = gw; row < NLAT; row += NGW) {
            const float* xr = LATX + (size_t)row * 1024;
            const int bi = row >> 12; const float* sh = modv + bi * 6144 + 3 * 1024; const float* sc = sh + 1024;
            f32x4 v[4]; float ss = 0.f;
#pragma unroll
            for (int j = 0; j < 4; ++j) { v[j] = *(const f32x4*)(xr + 4 * lane + 256 * j); ss += v[j][0] * v[j][0] + v[j][1] * v[j][1] + v[j][2] * v[j][2] + v[j][3] * v[j][3]; }
            const float rstd = rsqrtf(wave_sum(ss) * (1.f / 1024.f) + EPS);
            const int4 te = TOKE[row];
            int s1 = 0, s2 = 0;
#pragma unroll
            for (int e = 0; e < 8; ++e) { if (te.x == e) s1 = pbase[e] * 256 + te.y; if (te.z == e) s2 = pbase[e] * 256 + te.w; }
            if (lane == 0) TOKS[row] = make_int2(s1, s2);
#pragma unroll
            for (int j = 0; j < 4; ++j) { const int c = 4 * lane + 256 * j; const f32x4 w = *(const f32x4*)(nw + c), a1 = *(const f32x4*)(sc + c), a0 = *(const f32x4*)(sh + c);
                f32x4 y;
#pragma unroll
                for (int e = 0; e < 4; ++e) y[e] = v[j][e] * rstd * w[e] * (1.f + a1[e]) + a0[e];
                v2u o; o.x = pk2(y[0], y[1]); o.y = pk2(y[2], y[3]); *(v2u*)(XG + (size_t)s1 * 1024 + c) = o; *(v2u*)(XG + (size_t)s2 * 1024 + c) = o; }
        }
    }
    SEAM(21);
    for (int g = 0; g < 3; ++g) {
        const int p0 = 64 * g, np = pbase[8] - p0 < 64 ? (pbase[8] - p0 < 0 ? 0 : pbase[8] - p0) : 64;
        if (IN(22 + 2 * g)) { PHASE_BEGIN();
            pg8::Order S; S.init1(G, bx, XG, WMGU, np, 28, 1024);
            S.pm0 = p0; S.moe = 1; S.pb1 = pbase[1]; S.pb2 = pbase[2]; S.pb3 = pbase[3]; S.pb4 = pbase[4]; S.pb5 = pbase[5]; S.pb6 = pbase[6]; S.pb7 = pbase[7]; S.estride = (size_t)7168 * 1024 * 2;
            EpiSwiglu E{HM, FFE, p0};
            pg8::gemm_phase<EpiSwiglu, pg8::Order>(lds + RING_OFF, tid, 1024, S, E);
        }
        SEAM(22 + 2 * g);
        if (IN(23 + 2 * g)) { PHASE_BEGIN();
            pg8::Order S; S.init1(G, bx, HM, WMD, np, 4, FFE);
            S.pm0 = p0; S.apm0 = p0; S.moe = 1; S.pb1 = pbase[1]; S.pb2 = pbase[2]; S.pb3 = pbase[3]; S.pb4 = pbase[4]; S.pb5 = pbase[5]; S.pb6 = pbase[6]; S.pb7 = pbase[7]; S.estride = (size_t)1024 * FFE * 2;
            EpiPlain E{YS};
            pg8::gemm_phase<EpiPlain, pg8::Order>(lds + RING_OFF, tid, FFE, S, E);
        }
        SEAM(23 + 2 * g);
    }
    if (IN(28)) { PHASE_BEGIN();
        const float* modv = MODV + (size_t)5 * 6144; const float* fw = in[I_FNW];
        for (int row = gw; row < NLAT; row += NGW) {
            const float* xr = LATX + (size_t)row * 1024; const int bi = row >> 12; const float* g2 = modv + bi * 6144 + 5 * 1024;
            const int2 sl = TOKS[row]; const f32x2 tw = TOKW[row];
            f32x4 v[4]; float ss = 0.f;
#pragma unroll
            for (int j = 0; j < 4; ++j) { const int c = 4 * lane + 256 * j; const f32x4 x = *(const f32x4*)(xr + c), gg = *(const f32x4*)(g2 + c);
                const v2u y1 = *(const v2u*)(YS + (size_t)sl.x * 1024 + c), y2 = *(const v2u*)(YS + (size_t)sl.y * 1024 + c);
                const f32x4 a = (f32x4){bflo(y1.x), bfhi(y1.x), bflo(y1.y), bfhi(y1.y)}, bq = (f32x4){bflo(y2.x), bfhi(y2.x), bflo(y2.y), bfhi(y2.y)};
                v[j] = x + gg * (a * tw[0] + bq * tw[1]);
                ss += v[j][0] * v[j][0] + v[j][1] * v[j][1] + v[j][2] * v[j][2] + v[j][3] * v[j][3]; }
            const float rstd = rsqrtf(wave_sum(ss) * (1.f / 1024.f) + EPS);
#pragma unroll
            for (int j = 0; j < 4; ++j) { const int c = 4 * lane + 256 * j; const f32x4 w = *(const f32x4*)(fw + c); *(f32x4*)(args.out + (size_t)row * 1024 + c) = v[j] * rstd * w; }
        }
    }
#undef IN
#undef SEAM
}

extern "C" void kernel_launch(void* const* d_in, const int* in_sizes, int n_in, void* d_out, int out_size, void* d_ws, size_t ws_size, hipStream_t stream) {
    static int grid = 0;
    if (grid == 0) {
        if (n_in != N_IN || out_size != NLAT * D || ws_size < WS_END) { fprintf(stderr, "kernel_launch: unexpected shapes (n_in %d, out %d, ws %zu)\n", n_in, out_size, ws_size); grid = -1; return; }
        int dev = 0, cus = 0, per_cu = 0;
        if (hipGetDevice(&dev) != hipSuccess || hipDeviceGetAttribute(&cus, hipDeviceAttributeMultiprocessorCount, dev) != hipSuccess) { grid = -1; return; }
        if (hipFuncSetAttribute((const void*)fwd_kernel, hipFuncAttributeMaxDynamicSharedMemorySize, LDS_BYTES) != hipSuccess) { fprintf(stderr, "kernel_launch: hipFuncSetAttribute failed\n"); grid = -1; return; }
        if (hipOccupancyMaxActiveBlocksPerMultiprocessor(&per_cu, (const void*)fwd_kernel, NWAVES * 64, LDS_BYTES) != hipSuccess || per_cu < 1) fprintf(stderr, "kernel_launch: occupancy query reports %d\n", per_cu);
        (void)hipGetLastError();
        grid = cus;
    }
    if (grid < 0) return;
    if (hipMemsetAsync((char*)d_ws + WS_CTL, 0, CTL_ZERO_BYTES, stream) != hipSuccess) return;
    Args a{};
    for (int i = 0; i < N_IN; ++i) a.in[i] = (const float*)d_in[i];
    a.out = (float*)d_out; a.ws = (unsigned char*)d_ws;
#if MK_ONE_LAUNCH
    a.ph_lo = 0; a.ph_hi = NPH;
    hipLaunchKernelGGL(fwd_kernel, dim3(grid), dim3(NWAVES * 64), LDS_BYTES, stream, a);
#else
    for (int p = 0; p < NPH; ++p) { a.ph_lo = p; a.ph_hi = p + 1; hipLaunchKernelGGL(fwd_kernel, dim3(grid), dim3(NWAVES * 64), LDS_BYTES, stream, a); }
#endif
}
```

```cpp
#include <hip/hip_runtime.h>
#include <cstdio>
#include <cstdint>

#ifndef MK_ONE_LAUNCH
#define MK_ONE_LAUNCH 1
#endif

namespace pg8 {
#define PG8_LAS __attribute__((address_space(3)))
typedef unsigned short bf16_t;
typedef short bf16x8 __attribute__((ext_vector_type(8)));
typedef float f32x4 __attribute__((ext_vector_type(4)));
typedef unsigned u32x4 __attribute__((ext_vector_type(4)));
constexpr int BM = 256, BK = 64, HALF = 128, HTB = HALF * BK * 2, STAGE_BYTES = 8 * HTB, NXCD = 8, WGM = 8;

__host__ __device__ __forceinline__ int lds_byte(int r, int c) { const int st = (r >> 4) * 2 + (c >> 5), rr = r & 15, cc = c & 31, ob = rr * 64 + cc * 2; return st * 1024 + (ob ^ (((ob >> 9) & 1) << 5)); }
__host__ __device__ __forceinline__ void stage_rc(int b, int& R, int& C) { const int st = b / 1024, sb = b % 1024, swz = sb ^ (((sb >> 9) & 1) << 5); R = (st >> 1) * 16 + swz / 64; C = (st & 1) * 32 + (swz % 64) / 2; }
__host__ __device__ __forceinline__ int perm32(int rho) { const int n = rho >> 4, i = rho & 15; return 8 * (i >> 2) + 4 * n + (i & 3); }

struct Unit { int pm, pn, kind; const char* A; const char* B; };

struct Order {
    int G, c;
    int n0;
    const char* A0; const char* B0; int nM0, nN0, kind0;
    const char* A1; const char* B1; int nM1, nN1, kind1;
    size_t tstep;
    int pm0;
    int apm0;
    int moe; int pb1, pb2, pb3, pb4, pb5, pb6, pb7; size_t estride;
    __device__ __forceinline__ void init1(int G_, int c_, const void* A, const void* B, int nM, int nN, int K) {
        G = G_; c = c_; A0 = (const char*)A; B0 = (const char*)B; nM0 = nM; nN0 = nN; kind0 = 0; n0 = nM * nN; A1 = A0; B1 = B0; nM1 = 0; nN1 = 1; kind1 = 1;
        tstep = (size_t)256 * K * 2; pm0 = 0; apm0 = 0; moe = 0; pb1 = pb2 = pb3 = pb4 = pb5 = pb6 = pb7 = 0; estride = 0; }
    __device__ __forceinline__ bool next(int i, Unit& u) const {
        long L = (long)i * G + c; const bool s = L >= n0; if (s) L -= n0;
        const int nM = s ? nM1 : nM0, nN = s ? nN1 : nN0, nwg = nM * nN; if (L >= nwg) return false;
        int wgid = (int)L; { const int q = nwg / NXCD, r = nwg % NXCD, xcd = wgid % NXCD, off = wgid / NXCD; wgid = (xcd < r ? xcd * (q + 1) : r * (q + 1) + (xcd - r) * q) + off; }
        const int nig = WGM * nN, gid = wgid / nig, fm = gid * WGM, gsz = (nM - fm) < WGM ? (nM - fm) : WGM;
        const int pm = pm0 + fm + ((wgid % nig) % gsz), pn = (wgid % nig) / gsz;
        u.pm = pm; u.pn = pn; u.kind = s ? kind1 : kind0;
        u.A = (s ? A1 : A0) + (size_t)(pm - apm0) * tstep;
        const char* b = (s ? B1 : B0) + (size_t)pn * tstep;
        if (moe) { const int e = (pm >= pb1) + (pm >= pb2) + (pm >= pb3) + (pm >= pb4) + (pm >= pb5) + (pm >= pb6) + (pm >= pb7); b += (size_t)e * estride; }
        u.B = b; return true;
    }
    __device__ __forceinline__ void a_ready(const Unit&) const {}
    __device__ __forceinline__ void done(const Unit&) const {}
};

__device__ __forceinline__ unsigned cvt_pk_bf16(float lo, float hi) { unsigned r; asm volatile("v_cvt_pk_bf16_f32 %0, %1, %2" : "=v"(r) : "v"(lo), "v"(hi)); return r; }

template <class Epi, class Sched, bool ALIGN_EPI = true, bool SP2 = true>
__device__ __forceinline__ void gemm_phase(PG8_LAS unsigned char* lds, const int tid, const int K, const Sched& S, const Epi& E) {
    const int wid = __builtin_amdgcn_readfirstlane(tid >> 6), lane = tid & 63, wr = wid >> 2, wc = wid & 3, fr = lane & 15, fq = lane >> 4;
    const int nt = K / BK;
    unsigned voffA[2], voffB[2];
#pragma unroll
    for (int i = 0; i < 2; ++i) { int R, C; stage_rc(tid * 16 + i * 8192, R, C); const int Rb = ((R & ~31) + perm32(R & 31));
        voffA[i] = (unsigned)(R * K + C) * 2u; voffB[i] = (unsigned)(Rb * K + C) * 2u; }
    const size_t kstep = (size_t)(BK * 2);
    const size_t hstep = (size_t)HALF * K * 2;
    const unsigned ldsw = (unsigned)wid * 1024u;
    const int aoff = lds_byte(wr * 64 + fr, fq * 8), boff = lds_byte(wc * 32 + fr, fq * 8);
#define PG8_SA(b, h) (((b) * 2 + (h)) * HTB)
#define PG8_SB(b, h) ((4 + (b) * 2 + (h)) * HTB)
#define PG8_STAGE(bufoff, gbase, voff) do { _Pragma("unroll") for (int _i = 0; _i < 2; ++_i) \
        __builtin_amdgcn_global_load_lds((const unsigned*)((const char*)(gbase) + (voff)[_i]), (PG8_LAS unsigned*)(lds + (bufoff) + ldsw + _i * 8192), 16, 0, 0); } while (0)
#define PG8_LDA(dst, b, h) do { _Pragma("unroll") for (int m = 0; m < 4; ++m) _Pragma("unroll") for (int k = 0; k < 2; ++k) dst[m][k] = *(const PG8_LAS bf16x8*)(lds + PG8_SA(b, h) + aoff + m * 2048 + k * 1024); } while (0)
#define PG8_LDB(dst, b, h) do { _Pragma("unroll") for (int n = 0; n < 2; ++n) _Pragma("unroll") for (int k = 0; k < 2; ++k) dst[n][k] = *(const PG8_LAS bf16x8*)(lds + PG8_SB(b, h) + boff + n * 2048 + k * 1024); } while (0)
#define PG8_MMA(ai, bj, At, Bt) do { __builtin_amdgcn_s_setprio(1); _Pragma("unroll") for (int m = 0; m < 4; ++m) _Pragma("unroll") for (int n = 0; n < 2; ++n) _Pragma("unroll") for (int k = 0; k < 2; ++k) \
        acc[ai][bj][m][n] = __builtin_amdgcn_mfma_f32_16x16x32_bf16(Bt[n][k], At[m][k], acc[ai][bj][m][n], 0, 0, 0); __builtin_amdgcn_s_setprio(0); } while (0)
#define PG8_WAIT_V(n) asm volatile("s_waitcnt vmcnt(" #n ")" ::: "memory")
#define PG8_WAIT_L(n) asm volatile("s_waitcnt lgkmcnt(" #n ")" ::: "memory")
#define PG8_BAR __builtin_amdgcn_s_barrier()
#define PG8_SCHED __builtin_amdgcn_sched_barrier(0)
    Unit cur, nxt; int ui = 0;
    if (!S.next(0, cur)) return;
    f32x4 acc[2][2][4][2];
#pragma unroll
    for (int a = 0; a < 2; ++a)
#pragma unroll
        for (int b = 0; b < 2; ++b)
#pragma unroll
            for (int m = 0; m < 4; ++m)
#pragma unroll
                for (int n = 0; n < 2; ++n) acc[a][b][m][n] = (f32x4){0.f, 0.f, 0.f, 0.f};
    bf16x8 At[4][2], B0[2][2], B1[2][2];
    const char* cA = cur.A; const char* cB = cur.B;
    S.a_ready(cur);
    if constexpr (SP2) {
        PG8_STAGE(PG8_SB(0, 0), cB, voffB); PG8_STAGE(PG8_SB(0, 1), cB + hstep, voffB); PG8_STAGE(PG8_SA(0, 0), cA, voffA); PG8_STAGE(PG8_SA(0, 1), cA + hstep, voffA);
        if (wr == 1) PG8_BAR;
        PG8_WAIT_V(2); PG8_BAR;
        PG8_STAGE(PG8_SB(1, 0), cB + kstep, voffB); PG8_STAGE(PG8_SA(1, 0), cA + kstep, voffA); PG8_STAGE(PG8_SB(1, 1), cB + hstep + kstep, voffB);
        PG8_WAIT_V(6); PG8_BAR;
    } else {
        PG8_STAGE(PG8_SB(0, 0), cB, voffB); PG8_STAGE(PG8_SA(0, 0), cA, voffA); PG8_STAGE(PG8_SB(0, 1), cB + hstep, voffB); PG8_STAGE(PG8_SA(0, 1), cA + hstep, voffA);
        if (wr == 1) PG8_BAR;
        PG8_WAIT_V(4); PG8_BAR;
        PG8_STAGE(PG8_SB(1, 0), cB + kstep, voffB); PG8_STAGE(PG8_SA(1, 0), cA + kstep, voffA); PG8_STAGE(PG8_SB(1, 1), cB + hstep + kstep, voffB);
        PG8_WAIT_V(6); PG8_BAR;
    }
    for (;;) {
        const bool has_next = S.next(ui + 1, nxt);
        const char* nA = has_next ? nxt.A : cA; const char* nB = has_next ? nxt.B : cB;
        for (int t = 0; t < nt; t += 2) {
            const bool last = (t == nt - 2);
            const char* a1 = cA + (size_t)(t + 1) * kstep;
            const char* a2 = last ? nA : cA + (size_t)(t + 2) * kstep; const char* b2 = last ? nB : cB + (size_t)(t + 2) * kstep;
            const char* a3 = a2 + kstep; const char* b3 = b2 + kstep;
            if (last && has_next) S.a_ready(nxt);
            if constexpr (SP2) {
            PG8_LDB(B0, 0, 0); PG8_LDB(B1, 0, 1); PG8_SCHED; PG8_LDA(At, 0, 0); PG8_STAGE(PG8_SA(1, 1), a1 + hstep, voffA);
            PG8_WAIT_V(8); PG8_WAIT_L(0); PG8_BAR; PG8_MMA(0, 0, At, B0); PG8_MMA(0, 1, At, B1); PG8_BAR; PG8_SCHED;
            PG8_LDA(At, 0, 1); PG8_STAGE(PG8_SB(0, 0), b2, voffB); PG8_STAGE(PG8_SB(0, 1), b2 + hstep, voffB); PG8_STAGE(PG8_SA(0, 0), a2, voffA);
            PG8_WAIT_V(8); PG8_WAIT_L(0); PG8_BAR; PG8_MMA(1, 0, At, B0); PG8_MMA(1, 1, At, B1); PG8_BAR; PG8_SCHED;
            PG8_LDB(B0, 1, 0); PG8_LDB(B1, 1, 1); PG8_SCHED; PG8_LDA(At, 1, 0); PG8_STAGE(PG8_SA(0, 1), a2 + hstep, voffA);
            PG8_WAIT_V(8); PG8_WAIT_L(0); PG8_BAR; PG8_MMA(0, 0, At, B0); PG8_MMA(0, 1, At, B1); PG8_BAR; PG8_SCHED;
            PG8_LDA(At, 1, 1); PG8_STAGE(PG8_SB(1, 0), b3, voffB); PG8_STAGE(PG8_SB(1, 1), b3 + hstep, voffB); PG8_STAGE(PG8_SA(1, 0), a3, voffA);
            PG8_WAIT_V(8); PG8_WAIT_L(0); PG8_BAR; PG8_MMA(1, 0, At, B0); PG8_MMA(1, 1, At, B1); PG8_BAR; PG8_SCHED;
            } else {
            PG8_LDB(B0, 0, 0); PG8_SCHED; PG8_LDA(At, 0, 0); PG8_STAGE(PG8_SA(1, 1), a1 + hstep, voffA);
            PG8_WAIT_L(8); PG8_BAR; PG8_WAIT_L(0); PG8_MMA(0, 0, At, B0); PG8_BAR; PG8_SCHED;
            PG8_LDB(B1, 0, 1); PG8_STAGE(PG8_SB(0, 0), b2, voffB);
            PG8_BAR; PG8_WAIT_L(0); PG8_MMA(0, 1, At, B1); PG8_BAR;
            PG8_LDA(At, 0, 1); PG8_STAGE(PG8_SA(0, 0), a2, voffA);
            PG8_BAR; PG8_WAIT_L(0); PG8_MMA(1, 0, At, B0); PG8_BAR; PG8_SCHED;
            PG8_STAGE(PG8_SB(0, 1), b2 + hstep, voffB);
            PG8_WAIT_V(6); PG8_BAR; PG8_MMA(1, 1, At, B1); PG8_BAR;
            PG8_LDB(B0, 1, 0); PG8_SCHED; PG8_LDA(At, 1, 0); PG8_STAGE(PG8_SA(0, 1), a2 + hstep, voffA);
            PG8_WAIT_L(8); PG8_BAR; PG8_WAIT_L(0); PG8_MMA(0, 0, At, B0); PG8_BAR; PG8_SCHED;
            PG8_LDB(B1, 1, 1); PG8_STAGE(PG8_SB(1, 0), b3, voffB);
            PG8_BAR; PG8_WAIT_L(0); PG8_MMA(0, 1, At, B1); PG8_BAR;
            PG8_LDA(At, 1, 1); PG8_STAGE(PG8_SA(1, 0), a3, voffA);
            PG8_BAR; PG8_WAIT_L(0); PG8_MMA(1, 0, At, B0); PG8_BAR; PG8_SCHED;
            PG8_STAGE(PG8_SB(1, 1), b3 + hstep, voffB);
            PG8_WAIT_V(6); PG8_BAR; PG8_MMA(1, 1, At, B1); PG8_BAR;
            }
        }
        if constexpr (ALIGN_EPI) { if (wr == 0) PG8_BAR; }
        E(acc, cur, wr, wc, fr, fq); S.done(cur);
        if (!has_next) break;
#pragma unroll
        for (int a = 0; a < 2; ++a)
#pragma unroll
            for (int b = 0; b < 2; ++b)
#pragma unroll
                for (int m = 0; m < 4; ++m)
#pragma unroll
                    for (int n = 0; n < 2; ++n) acc[a][b][m][n] = (f32x4){0.f, 0.f, 0.f, 0.f};
        cur = nxt; cA = nA; cB = nB; ++ui;
        if constexpr (ALIGN_EPI) { if (wr == 1) PG8_BAR; }
    }
    PG8_WAIT_V(0);
    if constexpr (!ALIGN_EPI) { if (wr == 0) PG8_BAR; }
    PG8_BAR;
#undef PG8_SA
#undef PG8_SB
#undef PG8_STAGE
#undef PG8_LDA
#undef PG8_LDB
#undef PG8_MMA
#undef PG8_WAIT_V
#undef PG8_WAIT_L
#undef PG8_BAR
#undef PG8_SCHED
}
}

constexpr int NWAVES = 8;
constexpr int D = 1024, NBATCH = 4, SEQ = 4096, CTXL = 256;
constexpr int NLAT = NBATCH * SEQ, NCTX = NBATCH * CTXL, NROW = NLAT + NCTX, NPAN = NROW / 256;
constexpr int INW_SRC = 4128, INW = 4608;
constexpr int FFD = 2816, FFE = 3584, NEXP = 8;
constexpr float EPS = 1e-6f;

constexpr size_t MiB = 1u << 20;
constexpr size_t WS_CTL = 0, CTL_ZERO_BYTES = 1 * MiB;
constexpr size_t WS_TAB = 1 * MiB;
constexpr size_t WS_LATX = 8 * MiB;
constexpr size_t WS_W = 76 * MiB;
constexpr size_t WS_XN = 120 * MiB;
constexpr size_t WS_IP = 154 * MiB;
constexpr size_t WS_DS = 324 * MiB;
constexpr size_t WS_S5F = 392 * MiB;
constexpr size_t WS_OG = 401 * MiB;
constexpr size_t WS_SG = 418 * MiB;
constexpr size_t WS_O32 = 435 * MiB;
constexpr size_t WS_Y32 = 469 * MiB;
constexpr size_t WS_SST = 435 * MiB;
constexpr size_t WS_BC = 478 * MiB;
constexpr size_t WS_S5H = 469 * MiB;
constexpr size_t WS_WM = 76 * MiB;
constexpr size_t WS_XG = 244 * MiB;
constexpr size_t WS_HM = 312 * MiB;
constexpr size_t WS_YS = 424 * MiB;
constexpr size_t WS_END = 512 * MiB;
constexpr size_t IP_K = 0, IP_V = IP_K + (size_t)NROW * 256 * 2, IP_GF = IP_V + (size_t)NROW * 512 * 2, IP_GB = IP_GF + (size_t)NROW * 256 * 4,
                 IP_U = IP_GB + (size_t)NROW * 256 * 4, IP_Q = IP_U + (size_t)NROW * 512 * 2, IP_R = IP_Q + (size_t)NROW * 256 * 2,
                 IP_GA = IP_R + (size_t)NROW * 512 * 2, IP_GM = IP_GA + (size_t)NROW * 1024 * 2, IP_END = IP_GM + (size_t)NROW * 1024 * 2;
static_assert(IP_END <= 170 * MiB, "in-proj region");
constexpr size_t IP_T = IP_K;
constexpr size_t IP_S2 = IP_U;
constexpr size_t IP_HMID = 0;
static_assert((size_t)NROW * 1024 * 2 <= IP_GB, "T overlay");
static_assert((size_t)NROW * FFD * 2 <= 170 * MiB, "HMID overlay");
constexpr size_t W_IN = 0;
constexpr size_t W_GLU = 18 * MiB;
constexpr size_t W_GP = 19 * MiB;
constexpr size_t W_SP = 21 * MiB;
constexpr size_t W_OUT = 23 * MiB;
constexpr size_t W_FGU = 27 * MiB;
constexpr size_t W_FD = 38 * MiB;
constexpr size_t WM_GU = 0;
constexpr size_t WM_D = 112 * MiB;
constexpr size_t T_MODV = 0;
constexpr size_t T_LAMB = 256 * 1024;
constexpr size_t T_BBAR = 512 * 1024;
constexpr size_t T_TOKE = 2 * MiB;
constexpr size_t T_TOKW = 2 * MiB + 256 * 1024;
constexpr size_t T_TOKS = 2 * MiB + 512 * 1024;
constexpr size_t T_BMT = 3 * MiB;
constexpr size_t T_CMT = 3 * MiB + 512 * 1024;
constexpr size_t T_DEC = 4 * MiB;
constexpr int CW_TMO = 0, CW_CODE = 1;
constexpr int CW_BAR = 4096;
constexpr int CW_CNT = 16384;

constexpr int RING_OFF = 0, RING_BYTES = 131072;
constexpr int LDSCTL_OFF = RING_BYTES, MISC_OFF = LDSCTL_OFF + 320;
constexpr int LDS_BYTES = 147456;

#define GAS __attribute__((address_space(1)))
#define LAS __attribute__((address_space(3)))
typedef unsigned short bf16;
typedef unsigned v4u __attribute__((ext_vector_type(4)));
typedef unsigned v2u __attribute__((ext_vector_type(2)));
typedef float f32x4 __attribute__((ext_vector_type(4)));
typedef float f32x2 __attribute__((ext_vector_type(2)));
typedef short bf16x8 __attribute__((ext_vector_type(8)));
typedef GAS unsigned gu32;
#define RLX_AGENT __ATOMIC_RELAXED, __HIP_MEMORY_SCOPE_AGENT
#define LDS_WAIT() asm volatile("s_waitcnt lgkmcnt(0)" ::: "memory")
#define VM_WAIT() asm volatile("s_waitcnt vmcnt(0)" ::: "memory")
__device__ __forceinline__ unsigned f2bf(float f) { unsigned u = __builtin_bit_cast(unsigned, f); return (u + 0x7fffu + ((u >> 16) & 1u)) >> 16; }
__device__ __forceinline__ unsigned pk2(float lo, float hi) { return f2bf(lo) | (f2bf(hi) << 16); }
__device__ __forceinline__ float bf2f(unsigned b) { return __builtin_bit_cast(float, b << 16); }
__device__ __forceinline__ float bflo(unsigned w) { return __builtin_bit_cast(float, w << 16); }
__device__ __forceinline__ float bfhi(unsigned w) { return __builtin_bit_cast(float, w & 0xffff0000u); }
__device__ __forceinline__ float sigmoidf_(float x) { return __builtin_amdgcn_rcpf(1.0f + __expf(-x)); }
__device__ __forceinline__ float siluf_(float x) { return x * __builtin_amdgcn_rcpf(1.0f + __expf(-x)); }
__device__ __forceinline__ float geluf_(float x) { const float t = 1.5957691216057308f * (x + 0.044715f * x * x * x); return x * __builtin_amdgcn_rcpf(1.0f + __expf(-t)); }
__device__ __forceinline__ float logsigmoidf_(float z) { return fminf(z, 0.f) - __logf(1.0f + __expf(-fabsf(z))); }

#define XB_TMO      128
#define XB_XCNT(j)  (256  + 64 * (j))
#define XB_XSUB(j)  (1280 + 64 * (j))
#define XB_XGEN(j)  (2304 + 64 * (j))
#define XB_TOP      3328
#define XB_TOPGEN   3392
#define XCD_BAR_WORDS 3456
#define XB_SPIN_CAP (1u << 18)
__device__ __forceinline__ unsigned xb_ld(unsigned* p)              { return __hip_atomic_load(p, __ATOMIC_RELAXED, __HIP_MEMORY_SCOPE_AGENT); }
__device__ __forceinline__ unsigned xb_add(unsigned* p, unsigned v) { return __hip_atomic_fetch_add(p, v, __ATOMIC_RELAXED, __HIP_MEMORY_SCOPE_AGENT); }
__device__ __forceinline__ unsigned xb_xcc_id() { return (unsigned)__builtin_amdgcn_s_getreg((3 << 11) | 20) & 0xFu; }
#define XB_SPIN(cond, bar) do { unsigned _sp = 0; while (cond) { __builtin_amdgcn_s_sleep(1); \
    if ((++_sp & 255u) == 0u) { if (xb_ld(&(bar)[XB_TMO])) break; if (_sp > XB_SPIN_CAP) { atomicAdd(&(bar)[XB_TMO], 1u); break; } } } } while (0)
struct XcdBarrier { unsigned* bar; unsigned x; volatile LAS unsigned* st; };
__device__ __forceinline__ XcdBarrier xcd_barrier_post(unsigned* bar, volatile LAS unsigned* st) {
    XcdBarrier b; b.bar = bar; b.x = xb_xcc_id(); b.st = st;
    if (threadIdx.x == 0) (void)xb_add(&bar[XB_XCNT(b.x)], 1u);
    return b;
}
__device__ __forceinline__ void xcd_barrier_complete(unsigned* bar, unsigned x, unsigned& nloc, unsigned& nx) {
    const unsigned G = gridDim.x * gridDim.y * gridDim.z;
    unsigned sum, cnt, mine, sp = 0u;
    for (;;) {
        sum = 0u; cnt = 0u; mine = 0u;
#pragma unroll
        for (unsigned j = 0; j < 16; ++j) { const unsigned c = xb_ld(&bar[XB_XCNT(j)]); sum += c; cnt += (c > 0u) ? 1u : 0u; mine = (j == x) ? c : mine; }
        if (sum == G) break;
        __builtin_amdgcn_s_sleep(1);
        if ((++sp & 255u) == 0u) { if (xb_ld(&bar[XB_TMO])) break; if (sp > XB_SPIN_CAP) { atomicAdd(&bar[XB_TMO], 1u); break; } }
    }
    nloc = mine > 0u ? mine : 1u; nx = cnt > 0u ? cnt : 1u;
}
__device__ __forceinline__ void xcd_barrier(const XcdBarrier& b) {
    asm volatile("s_waitcnt vmcnt(0)" ::: "memory");
    __syncthreads();
    if (threadIdx.x == 0) {
        unsigned* bar = b.bar;
        __builtin_amdgcn_s_waitcnt(0);
        unsigned nloc = b.st[0], nx = b.st[1];
        if (nloc == 0u) { xcd_barrier_complete(bar, b.x, nloc, nx); b.st[0] = nloc; b.st[1] = nx; }
        const unsigned old = xb_add(&bar[XB_XSUB(b.x)], 1u);
        const unsigned gen = old / nloc;
        if (old + 1u == (gen + 1u) * nloc) {
            __builtin_amdgcn_fence(__ATOMIC_RELEASE, "agent");
            asm volatile("s_waitcnt vmcnt(0)" ::: "memory");
            const unsigned og = xb_add(&bar[XB_TOP], 1u);
            const unsigned tg = og / nx;
            if (og + 1u == (tg + 1u) * nx) xb_add(&bar[XB_TOPGEN], 1u);
            else XB_SPIN(xb_ld(&bar[XB_TOPGEN]) == tg, bar);
            __builtin_amdgcn_fence(__ATOMIC_ACQUIRE, "");
            xb_add(&bar[XB_XGEN(b.x)], 1u);
            asm volatile("s_waitcnt vmcnt(0)" ::: "memory");
        } else {
            XB_SPIN(xb_ld(&bar[XB_XGEN(b.x)]) == gen, bar);
            __builtin_amdgcn_fence(__ATOMIC_ACQUIRE, "");
            asm volatile("s_waitcnt vmcnt(0)" ::: "memory");
        }
    }
    __syncthreads();
}

enum InIdx { I_X = 0, I_C, I_CTX, I_CCTX, I_WMOD, I_BMOD, I_N1W, I_N2W, I_FNW, I_WIN, I_LRF, I_LRB, I_BIASF, I_BIASB, I_GNW,
             I_AREF, I_AIMF, I_LDTF, I_AREB, I_AIMB, I_LDTB, I_BRE, I_BIM, I_CRE, I_CIM, I_S5D, I_WGLU, I_BGLU, I_WGP, I_WSP, I_WOUT,
             I_FG, I_FU, I_FD, I_ROUTER, I_MG, I_MU, I_MD, N_IN };
struct Args { const float* in[N_IN]; float* out; unsigned char* ws; int ph_lo, ph_hi; };

__device__ __forceinline__ float wave_sum(float v) {
#pragma unroll
    for (int o = 1; o < 64; o <<= 1) v += __shfl_xor(v, o);
    return v;
}

__device__ __forceinline__ void transpose_item(const float* W, int ldw, int k0, int n0, bf16* WT, int ldt, int drow0, LAS float* scr, int lane) {
#pragma unroll 8
    for (int i = 0; i < 32; ++i) { const int kk = 2 * i + (lane >> 5); scr[kk * 33 + (lane & 31)] = W[(size_t)(k0 + kk) * ldw + n0 + (lane & 31)]; }
    LDS_WAIT(); asm volatile("" ::: "memory");
    const int c = lane & 7;
#pragma unroll
    for (int j = 0; j < 4; ++j) { const int n = (lane >> 3) + 8 * j; const LAS float* s = scr + (8 * c) * 33 + n;
        v4u o; o.x = pk2(s[0 * 33], s[1 * 33]); o.y = pk2(s[2 * 33], s[3 * 33]); o.z = pk2(s[4 * 33], s[5 * 33]); o.w = pk2(s[6 * 33], s[7 * 33]);
        *(GAS v4u*)(WT + (size_t)(drow0 + n) * ldt + k0 + 8 * c) = o; }
    LDS_WAIT(); asm volatile("" ::: "memory");
}
__device__ __forceinline__ bool conv_matrix(int& r, const float* W, int K, int N, bf16* WT, int mode, int roff, LAS float* scr, int lane) {
    const int nblk = N / 32, items = (K / 64) * nblk;
    if (r >= items) { r -= items; return false; }
    const int kb = r / nblk, nb = r % nblk, k0 = 64 * kb, n0 = 32 * nb;
    int drow0;
    if (mode == 0) drow0 = n0 + roff;
    else if (mode == 1) { if (n0 == 768) return true; drow0 = n0 < 768 ? n0 : n0 + 480; }
    else drow0 = (n0 >> 7) * 256 + (n0 & 127) + roff;
    transpose_item(W, N, k0, n0, WT, K, drow0, scr, lane);
    return true;
}

using pg8::Unit; using pg8::cvt_pk_bf16;
typedef pg8::f32x4 accv;
#define EPI_ARGS const accv (&acc)[2][2][4][2], const Unit& u, int wr, int wc, int fr, int fq
__device__ __forceinline__ v4u pack8(f32x4 a, f32x4 b) { v4u w; w.x = cvt_pk_bf16(a[0], a[1]); w.y = cvt_pk_bf16(a[2], a[3]); w.z = cvt_pk_bf16(b[0], b[1]); w.w = cvt_pk_bf16(b[2], b[3]); return w; }
__device__ __forceinline__ void unpack8(v4u w, f32x4& a, f32x4& b) { a = (f32x4){bflo(w.x), bfhi(w.x), bflo(w.y), bfhi(w.y)}; b = (f32x4){bflo(w.z), bfhi(w.z), bflo(w.w), bfhi(w.w)}; }

struct EpiInProj {
    bf16 *Kb, *Vb, *Ub, *Qb, *Rb, *GAb, *GMb; float *GF, *GB; const float *bias_f, *bias_b;
    __device__ __forceinline__ void operator()(EPI_ARGS) const {
        const int pn = u.pn, row0 = u.pm * 256 + wr * 64 + fr, cw = wc * 32 + 8 * fq;
        if (pn == 3 || pn == 4) {
            float* dst = pn == 3 ? GF : GB; const float* bias = pn == 3 ? bias_f : bias_b;
#pragma unroll
            for (int bj = 0; bj < 2; ++bj) { const int c = cw + bj * 128; const f32x4 b0 = *(const f32x4*)(bias + c), b1 = *(const f32x4*)(bias + c + 4);
#pragma unroll
                for (int ai = 0; ai < 2; ++ai)
#pragma unroll
                    for (int m = 0; m < 4; ++m) { float* p = dst + (size_t)(row0 + ai * 128 + m * 16) * 256 + c; f32x4 v0 = acc[ai][bj][m][0] + b0, v1 = acc[ai][bj][m][1] + b1;
#pragma unroll
                        for (int j = 0; j < 4; ++j) { v0[j] = logsigmoidf_(v0[j]) * 0.0625f; v1[j] = logsigmoidf_(v1[j]) * 0.0625f; }
                        *(f32x4*)p = v0; *(f32x4*)(p + 4) = v1; } }
            return;
        }
        bf16* dst; int ld, cb, act;
        if (pn == 0) { dst = Kb; ld = 256; cb = 0; act = 0; }
        else if (pn <= 2) { dst = Vb; ld = 512; cb = (pn - 1) * 256; act = 0; }
        else if (pn <= 6) { dst = Ub; ld = 512; cb = (pn - 5) * 256; act = 0; }
        else if (pn == 7) { dst = Qb; ld = 256; cb = 0; act = 1; }
        else if (pn <= 9) { dst = Rb; ld = 512; cb = (pn - 8) * 256; act = 2; }
        else if (pn <= 13) { dst = GAb; ld = 1024; cb = (pn - 10) * 256; act = 3; }
        else { dst = GMb; ld = 1024; cb = (pn - 14) * 256; act = 3; }
#pragma unroll
        for (int ai = 0; ai < 2; ++ai)
#pragma unroll
            for (int m = 0; m < 4; ++m) { bf16* rowp = dst + (size_t)(row0 + ai * 128 + m * 16) * ld + cb + cw;
#pragma unroll
                for (int bj = 0; bj < 2; ++bj) { f32x4 v0 = acc[ai][bj][m][0], v1 = acc[ai][bj][m][1];
                    if (act == 1) { v0 = v0 * 0.125f; v1 = v1 * 0.125f; }
                    else if (act == 2) {
#pragma unroll
                        for (int j = 0; j < 4; ++j) { v0[j] = siluf_(v0[j]); v1[j] = siluf_(v1[j]); } }
                    else if (act == 3) {
#pragma unroll
                        for (int j = 0; j < 4; ++j) { v0[j] = sigmoidf_(v0[j]); v1[j] = sigmoidf_(v1[j]); } }
                    *(v4u*)(rowp + bj * 128) = pack8(v0, v1); } }
    }
};
struct EpiD12 {
    const bf16* SG; bf16* S2; const float* bglu; const bf16* GA; bf16* T;
    __device__ __forceinline__ void operator()(EPI_ARGS) const {
        const int row0 = u.pm * 256 + wr * 64 + fr, c0 = u.pn * 256 + wc * 32 + 8 * fq;
#pragma unroll
        for (int ai = 0; ai < 2; ++ai)
#pragma unroll
            for (int m = 0; m < 4; ++m) { const size_t row = (size_t)(row0 + ai * 128 + m * 16);
#pragma unroll
                for (int bj = 0; bj < 2; ++bj) { const int c = c0 + bj * 128; f32x4 v0 = acc[ai][bj][m][0], v1 = acc[ai][bj][m][1], s0, s1;
                    if (u.kind == 0) { const f32x4 b0 = *(const f32x4*)(bglu + c), b1 = *(const f32x4*)(bglu + c + 4); unpack8(*(const v4u*)(SG + row * 512 + c), s0, s1);
#pragma unroll
                        for (int j = 0; j < 4; ++j) { v0[j] = s0[j] * sigmoidf_(v0[j] + b0[j]); v1[j] = s1[j] * sigmoidf_(v1[j] + b1[j]); }
                        *(v4u*)(S2 + row * 512 + c) = pack8(v0, v1); }
                    else { unpack8(*(const v4u*)(GA + row * 1024 + c), s0, s1); *(v4u*)(T + row * 1024 + c) = pack8(v0 * s0, v1 * s1); } } }
    }
};
struct EpiD3 {
    const bf16* T; const bf16* GM; bf16* MB;
    __device__ __forceinline__ void operator()(EPI_ARGS) const {
        const int row0 = u.pm * 256 + wr * 64 + fr, c0 = u.pn * 256 + wc * 32 + 8 * fq;
#pragma unroll
        for (int ai = 0; ai < 2; ++ai)
#pragma unroll
            for (int m = 0; m < 4; ++m) { const size_t row = (size_t)(row0 + ai * 128 + m * 16);
#pragma unroll
                for (int bj = 0; bj < 2; ++bj) { const int c = c0 + bj * 128; f32x4 t0, t1, g0, g1; unpack8(*(const v4u*)(T + row * 1024 + c), t0, t1); unpack8(*(const v4u*)(GM + row * 1024 + c), g0, g1);
                    *(v4u*)(MB + row * 1024 + c) = pack8(t0 + g0 * acc[ai][bj][m][0], t1 + g1 * acc[ai][bj][m][1]); } }
    }
};
struct EpiResid {
    const float* rl; const float* rc; float* out; const float* modv; int gidx;
    __device__ __forceinline__ void operator()(EPI_ARGS) const {
        const int row0 = u.pm * 256 + wr * 64 + fr, c0 = u.pn * 256 + wc * 32 + 8 * fq;
        const int bi = u.pm < NLAT / 256 ? (u.pm >> 4) : 4;
        const float* gp = modv + bi * 6144 + gidx * 1024;
#pragma unroll
        for (int bj = 0; bj < 2; ++bj) { const int c = c0 + bj * 128; const f32x4 g0 = *(const f32x4*)(gp + c), g1 = *(const f32x4*)(gp + c + 4);
#pragma unroll
            for (int ai = 0; ai < 2; ++ai)
#pragma unroll
                for (int m = 0; m < 4; ++m) { const int row = row0 + ai * 128 + m * 16;
                    const float* rp = (row < NLAT ? rl + (size_t)row * 1024 : rc + (size_t)(row - NLAT) * 1024) + c; float* op = out + (size_t)row * 1024 + c;
                    const f32x4 r0 = *(const f32x4*)rp, r1 = *(const f32x4*)(rp + 4);
                    *(f32x4*)op = r0 + g0 * acc[ai][bj][m][0]; *(f32x4*)(op + 4) = r1 + g1 * acc[ai][bj][m][1]; } }
    }
};
struct EpiSwiglu {
    bf16* H; int ld; int pmoff;
    __device__ __forceinline__ void operator()(EPI_ARGS) const {
        const int row0 = (u.pm - pmoff) * 256 + wr * 64 + fr, c = u.pn * 128 + wc * 32 + 8 * fq;
#pragma unroll
        for (int ai = 0; ai < 2; ++ai)
#pragma unroll
            for (int m = 0; m < 4; ++m) { f32x4 g0 = acc[ai][0][m][0], g1 = acc[ai][0][m][1]; const f32x4 u0 = acc[ai][1][m][0], u1 = acc[ai][1][m][1];
#pragma unroll
                for (int j = 0; j < 4; ++j) { g0[j] = siluf_(g0[j]) * u0[j]; g1[j] = siluf_(g1[j]) * u1[j]; }
                *(v4u*)(H + (size_t)(row0 + ai * 128 + m * 16) * ld + c) = pack8(g0, g1); }
    }
};
struct EpiPlain {
    bf16* Y;
    __device__ __forceinline__ void operator()(EPI_ARGS) const {
        const int row0 = u.pm * 256 + wr * 64 + fr, c0 = u.pn * 256 + wc * 32 + 8 * fq;
#pragma unroll
        for (int ai = 0; ai < 2; ++ai)
#pragma unroll
            for (int m = 0; m < 4; ++m)
#pragma unroll
                for (int bj = 0; bj < 2; ++bj) *(v4u*)(Y + (size_t)(row0 + ai * 128 + m * 16) * 1024 + c0 + bj * 128) = pack8(acc[ai][bj][m][0], acc[ai][bj][m][1]);
    }
};

#define PHASE_BEGIN() int tid_ = threadIdx.x; asm volatile("" : "+v"(tid_)); unsigned char* ws = args.ws; asm volatile("" : "+s"(ws)); \
    const int tid = tid_, lane = tid & 63, wave = __builtin_amdgcn_readfirstlane(tid >> 6), gw = vcu * NWAVES + wave; (void)lane; (void)gw; \
    const float* const* in = args.in; (void)in; gu32* ctl = (gu32*)(ws + WS_CTL); (void)ctl;
#define LATX ((float*)(ws + WS_LATX))
#define XN ((bf16*)(ws + WS_XN))
#define Kb ((bf16*)(ws + WS_IP + IP_K))
#define Vb ((bf16*)(ws + WS_IP + IP_V))
#define GF ((float*)(ws + WS_IP + IP_GF))
#define GB ((float*)(ws + WS_IP + IP_GB))
#define Ub ((bf16*)(ws + WS_IP + IP_U))
#define Qb ((bf16*)(ws + WS_IP + IP_Q))
#define Rb ((bf16*)(ws + WS_IP + IP_R))
#define GAb ((bf16*)(ws + WS_IP + IP_GA))
#define GMb ((bf16*)(ws + WS_IP + IP_GM))
#define Tb ((bf16*)(ws + WS_IP + IP_T))
#define S2 ((bf16*)(ws + WS_IP + IP_S2))
#define HMID ((bf16*)(ws + WS_IP + IP_HMID))
#define OG ((bf16*)(ws + WS_OG))
#define SG ((bf16*)(ws + WS_SG))
#define O32 ((float*)(ws + WS_O32))
#define Y32 ((float*)(ws + WS_Y32))
#define MODV ((float*)(ws + WS_TAB + T_MODV))
#define LAMB ((f32x2*)(ws + WS_TAB + T_LAMB))
#define BBAR ((f32x2*)(ws + WS_TAB + T_BBAR))
#define BMT ((bf16*)(ws + WS_TAB + T_BMT))
#define CMT ((bf16*)(ws + WS_TAB + T_CMT))
#define S5F ((f32x2*)(ws + WS_S5F))
#define S5H ((f32x2*)(ws + WS_S5H))
#define DSB ((float*)(ws + WS_DS))
#define SSTB ((bf16*)(ws + WS_SST))
#define BCB ((float*)(ws + WS_BC))
#define DECB ((float*)(ws + WS_TAB + T_DEC))
#define TOKE ((int4*)(ws + WS_TAB + T_TOKE))
#define TOKW ((f32x2*)(ws + WS_TAB + T_TOKW))
#define TOKS ((int2*)(ws + WS_TAB + T_TOKS))
#define wb (ws + WS_W)
#define WMGU ((bf16*)(ws + WS_WM + WM_GU))
#define WMD ((bf16*)(ws + WS_WM + WM_D))
#define XG ((bf16*)(ws + WS_XG))
#define HM ((bf16*)(ws + WS_HM))
#define YS ((bf16*)(ws + WS_YS))


typedef float f32x16 __attribute__((ext_vector_type(16)));
#define MFMA32(a, b, c) __builtin_amdgcn_mfma_f32_32x32x16_bf16((a), (b), (c), 0, 0, 0)
#define MFMA16(a, b, c) __builtin_amdgcn_mfma_f32_16x16x32_bf16((a), (b), (c), 0, 0, 0)
__device__ __forceinline__ void cmul(float& ar, float& ai, float br, float bi) { const float r = ar * br - ai * bi, i = ar * bi + ai * br; ar = r; ai = i; }
template <int DIR> __device__ __forceinline__ void s5_scan(f32x16 (&tre)[2], f32x16 (&tim)[2], const float lr, const float li, float& sr, float& si) {
#pragma unroll
    for (int q = 0; q < 32; ++q) { const int idx = DIR ? 31 - q : q, mt = idx >> 4, i = idx & 15;
        const float nr = lr * sr - li * si + tre[mt][i], ni = lr * si + li * sr + tim[mt][i]; sr = nr; si = ni; tre[mt][i] = sr; tim[mt][i] = si; }
}
template <int DIR> __device__ __forceinline__ void s5_fix(f32x16 (&tre)[2], f32x16 (&tim)[2], const float lr, const float li, const float xr, const float xi) {
    float fr = lr, fi = li;
#pragma unroll
    for (int q = 0; q < 32; ++q) { const int idx = DIR ? 31 - q : q, mt = idx >> 4, i = idx & 15;
        tre[mt][i] += fr * xr - fi * xi; tim[mt][i] += fr * xi + fi * xr; cmul(fr, fi, lr, li); }
}
__device__ __forceinline__ void ts_rows(int b, int ts, int& rb, int& rs) { if (ts < 4) { rb = NLAT + b * CTXL + 64 * ts; rs = 1; } else { rb = b * SEQ + (ts - 4); rs = 64; } }
__device__ __forceinline__ int chain_pos(int dir, int ts) { return dir == 0 ? ts : (ts < 4 ? 3 - ts : 71 - ts); }

template <int MODE> __device__ __forceinline__ void s5_unit(unsigned char* ws, const float* const* in, LAS unsigned char* hbuf_raw, const int l, const int b, const int ts, const int g, const int lane) {
    const int r = lane & 31, hh = lane >> 5;
    int rb, rs; ts_rows(b, ts, rb, rs);
    bf16x8 ua[2];
#pragma unroll
    for (int mt = 0; mt < 2; ++mt) { const int tokA = 32 * ((r >> 2) & 1) + 16 * mt + (r & 3) + 4 * (r >> 3);
        ua[mt] = *(const bf16x8*)(Ub + (size_t)(rb + tokA * rs) * 512 + 16 * g + 8 * hh); }
    f32x4 yacc[4];
#pragma unroll
    for (int i = 0; i < 4; ++i) yacc[i] = (f32x4){0.f, 0.f, 0.f, 0.f};
    LAS unsigned* hbuf = (LAS unsigned*)hbuf_raw;
#pragma unroll
    for (int dir = 0; dir < 2; ++dir) {
        const int cpos = chain_pos(dir, ts);
#pragma unroll
        for (int ph = 0; ph < 2; ++ph) {
            const bf16* bm = BMT + ((size_t)((((l * 2 + dir) * 32 + g) * 2 + ph) * 2)) * 512 + r * 16 + 8 * hh;
            const bf16x8 bre = *(const bf16x8*)bm, bim = *(const bf16x8*)(bm + 512);
            f32x16 tre[2], tim[2];
#pragma unroll
            for (int mt = 0; mt < 2; ++mt) { f32x16 z;
#pragma unroll
                for (int i = 0; i < 16; ++i) z[i] = 0.f;
                tre[mt] = MFMA32(ua[mt], bre, z); tim[mt] = MFMA32(ua[mt], bim, z); }
            const int p = 32 * ph + r;
            const f32x2 lam = LAMB[((l * 2 + dir) * 32 + g) * 64 + p];
            const size_t fidx = ((size_t)((dir * 4 + b) * 32 + g) * 68 + cpos) * 64 + p;
            const bool first = (hh == dir);
            float sr = 0.f, si = 0.f;
            if (MODE == 1) { const f32x2 h0 = S5H[fidx]; if (first) { sr = h0[0]; si = h0[1]; } }
            if (dir == 0) s5_scan<0>(tre, tim, lam[0], lam[1], sr, si); else s5_scan<1>(tre, tim, lam[0], lam[1], sr, si);
            const float orr = __shfl_xor(sr, 32), oi = __shfl_xor(si, 32);
            if (MODE == 0) {
                float l32r = lam[0], l32i = lam[1];
#pragma unroll
                for (int q = 0; q < 5; ++q) cmul(l32r, l32i, l32r, l32i);
                const float fr_ = first ? sr : orr, fi_ = first ? si : oi, sr_ = first ? orr : sr, si_ = first ? oi : si;
                const f32x2 fv = (f32x2){l32r * fr_ - l32i * fi_ + sr_, l32r * fi_ + l32i * fr_ + si_};
                asm volatile("s_waitcnt lgkmcnt(0)" ::: "memory");
                if (hh == 0) S5F[fidx] = fv;
            } else {
                const float xr = first ? 0.f : orr, xi = first ? 0.f : oi;
                if (dir == 0) s5_fix<0>(tre, tim, lam[0], lam[1], xr, xi); else s5_fix<1>(tre, tim, lam[0], lam[1], xr, xi);
#pragma unroll
                for (int mt = 0; mt < 2; ++mt)
#pragma unroll
                    for (int i = 0; i < 16; ++i) hbuf[(32 * hh + 16 * mt + i) * 36 + r] = cvt_pk_bf16(tre[mt][i], tim[mt][i]);
                LDS_WAIT();
#pragma unroll
                for (int ks = 0; ks < 2; ++ks) {
                    const bf16x8 cb = *(const bf16x8*)(CMT + ((size_t)((l * 32 + g) * 16 + (lane & 15)) * 2 + ph) * 64 + 32 * ks + 8 * (lane >> 4));
#pragma unroll
                    for (int m4 = 0; m4 < 4; ++m4) { const bf16x8 ha = *(const LAS bf16x8*)(hbuf + (16 * m4 + (lane & 15)) * 36 + 16 * ks + 4 * (lane >> 4)); yacc[m4] = MFMA16(ha, cb, yacc[m4]); }
                }
                LDS_WAIT();
            }
        }
    }
    if (MODE == 1) {
        const int hc = lane & 15; const float dsk = in[I_S5D][l * 512 + 16 * g + hc];
#pragma unroll
        for (int m4 = 0; m4 < 4; ++m4)
#pragma unroll
            for (int i = 0; i < 4; ++i) { const int tok = 16 * m4 + 4 * (lane >> 4) + i; const size_t o = (size_t)(rb + tok * rs) * 512 + 16 * g + hc;
                SG[o] = (bf16)f2bf(geluf_(yacc[m4][i] + dsk * bf2f(Ub[o]))); }
    }
}


typedef __bf16 bf16x2_t __attribute__((ext_vector_type(2)));
__device__ __forceinline__ unsigned cvtpk(float lo, float hi) { const f32x2 v = {lo, hi}; const bf16x2_t b = __builtin_convertvector(v, bf16x2_t); return __builtin_bit_cast(unsigned, b); }
__device__ __forceinline__ int gla_rowbase(int b, int ts) { return ts < 4 ? NLAT + b * CTXL + 64 * ts : b * SEQ + 64 * (ts - 4); }
__device__ __forceinline__ void gla_vt_image(unsigned char* ws, LAS unsigned char* img, int rb, int tid) {
    const bf16* vp = Vb + (size_t)rb * 512 + tid;
#pragma unroll 2
    for (int c = 0; c < 8; ++c) { unsigned pk[4];
#pragma unroll
        for (int j = 0; j < 4; ++j) pk[j] = (unsigned)vp[(8 * c + 2 * j) * 512] | ((unsigned)vp[(8 * c + 2 * j + 1) * 512] << 16);
        v4u v; v.x = pk[0]; v.y = pk[1]; v.z = pk[2]; v.w = pk[3]; *(LAS v4u*)(img + tid * 128 + ((c ^ ((tid >> 1) & 7)) * 16)) = v; }
}
__device__ __forceinline__ void gla_c1_unit(unsigned char* ws, LAS unsigned char* lds, const int b, const int ts, const int tid) {
    const int lane = tid & 63, w = __builtin_amdgcn_readfirstlane(tid >> 6), dir = w >> 2, h = w & 3;
    const int rb = gla_rowbase(b, ts), chain = (dir * 4 + b) * 4 + h, cpos = chain_pos(dir, ts);
    {
        const float* gp = (dir ? GB : GF) + (size_t)rb * 256 + h * 64 + lane;
        float total = 0.f;
#pragma unroll 16
        for (int t = 0; t < 64; ++t) total += gp[t * 256];
        float* bcp = BCB + (size_t)rb * 512 + dir * 256 + h * 64 + lane;
        const bf16* kp = Kb + (size_t)rb * 256 + h * 64 + lane;
        float P = 0.f;
#pragma unroll 2
        for (int c = 0; c < 8; ++c) { float kl[8];
#pragma unroll
            for (int j = 0; j < 8; ++j) { const int t = 8 * c + j; const float gv = gp[t * 256]; P += gv; const float bc = dir == 0 ? P : total - P + gv; bcp[t * 512] = bc; kl[j] = bf2f(kp[t * 256]) * __expf(total - bc); }
            v4u v; v.x = cvtpk(kl[0], kl[1]); v.y = cvtpk(kl[2], kl[3]); v.z = cvtpk(kl[4], kl[5]); v.w = cvtpk(kl[6], kl[7]);
            *(LAS v4u*)(lds + w * 8192 + lane * 128 + ((c ^ ((lane >> 1) & 7)) * 16)) = v; }
        DECB[(size_t)(chain * 68 + cpos) * 64 + lane] = __expf(total);
    }
    gla_vt_image(ws, lds + 65536, rb, tid);
    __syncthreads();
    {
        const int r = lane & 31, hh = lane >> 5;
        bf16x8 bfr[2][4];
#pragma unroll
        for (int dt = 0; dt < 2; ++dt)
#pragma unroll
            for (int ks = 0; ks < 4; ++ks) { const int d = 32 * dt + r; bfr[dt][ks] = *(const LAS bf16x8*)(lds + w * 8192 + d * 128 + (((2 * ks + hh) ^ ((d >> 1) & 7)) * 16)); }
        float* dsp = DSB + (size_t)(chain * 68 + cpos) * 8192 + (4 * hh) * 64 + r;
#pragma unroll 1
        for (int et = 0; et < 4; ++et) {
            f32x16 acc[2];
#pragma unroll
            for (int i = 0; i < 16; ++i) { acc[0][i] = 0.f; acc[1][i] = 0.f; }
            const int eg = h * 128 + 32 * et + r;
#pragma unroll
            for (int ks = 0; ks < 4; ++ks) { const bf16x8 a = *(const LAS bf16x8*)(lds + 65536 + eg * 128 + (((2 * ks + hh) ^ ((eg >> 1) & 7)) * 16));
                acc[0] = MFMA32(a, bfr[0][ks], acc[0]); acc[1] = MFMA32(a, bfr[1][ks], acc[1]); }
#pragma unroll
            for (int dt = 0; dt < 2; ++dt)
#pragma unroll
                for (int i = 0; i < 16; ++i) dsp[(32 * et) * 64 + ((i & 3) + 8 * (i >> 2)) * 64 + 32 * dt] = acc[dt][i];
        }
    }
    __syncthreads();
}
__device__ __forceinline__ void gla_c3_unit(unsigned char* ws, const float* const* in, LAS unsigned char* lds, const int l, const int b, const int ts, const int tid) {
    const int lane = tid & 63, w = __builtin_amdgcn_readfirstlane(tid >> 6), h = w >> 1, eh = w & 1, r = lane & 31, hh = lane >> 5;
    const int rb = gla_rowbase(b, ts);
    gla_vt_image(ws, lds, rb, tid);
    __syncthreads();
    f32x16 acc[2][2];
#pragma unroll
    for (int a = 0; a < 2; ++a)
#pragma unroll
        for (int c = 0; c < 2; ++c)
#pragma unroll
            for (int i = 0; i < 16; ++i) acc[a][c][i] = 0.f;
#pragma unroll 1
    for (int dir = 0; dir < 2; ++dir) {
        const int chain = (dir * 4 + b) * 4 + h, cpos = chain_pos(dir, ts);
        bf16x8 QD[2][4], KD[2][4];
#pragma unroll
        for (int tile = 0; tile < 2; ++tile) {
            const size_t row = (size_t)(rb + 32 * tile + r);
#pragma unroll
            for (int ks = 0; ks < 4; ++ks) { const int d0 = 16 * ks + 8 * hh;
                const v4u qv = *(const v4u*)(Qb + row * 256 + h * 64 + d0), kv = *(const v4u*)(Kb + row * 256 + h * 64 + d0);
                const float* bp = BCB + row * 512 + dir * 256 + h * 64 + d0; const f32x4 b0 = *(const f32x4*)bp, b1 = *(const f32x4*)(bp + 4);
                f32x4 qa, qb, ka, kb; unpack8(qv, qa, qb); unpack8(kv, ka, kb);
                f32x4 e0, e1, i0, i1;
#pragma unroll
                for (int j = 0; j < 4; ++j) { e0[j] = __expf(b0[j]); e1[j] = __expf(b1[j]); i0[j] = __expf(-b0[j]); i1[j] = __expf(-b1[j]); }
                qa = qa * e0; qb = qb * e1; ka = ka * i0; kb = kb * i1;
                v4u qp, kp; qp.x = cvtpk(qa[0], qa[1]); qp.y = cvtpk(qa[2], qa[3]); qp.z = cvtpk(qb[0], qb[1]); qp.w = cvtpk(qb[2], qb[3]);
                kp.x = cvtpk(ka[0], ka[1]); kp.y = cvtpk(ka[2], ka[3]); kp.z = cvtpk(kb[0], kb[1]); kp.w = cvtpk(kb[2], kb[3]);
                QD[tile][ks] = __builtin_bit_cast(bf16x8, qp); KD[tile][ks] = __builtin_bit_cast(bf16x8, kp);
                if (ks & 1) asm volatile("" ::: "memory"); }
        }
#pragma unroll
        for (int st = 0; st < 2; ++st) {
#pragma unroll
            for (int tt = 0; tt < 2; ++tt) {
                const bool dead = dir == 0 ? (st == 1 && tt == 0) : (st == 0 && tt == 1);
                if (!dead) {
                    f32x16 at;
#pragma unroll
                    for (int i = 0; i < 16; ++i) at[i] = 0.f;
#pragma unroll
                    for (int ks = 0; ks < 4; ++ks) at = MFMA32(KD[st][ks], QD[tt][ks], at);
                    const int tq = 32 * tt + r;
#pragma unroll
                    for (int i = 0; i < 16; ++i) { const int sq = 32 * st + (i & 3) + 8 * (i >> 2) + 4 * hh; const bool keep = dir == 0 ? (sq <= tq) : (sq >= tq); at[i] = keep ? at[i] : 0.f; }
#pragma unroll
                    for (int sp = 0; sp < 2; ++sp) {
                        v4u pp; pp.x = cvtpk(at[8 * sp], at[8 * sp + 1]); pp.y = cvtpk(at[8 * sp + 2], at[8 * sp + 3]); pp.z = cvtpk(at[8 * sp + 4], at[8 * sp + 5]); pp.w = cvtpk(at[8 * sp + 6], at[8 * sp + 7]);
                        const bf16x8 p = __builtin_bit_cast(bf16x8, pp);
#pragma unroll
                        for (int et = 0; et < 2; ++et) { const int eg = h * 128 + 64 * eh + 32 * et + r, sw = (eg >> 1) & 7, c0 = 4 * st + 2 * sp;
                            const v2u lo = *(const LAS v2u*)(lds + eg * 128 + ((c0 ^ sw) * 16) + 8 * hh), hi = *(const LAS v2u*)(lds + eg * 128 + (((c0 + 1) ^ sw) * 16) + 8 * hh);
                            v4u av; av.x = lo.x; av.y = lo.y; av.z = hi.x; av.w = hi.y;
                            acc[et][tt] = MFMA32(__builtin_bit_cast(bf16x8, av), p, acc[et][tt]); }
                    }
                }
            }
        }
        const bf16* sst = SSTB + ((size_t)(chain * 68 + cpos) * 128 + 64 * eh) * 64;
#pragma unroll
        for (int et = 0; et < 2; ++et)
#pragma unroll
            for (int ks = 0; ks < 4; ++ks) { const bf16x8 a = *(const bf16x8*)(sst + (size_t)(32 * et + r) * 64 + 16 * ks + 8 * hh);
                acc[et][0] = MFMA32(a, QD[0][ks], acc[et][0]); acc[et][1] = MFMA32(a, QD[1][ks], acc[et][1]); }
    }
    float ss[2];
#pragma unroll
    for (int tt = 0; tt < 2; ++tt) { float s = 0.f;
#pragma unroll
        for (int et = 0; et < 2; ++et)
#pragma unroll
            for (int i = 0; i < 16; ++i) s += acc[et][tt][i] * acc[et][tt][i];
        s += __shfl_xor(s, 32); ss[tt] = s; }
    LAS float* sqb = (LAS float*)(lds + 65536);
    asm volatile("s_waitcnt lgkmcnt(0)" ::: "memory");
    if (hh == 0) { sqb[w * 64 + r] = ss[0]; sqb[w * 64 + 32 + r] = ss[1]; }
    __syncthreads();
    const float* gnw = in[I_GNW] + l * 128;
#pragma unroll
    for (int tt = 0; tt < 2; ++tt) {
        const float rstd = rsqrtf((ss[tt] + sqb[(w ^ 1) * 64 + 32 * tt + r]) * (1.f / 128.f) + EPS);
        const size_t row = (size_t)(rb + 32 * tt + r);
#pragma unroll
        for (int et = 0; et < 2; ++et)
#pragma unroll
            for (int a = 0; a < 4; ++a) { const int e0 = 64 * eh + 32 * et + 8 * a + 4 * hh; const f32x4 gn = *(const f32x4*)(gnw + e0);
                const v2u rr = *(const v2u*)(Rb + row * 512 + h * 128 + e0);
                v2u o; o.x = cvtpk(acc[et][tt][4 * a] * rstd * gn[0] * bflo(rr.x), acc[et][tt][4 * a + 1] * rstd * gn[1] * bfhi(rr.x));
                o.y = cvtpk(acc[et][tt][4 * a + 2] * rstd * gn[2] * bflo(rr.y), acc[et][tt][4 * a + 3] * rstd * gn[3] * bfhi(rr.y));
                *(v2u*)(OG + row * 512 + h * 128 + e0) = o; if (a & 1) asm volatile("" ::: "memory"); }
    }
    __syncthreads();
}

constexpr int NPH = 29;

__global__ void __launch_bounds__(NWAVES * 64, 2) fwd_kernel(Args args) {
    extern __shared__ __attribute__((aligned(16))) unsigned char lds_raw[];
    LAS unsigned char* lds = (LAS unsigned char*)lds_raw;
    volatile LAS unsigned* MISC = (volatile LAS unsigned*)(lds + MISC_OFF);
    const int G = gridDim.x; const int bx = blockIdx.x; const int vcu = (G % 8 == 0) ? (bx % 8) * (G / 8) + bx / 8 : bx;
    const int NGW = G * NWAVES;
    for (int i = threadIdx.x; i < (LDS_BYTES - LDSCTL_OFF) / 4; i += NWAVES * 64) ((LAS unsigned*)(lds + LDSCTL_OFF))[i] = 0u;
    __syncthreads();
    XcdBarrier bar; bar.bar = (unsigned*)(args.ws + WS_CTL) + CW_BAR; bar.x = 0; bar.st = nullptr;
    if (MK_ONE_LAUNCH) bar = xcd_barrier_post((unsigned*)(args.ws + WS_CTL) + CW_BAR, MISC + 8);
    const int lo = args.ph_lo, hi = args.ph_hi;
#define IN(k) (lo <= (k) && (k) < hi)
#define SEAM(k) do { if (lo <= (k) && (k) + 1 < hi) xcd_barrier(bar); } while (0)

    if (IN(0)) { PHASE_BEGIN();
        {
            LAS float* sil = (LAS float*)(lds + 73728);
            LAS float* red = (LAS float*)(lds + 73728 + 20480);
            for (int i = tid; i < 5 * 1024; i += 512) { const int bi = i >> 10, k = i & 1023; const float v = bi < 4 ? in[I_C][bi * 1024 + k] : in[I_CCTX][k]; sil[i] = siluf_(v); }
            __syncthreads();
            for (int it = vcu; it < 2 * 96; it += G) {
                const int l = it / 96, n0 = (it % 96) * 64, kk = lane >> 4, q = lane & 15;
                f32x4 a[5];
#pragma unroll
                for (int bi = 0; bi < 5; ++bi) a[bi] = (f32x4){0.f, 0.f, 0.f, 0.f};
                const float* wp = in[I_WMOD] + (size_t)l * 1024 * 6144 + n0 + 4 * q;
#pragma unroll 4
                for (int i2 = 0; i2 < 32; ++i2) { const int k = wave * 128 + i2 * 4 + kk; const f32x4 w = *(const f32x4*)(wp + (size_t)k * 6144);
#pragma unroll
                    for (int bi = 0; bi < 5; ++bi) a[bi] = a[bi] + w * sil[bi * 1024 + k]; }
#pragma unroll
                for (int bi = 0; bi < 5; ++bi)
#pragma unroll
                    for (int j = 0; j < 4; ++j) { float v = a[bi][j]; v += __shfl_xor(v, 16); v += __shfl_xor(v, 32); a[bi][j] = v; }
                if (lane < 16) {
#pragma unroll
                    for (int bi = 0; bi < 5; ++bi)
#pragma unroll
                        for (int j = 0; j < 4; ++j) red[(wave * 5 + bi) * 64 + 4 * q + j] = a[bi][j]; }
                __syncthreads();
                if (tid < 320) { const int bi = tid >> 6, cc = tid & 63; float s = 0.f;
#pragma unroll
                    for (int w = 0; w < 8; ++w) s += red[(w * 5 + bi) * 64 + cc];
                    MODV[(l * 5 + bi) * 6144 + n0 + cc] = s + in[I_BMOD][l * 6144 + n0 + cc]; }
                __syncthreads();
            }
        }
        for (int i = gw * 64 + lane; i < 2 * 2 * 32 * 64; i += NGW * 64) {
            const int p = i & 63, g = (i >> 6) & 31, dir = (i >> 11) & 1, l = i >> 12;
            const float* are = in[dir ? I_AREB : I_AREF]; const float* aim = in[dir ? I_AIMB : I_AIMF]; const float* ldt = in[dir ? I_LDTB : I_LDTF];
            const double ar = are[(l * 32 + g) * 64 + p], ai = aim[(l * 32 + g) * 64 + p], dt = exp((double)ldt[l * 32 + g]);
            const double mag = exp(ar * dt), lr = mag * cos(ai * dt), li = mag * sin(ai * dt);
            LAMB[i] = (f32x2){(float)lr, (float)li};
            const double nr = lr - 1.0, ni = li, den = ar * ar + ai * ai, cr = (nr * ar + ni * ai) / den, ci = (ni * ar - nr * ai) / den;
            const float* bre = in[I_BRE] + ((size_t)(l * 32 + g) * 64 + p) * 16; const float* bim = in[I_BIM] + ((size_t)(l * 32 + g) * 64 + p) * 16;
            bf16* bm = BMT + ((size_t)(((l * 2 + dir) * 32 + g) * 2 + (p >> 5)) * 2) * 512 + (p & 31) * 16;
            for (int j = 0; j < 16; ++j) { const double br = bre[j], bi2 = bim[j]; const float vr = (float)(cr * br - ci * bi2), vi = (float)(cr * bi2 + ci * br);
                BBAR[(size_t)i * 16 + j] = (f32x2){vr, vi}; bm[j] = (bf16)f2bf(vr); bm[512 + j] = (bf16)f2bf(vi); }
        }
        for (int i = gw * 64 + lane; i < 2 * 32 * 16 * 2 * 64; i += NGW * 64) {
            const int k = i & 63, ph = (i >> 6) & 1, hh = (i >> 7) & 15, g = (i >> 11) & 31, l = i >> 16, p = 32 * ph + (k >> 1);
            const size_t ci = ((size_t)(l * 32 + g) * 16 + hh) * 64 + p;
            CMT[i] = (bf16)f2bf((k & 1) ? -in[I_CIM][ci] : in[I_CRE][ci]);
        }
        for (int i = gw * 64 + lane; i < 2 * 2 * 256 * 128; i += NGW * 64) {
            const int kc = i & 127, n = (i >> 7) & 255, dir = (i >> 15) & 1, l = i >> 16;
            const float* lr = in[dir ? I_LRB : I_LRF] + (size_t)l * 16 * 256 + n; float lrv[16];
#pragma unroll
            for (int j = 0; j < 16; ++j) lrv[j] = lr[j * 256];
            float o[8];
#pragma unroll
            for (int kk = 0; kk < 8; ++kk) { const float* wr_ = in[I_WIN] + ((size_t)l * 1024 + kc * 8 + kk) * INW_SRC + 768 + 16 * dir; float s = 0.f;
#pragma unroll
                for (int j4 = 0; j4 < 4; ++j4) { const f32x4 w = *(const f32x4*)(wr_ + 4 * j4); s += w[0] * lrv[4 * j4] + w[1] * lrv[4 * j4 + 1] + w[2] * lrv[4 * j4 + 2] + w[3] * lrv[4 * j4 + 3]; }
                o[kk] = s; }
            v4u w; w.x = pk2(o[0], o[1]); w.y = pk2(o[2], o[3]); w.z = pk2(o[4], o[5]); w.w = pk2(o[6], o[7]);
            *(v4u*)((bf16*)(wb + W_IN) + ((size_t)l * INW + 768 + 256 * dir + n) * 1024 + kc * 8) = w;
        }
        {
            LAS float* scr = (LAS float*)(lds + wave * 9216);
            constexpr int IT_IN = 16 * 129, IT_GLU = 8 * 16, IT_P = 8 * 32, IT_OUT = 16 * 32, IT_F = 16 * 88, IT_FD = 44 * 32;
            constexpr int IT_L = IT_IN + IT_GLU + 2 * IT_P + IT_OUT, NIT = 2 * IT_L + 2 * IT_F + IT_FD;
            for (int it = gw; it < NIT; it += NGW) {
                int r = it;
                if (r < 2 * IT_L) { const int l = r / IT_L; r -= l * IT_L;
                    if (conv_matrix(r, in[I_WIN] + (size_t)l * 1024 * INW_SRC, 1024, INW_SRC, (bf16*)(wb + W_IN) + (size_t)l * INW * 1024, 1, 0, scr, lane)) continue;
                    if (conv_matrix(r, in[I_WGLU] + (size_t)l * 512 * 512, 512, 512, (bf16*)(wb + W_GLU) + (size_t)l * 512 * 512, 0, 0, scr, lane)) continue;
                    if (conv_matrix(r, in[I_WGP] + (size_t)l * 512 * 1024, 512, 1024, (bf16*)(wb + W_GP) + (size_t)l * 1024 * 512, 0, 0, scr, lane)) continue;
                    if (conv_matrix(r, in[I_WSP] + (size_t)l * 512 * 1024, 512, 1024, (bf16*)(wb + W_SP) + (size_t)l * 1024 * 512, 0, 0, scr, lane)) continue;
                    conv_matrix(r, in[I_WOUT] + (size_t)l * 1024 * 1024, 1024, 1024, (bf16*)(wb + W_OUT) + (size_t)l * 1024 * 1024, 0, 0, scr, lane); continue; }
                r -= 2 * IT_L;
                if (conv_matrix(r, in[I_FG], 1024, FFD, (bf16*)(wb + W_FGU), 2, 0, scr, lane)) continue;
                if (conv_matrix(r, in[I_FU], 1024, FFD, (bf16*)(wb + W_FGU), 2, 128, scr, lane)) continue;
                conv_matrix(r, in[I_FD], FFD, 1024, (bf16*)(wb + W_FD), 0, 0, scr, lane);
            }
        }
    }
    SEAM(0);

    for (int l = 0; l < 2; ++l) {
        const int pb = 1 + 11 * l;
#define MODVL (MODV + (size_t)l * 5 * 6144)
#define RES_L (l == 0 ? in[I_X] : (const float*)LATX)
#define RES_C (l == 0 ? in[I_CTX] : (const float*)(LATX + (size_t)NLAT * 1024))
        const int nrows = NROW;
        const int mpan = l == 0 ? NPAN : NLAT / 256;
        if (IN(pb + 0)) { PHASE_BEGIN();
            const float* nw = in[I_N1W] + l * 1024;
            for (int row = gw; row < nrows; row += NGW) {
                const float* xr = row < NLAT ? RES_L + (size_t)row * 1024 : RES_C + (size_t)(row - NLAT) * 1024;
                const int bi = row < NLAT ? row >> 12 : 4; const float* sh = MODVL + bi * 6144; const float* sc = sh + 1024;
                f32x4 v[4]; float ss = 0.f;
#pragma unroll
                for (int j = 0; j < 4; ++j) { v[j] = *(const f32x4*)(xr + 4 * lane + 256 * j); ss += v[j][0] * v[j][0] + v[j][1] * v[j][1] + v[j][2] * v[j][2] + v[j][3] * v[j][3]; }
                const float rstd = rsqrtf(wave_sum(ss) * (1.f / 1024.f) + EPS);
#pragma unroll
                for (int j = 0; j < 4; ++j) { const int c = 4 * lane + 256 * j; const f32x4 w = *(const f32x4*)(nw + c), s1 = *(const f32x4*)(sc + c), s0 = *(const f32x4*)(sh + c);
                    f32x4 y;
#pragma unroll
                    for (int e = 0; e < 4; ++e) y[e] = v[j][e] * rstd * w[e] * (1.f + s1[e]) + s0[e];
                    v2u o; o.x = pk2(y[0], y[1]); o.y = pk2(y[2], y[3]); *(v2u*)(XN + (size_t)row * 1024 + c) = o; }
            }
        }
        SEAM(pb + 0);
        if (IN(pb + 1)) { PHASE_BEGIN();
            pg8::Order S; S.init1(G, bx, XN, (bf16*)(wb + W_IN) + (size_t)l * INW * 1024, NPAN, 18, 1024);
            EpiInProj E{Kb, Vb, Ub, Qb, Rb, GAb, GMb, GF, GB, in[I_BIASF] + l * 256, in[I_BIASB] + l * 256};
            pg8::gemm_phase<EpiInProj, pg8::Order>(lds + RING_OFF, tid, 1024, S, E);
        }
        SEAM(pb + 1);
        if (IN(pb + 2)) { PHASE_BEGIN();
            for (int u = vcu; u < 4 * 68; u += G) gla_c1_unit(ws, lds, u / 68, u % 68, tid);
            for (int wu = gw; wu < 4 * 68 * 32; wu += NGW) {
                const int g = wu & 31, ts = (wu >> 5) % 68, b = (wu >> 5) / 68;
                s5_unit<0>(ws, in, lds + wave * 9216, l, b, ts, g, lane);
            }
        }
        SEAM(pb + 2);
        if (IN(pb + 3)) { PHASE_BEGIN();
            for (int i = gw * 64 + lane; i < 32 * 128 * 32; i += NGW * 64) {
                const int dp = i & 31, e = (i >> 5) & 127, chain = i >> 12;
                const float* dsp = DSB + (size_t)chain * 68 * 8192 + e * 64 + 2 * dp; bf16* sp = SSTB + (size_t)chain * 68 * 8192 + e * 64 + 2 * dp; const float* dcp = DECB + (size_t)chain * 68 * 64 + 2 * dp;
                float s0 = 0.f, s1 = 0.f;
#pragma unroll 4
                for (int c = 0; c < 68; ++c) { const f32x2 t = *(const f32x2*)(dsp + (size_t)c * 8192), dc = *(const f32x2*)(dcp + c * 64); *(unsigned*)(sp + (size_t)c * 8192) = cvtpk(s0, s1); s0 = dc[0] * s0 + t[0]; s1 = dc[1] * s1 + t[1]; }
            }
            for (int i = gw * 64 + lane; i < 2 * 4 * 32 * 64; i += NGW * 64) {
                const int p = i & 63, g = (i >> 6) & 31, dir = i >> 13;
                const f32x2 lam = LAMB[((l * 2 + dir) * 32 + g) * 64 + p];
                float ar = lam[0], ai = lam[1];
#pragma unroll
                for (int q = 0; q < 6; ++q) cmul(ar, ai, ar, ai);
                const f32x2* f = S5F + (size_t)(i >> 6) * 68 * 64 + p; f32x2* fo = S5H + (size_t)(i >> 6) * 68 * 64 + p;
                float hr = 0.f, hi_ = 0.f;
                for (int c = 0; c < 68; ++c) { const f32x2 t = f[c * 64]; fo[c * 64] = (f32x2){hr, hi_}; const float nr = ar * hr - ai * hi_ + t[0], ni = ar * hi_ + ai * hr + t[1]; hr = nr; hi_ = ni; }
            }
        }
        SEAM(pb + 3);
        if (IN(pb + 4)) { PHASE_BEGIN();
            {
                const int skip = l == 1 ? 4 : 0, nts = 68 - skip;
                for (int u = vcu; u < 4 * nts; u += G) gla_c3_unit(ws, in, lds, l, u / nts, skip + u % nts, tid);
                for (int wu = vcu; wu < 4 * nts * 4; wu += G) {
                    const int g = 8 * (wu & 3) + wave, ts = skip + (wu >> 2) % nts, b = (wu >> 2) / nts;
                    s5_unit<1>(ws, in, lds + wave * 9216, l, b, ts, g, lane);
                }
            }
        }
        SEAM(pb + 4);
        if (IN(pb + 5)) { PHASE_BEGIN();
            pg8::Order S; S.init1(G, bx, SG, (bf16*)(wb + W_GLU) + (size_t)l * 512 * 512, mpan, 2, 512);
            S.A1 = (const char*)OG; S.B1 = (const char*)((bf16*)(wb + W_GP) + (size_t)l * 1024 * 512); S.nM1 = mpan; S.nN1 = 4; S.kind1 = 1;
            EpiD12 E{SG, S2, in[I_BGLU] + l * 512, GAb, Tb};
            pg8::gemm_phase<EpiD12, pg8::Order>(lds + RING_OFF, tid, 512, S, E);
        }
        SEAM(pb + 5);
        if (IN(pb + 6)) { PHASE_BEGIN();
            pg8::Order S; S.init1(G, bx, S2, (bf16*)(wb + W_SP) + (size_t)l * 1024 * 512, mpan, 4, 512);
            EpiD3 E{Tb, GMb, XN};
            pg8::gemm_phase<EpiD3, pg8::Order>(lds + RING_OFF, tid, 512, S, E);
        }
        SEAM(pb + 6);
        if (IN(pb + 7)) { PHASE_BEGIN();
            pg8::Order S; S.init1(G, bx, XN, (bf16*)(wb + W_OUT) + (size_t)l * 1024 * 1024, mpan, 4, 1024);
            EpiResid E{RES_L, RES_C, LATX, MODVL, 2};
            pg8::gemm_phase<EpiResid, pg8::Order>(lds + RING_OFF, tid, 1024, S, E);
        }
        SEAM(pb + 7);
        if (IN(pb + 8)) { PHASE_BEGIN();
            const float* nw = in[I_N2W] + l * 1024;
            LAS float* rw = (LAS float*)(lds);
            if (l == 1) { for (int i = tid; i < 8192; i += 512) rw[i] = in[I_ROUTER][i]; __syncthreads(); }
            const int nr2 = l == 0 ? NROW : NLAT;
            for (int row = gw; row < nr2; row += NGW) {
                const float* xr = LATX + (size_t)row * 1024;
                const int bi = row < NLAT ? row >> 12 : 4; const float* sh = MODVL + bi * 6144 + 3 * 1024; const float* sc = sh + 1024;
                f32x4 v[4]; float ss = 0.f;
#pragma unroll
                for (int j = 0; j < 4; ++j) { v[j] = *(const f32x4*)(xr + 4 * lane + 256 * j); ss += v[j][0] * v[j][0] + v[j][1] * v[j][1] + v[j][2] * v[j][2] + v[j][3] * v[j][3]; }
                const float rstd = rsqrtf(wave_sum(ss) * (1.f / 1024.f) + EPS);
                float lg[8];
#pragma unroll
                for (int e = 0; e < 8; ++e) lg[e] = 0.f;
#pragma unroll
                for (int j = 0; j < 4; ++j) { const int c = 4 * lane + 256 * j; const f32x4 w = *(const f32x4*)(nw + c), s1 = *(const f32x4*)(sc + c), s0 = *(const f32x4*)(sh + c);
                    f32x4 y;
#pragma unroll
                    for (int e = 0; e < 4; ++e) y[e] = v[j][e] * rstd * w[e] * (1.f + s1[e]) + s0[e];
                    if (l == 0) { v2u o; o.x = pk2(y[0], y[1]); o.y = pk2(y[2], y[3]); *(v2u*)(XN + (size_t)row * 1024 + c) = o; }
                    else {
#pragma unroll
                        for (int e = 0; e < 4; ++e) { const f32x4 r0 = *(const LAS f32x4*)(rw + (c + e) * 8), r1 = *(const LAS f32x4*)(rw + (c + e) * 8 + 4);
                            lg[0] += y[e] * r0[0]; lg[1] += y[e] * r0[1]; lg[2] += y[e] * r0[2]; lg[3] += y[e] * r0[3]; lg[4] += y[e] * r1[0]; lg[5] += y[e] * r1[1]; lg[6] += y[e] * r1[2]; lg[7] += y[e] * r1[3]; } } }
                if (l == 1) {
#pragma unroll
                    for (int e = 0; e < 8; ++e) lg[e] = wave_sum(lg[e]);
                    int e1 = 0; float v1 = lg[0];
#pragma unroll
                    for (int e = 1; e < 8; ++e) if (lg[e] > v1) { v1 = lg[e]; e1 = e; }
                    int e2 = -1; float v2 = -3.0e38f;
#pragma unroll
                    for (int e = 0; e < 8; ++e) if (e != e1 && lg[e] > v2) { v2 = lg[e]; e2 = e; }
                    if (lane == 0) {
                        const float w1 = 1.f / (1.f + __expf(v2 - v1));
                        const int p1 = (int)__hip_atomic_fetch_add(ctl + CW_CNT + 64 * e1, 1u, RLX_AGENT), p2 = (int)__hip_atomic_fetch_add(ctl + CW_CNT + 64 * e2, 1u, RLX_AGENT);
                        TOKE[row] = make_int4(e1, p1, e2, p2); TOKW[row] = (f32x2){w1, 1.f - w1};
                    }
                }
            }
        }
        SEAM(pb + 8);
        if (l == 0) {
            if (IN(10)) { PHASE_BEGIN();
                pg8::Order S; S.init1(G, bx, XN, (bf16*)(wb + W_FGU), NPAN, 22, 1024);
                EpiSwiglu E{HMID, FFD, 0};
                pg8::gemm_phase<EpiSwiglu, pg8::Order>(lds + RING_OFF, tid, 1024, S, E);
            }
            SEAM(10);
            if (IN(11)) { PHASE_BEGIN();
                pg8::Order S; S.init1(G, bx, HMID, (bf16*)(wb + W_FD), NPAN, 4, FFD);
                EpiResid E{LATX, LATX + (size_t)NLAT * 1024, LATX, MODVL, 5};
                pg8::gemm_phase<EpiResid, pg8::Order>(lds + RING_OFF, tid, FFD, S, E);
            }
            SEAM(11);
        }
    }

    int pbase[9];
    {
        int a = 0;
#pragma unroll
        for (int e = 0; e < 8; ++e) { pbase[e] = a; const unsigned c = hi > 21 ? __hip_atomic_load((gu32*)(args.ws + WS_CTL) + CW_CNT + 64 * e, RLX_AGENT) : 0u; a += (int)((c + 255u) >> 8); }
        pbase[8] = a;
    }
    if (IN(21)) { PHASE_BEGIN();
        {
            LAS float* scr = (LAS float*)(lds + wave * 9216);
            constexpr int IT_G = 16 * 112, IT_D = 56 * 32, IT_E = 2 * IT_G + IT_D;
            for (int it = gw; it < 8 * IT_E; it += NGW) {
                const int e = it / IT_E; int r = it - e * IT_E;
                if (conv_matrix(r, in[I_MG] + (size_t)e * 1024 * FFE, 1024, FFE, WMGU + (size_t)e * 7168 * 1024, 2, 0, scr, lane)) continue;
                if (conv_matrix(r, in[I_MU] + (size_t)e * 1024 * FFE, 1024, FFE, WMGU + (size_t)e * 7168 * 1024, 2, 128, scr, lane)) continue;
                conv_matrix(r, in[I_MD] + (size_t)e * FFE * 1024, FFE, 1024, WMD + (size_t)e * 1024 * FFE, 0, 0, scr, lane);
            }
        }
        const float* modv = MODV + (size_t)5 * 6144; const float* nw = in[I_N2W] + 1024;
        for (int row = gw; row < NLAT; row += NGW) {
            const float* xr = LATX + (size_t)row * 1024;
            const int bi = row >> 12; const float* sh = modv + bi * 6144 + 3 * 1024; const float* sc = sh + 1024;
            f32x4 v[4]; float ss = 0.f;
#pragma unroll
            for (int j = 0; j < 4; ++j) { v[j] = *(const f32x4*)(xr + 4 * lane + 256 * j); ss += v[j][0] * v[j][0] + v[j][1] * v[j][1] + v[j][2] * v[j][2] + v[j][3] * v[j][3]; }
            const float rstd = rsqrtf(wave_sum(ss) * (1.f / 1024.f) + EPS);
            const int4 te = TOKE[row];
            int s1 = 0, s2 = 0;
#pragma unroll
            for (int e = 0; e < 8; ++e) { if (te.x == e) s1 = pbase[e] * 256 + te.y; if (te.z == e) s2 = pbase[e] * 256 + te.w; }
            if (lane == 0) TOKS[row] = make_int2(s1, s2);
#pragma unroll
            for (int j = 0; j < 4; ++j) { const int c = 4 * lane + 256 * j; const f32x4 w = *(const f32x4*)(nw + c), a1 = *(const f32x4*)(sc + c), a0 = *(const f32x4*)(sh + c);
                f32x4 y;
#pragma unroll
                for (int e = 0; e < 4; ++e) y[e] = v[j][e] * rstd * w[e] * (1.f + a1[e]) + a0[e];
                v2u o; o.x = pk2(y[0], y[1]); o.y = pk2(y[2], y[3]); *(v2u*)(XG + (size_t)s1 * 1024 + c) = o; *(v2u*)(XG + (size_t)s2 * 1024 + c) = o; }
        }
    }
    SEAM(21);
    for (int g = 0; g < 3; ++g) {
        const int p0 = 64 * g, np = pbase[8] - p0 < 64 ? (pbase[8] - p0 < 0 ? 0 : pbase[8] - p0) : 64;
        if (IN(22 + 2 * g)) { PHASE_BEGIN();
            pg8::Order S; S.init1(G, bx, XG, WMGU, np, 28, 1024);
            S.pm0 = p0; S.moe = 1; S.pb1 = pbase[1]; S.pb2 = pbase[2]; S.pb3 = pbase[3]; S.pb4 = pbase[4]; S.pb5 = pbase[5]; S.pb6 = pbase[6]; S.pb7 = pbase[7]; S.estride = (size_t)7168 * 1024 * 2;
            EpiSwiglu E{HM, FFE, p0};
            pg8::gemm_phase<EpiSwiglu, pg8::Order>(lds + RING_OFF, tid, 1024, S, E);
        }
        SEAM(22 + 2 * g);
        if (IN(23 + 2 * g)) { PHASE_BEGIN();
            pg8::Order S; S.init1(G, bx, HM, WMD, np, 4, FFE);
            S.pm0 = p0; S.apm0 = p0; S.moe = 1; S.pb1 = pbase[1]; S.pb2 = pbase[2]; S.pb3 = pbase[3]; S.pb4 = pbase[4]; S.pb5 = pbase[5]; S.pb6 = pbase[6]; S.pb7 = pbase[7]; S.estride = (size_t)1024 * FFE * 2;
            EpiPlain E{YS};
            pg8::gemm_phase<EpiPlain, pg8::Order>(lds + RING_OFF, tid, FFE, S, E);
        }
        SEAM(23 + 2 * g);
    }
    if (IN(28)) { PHASE_BEGIN();
        const float* modv = MODV + (size_t)5 * 6144; const float* fw = in[I_FNW];
        for (int row = gw; row < NLAT; row += NGW) {
            const float* xr = LATX + (size_t)row * 1024; const int bi = row >> 12; const float* g2 = modv + bi * 6144 + 5 * 1024;
            const int2 sl = TOKS[row]; const f32x2 tw = TOKW[row];
            f32x4 v[4]; float ss = 0.f;
#pragma unroll
            for (int j = 0; j < 4; ++j) { const int c = 4 * lane + 256 * j; const f32x4 x = *(const f32x4*)(xr + c), gg = *(const f32x4*)(g2 + c);
                const v2u y1 = *(const v2u*)(YS + (size_t)sl.x * 1024 + c), y2 = *(const v2u*)(YS + (size_t)sl.y * 1024 + c);
                const f32x4 a = (f32x4){bflo(y1.x), bfhi(y1.x), bflo(y1.y), bfhi(y1.y)}, bq = (f32x4){bflo(y2.x), bfhi(y2.x), bflo(y2.y), bfhi(y2.y)};
                v[j] = x + gg * (a * tw[0] + bq * tw[1]);
                ss += v[j][0] * v[j][0] + v[j][1] * v[j][1] + v[j][2] * v[j][2] + v[j][3] * v[j][3]; }
            const float rstd = rsqrtf(wave_sum(ss) * (1.f / 1024.f) + EPS);
#pragma unroll
            for (int j = 0; j < 4; ++j) { const int c = 4 * lane + 256 * j; const f32x4 w = *(const f32x4*)(fw + c); *(f32x4*)(args.out + (size_t)row * 1024 + c) = v[j] * rstd * w; }
        }
    }
#undef IN
#undef SEAM
}

extern "C" void kernel_launch(void* const* d_in, const int* in_sizes, int n_in, void* d_out, int out_size, void* d_ws, size_t ws_size, hipStream_t stream) {
    static int grid = 0;
    if (grid == 0) {
        if (n_in != N_IN || out_size != NLAT * D || ws_size < WS_END) { fprintf(stderr, "kernel_launch: unexpected shapes (n_in %d, out %d, ws %zu)\n", n_in, out_size, ws_size); grid = -1; return; }
        int dev = 0, cus = 0, per_cu = 0;
        if (hipGetDevice(&dev) != hipSuccess || hipDeviceGetAttribute(&cus, hipDeviceAttributeMultiprocessorCount, dev) != hipSuccess) { grid = -1; return; }
        if (hipFuncSetAttribute((const void*)fwd_kernel, hipFuncAttributeMaxDynamicSharedMemorySize, LDS_BYTES) != hipSuccess) { fprintf(stderr, "kernel_launch: hipFuncSetAttribute failed\n"); grid = -1; return; }
        if (hipOccupancyMaxActiveBlocksPerMultiprocessor(&per_cu, (const void*)fwd_kernel, NWAVES * 64, LDS_BYTES) != hipSuccess || per_cu < 1) fprintf(stderr, "kernel_launch: occupancy query reports %d\n", per_cu);
        (void)hipGetLastError();
        grid = cus;
    }
    if (grid < 0) return;
    if (hipMemsetAsync((char*)d_ws + WS_CTL, 0, CTL_ZERO_BYTES, stream) != hipSuccess) return;
    Args a{};
    for (int i = 0; i < N_IN; ++i) a.in[i] = (const float*)d_in[i];
    a.out = (float*)d_out; a.ws = (unsigned char*)d_ws;
#if MK_ONE_LAUNCH
    a.ph_lo = 0; a.ph_hi = NPH;
    hipLaunchKernelGGL(fwd_kernel, dim3(grid), dim3(NWAVES * 64), LDS_BYTES, stream, a);
#else
    for (int p = 0; p < NPH; ++p) { a.ph_lo = p; a.ph_hi = p + 1; hipLaunchKernelGGL(fwd_kernel, dim3(grid), dim3(NWAVES * 64), LDS_BYTES, stream, a); }
#endif
}
```

```cpp
#include <hip/hip_runtime.h>
#include <cstdio>
#include <cstdint>

#ifndef MK_ONE_LAUNCH
#define MK_ONE_LAUNCH 1
#endif

namespace pg8 {
#define PG8_LAS __attribute__((address_space(3)))
typedef unsigned short bf16_t;
typedef short bf16x8 __attribute__((ext_vector_type(8)));
typedef float f32x4 __attribute__((ext_vector_type(4)));
typedef unsigned u32x4 __attribute__((ext_vector_type(4)));
constexpr int BM = 256, BK = 64, HALF = 128, HTB = HALF * BK * 2, STAGE_BYTES = 8 * HTB, NXCD = 8, WGM = 8;

__host__ __device__ __forceinline__ int lds_byte(int r, int c) { const int st = (r >> 4) * 2 + (c >> 5), rr = r & 15, cc = c & 31, ob = rr * 64 + cc * 2; return st * 1024 + (ob ^ (((ob >> 9) & 1) << 5)); }
__host__ __device__ __forceinline__ void stage_rc(int b, int& R, int& C) { const int st = b / 1024, sb = b % 1024, swz = sb ^ (((sb >> 9) & 1) << 5); R = (st >> 1) * 16 + swz / 64; C = (st & 1) * 32 + (swz % 64) / 2; }
__host__ __device__ __forceinline__ int perm32(int rho) { const int n = rho >> 4, i = rho & 15; return 8 * (i >> 2) + 4 * n + (i & 3); }

struct Unit { int pm, pn, kind, nt, slice, par; const char* A; const char* B; };

struct Order {
    int G, c;
    int n0;
    const char* A0; const char* B0; int nM0, nN0, kind0;
    const char* A1; const char* B1; int nM1, nN1, kind1;
    size_t tstep;
    int pm0;
    int pm1off;
    int apm0;
    int moe; int pb1, pb2, pb3, pb4, pb5, pb6, pb7; size_t estride;
    int nelo; size_t elo;
    int nt0, nt1;
    int ksl1; size_t kbytes1;
    __device__ __forceinline__ void init1(int G_, int c_, const void* A, const void* B, int nM, int nN, int K) {
        G = G_; c = c_; A0 = (const char*)A; B0 = (const char*)B; nM0 = nM; nN0 = nN; kind0 = 0; n0 = nM * nN; A1 = A0; B1 = B0; nM1 = 0; nN1 = 1; kind1 = 1;
        tstep = (size_t)256 * K * 2; pm0 = 0; pm1off = 0; apm0 = 0; moe = 0; pb1 = pb2 = pb3 = pb4 = pb5 = pb6 = pb7 = 0; estride = 0; nelo = 0; elo = 0; nt0 = nt1 = K / BK; ksl1 = 1; kbytes1 = 0; }
    __device__ __forceinline__ bool next(int i, Unit& u) const {
        long L = (long)i * G + c; const bool s = L >= n0; if (s) L -= n0;
        const int nM = s ? nM1 : nM0, nN = s ? nN1 : nN0, nwg = nM * nN; const int ksl = s ? ksl1 : 1; if (L >= (long)nwg * ksl) return false;
        const int slice = (int)(L % ksl); L /= ksl;
        int wgid = (int)L; { const int q = nwg / NXCD, r = nwg % NXCD, xcd = wgid % NXCD, off = wgid / NXCD; wgid = (xcd < r ? xcd * (q + 1) : r * (q + 1) + (xcd - r) * q) + off; }
        const int nig = WGM * nN, gid = wgid / nig, fm = gid * WGM, gsz = (nM - fm) < WGM ? (nM - fm) : WGM;
        const int pm = pm0 + (s ? pm1off : 0) + fm + ((wgid % nig) % gsz), pn = (wgid % nig) / gsz;
        u.pm = pm; u.pn = pn; u.kind = s ? kind1 : kind0; u.nt = s ? nt1 : nt0; u.slice = slice;
        u.A = (s ? A1 : A0) + (size_t)(pm - apm0) * tstep + (size_t)slice * kbytes1;
        const char* b = (s ? B1 : B0) + (size_t)pn * tstep + (size_t)slice * kbytes1;
        if (moe) { const int e = (pm >= pb1) + (pm >= pb2) + (pm >= pb3) + (pm >= pb4) + (pm >= pb5) + (pm >= pb6) + (pm >= pb7); b += (size_t)e * estride + (e < nelo ? elo : (size_t)0); }
        u.B = b; return true;
    }
    __device__ __forceinline__ void a_ready(const Unit&) const {}
    __device__ __forceinline__ void done(const Unit&) const {}
};

__device__ __forceinline__ unsigned cvt_pk_bf16(float lo, float hi) { unsigned r; asm volatile("v_cvt_pk_bf16_f32 %0, %1, %2" : "=v"(r) : "v"(lo), "v"(hi)); return r; }

typedef int i32x4 __attribute__((ext_vector_type(4)));
typedef int i32x8 __attribute__((ext_vector_type(8)));
__device__ __forceinline__ i32x8 cat32(bf16x8 a, bf16x8 b) { return __builtin_shufflevector(__builtin_bit_cast(i32x4, a), __builtin_bit_cast(i32x4, b), 0, 1, 2, 3, 4, 5, 6, 7); }
template <class E> struct epi_has_pre { template <class T> static auto t(int) -> decltype(&T::pre, char()); template <class T> static long t(...); static constexpr bool value = sizeof(t<E>(0)) == 1; };
template <class Epi, class Sched, bool MIXED = false, bool ALIGN_EPI = true, bool SP2 = true, int QM = 0>
__device__ __forceinline__ void gemm_phase(PG8_LAS unsigned char* lds, const int tid, const int K, const Sched& S, const Epi& E) {
    const int wid = __builtin_amdgcn_readfirstlane(tid >> 6), lane = tid & 63, wr = wid >> 2, wc = wid & 3, fr = lane & 15, fq = lane >> 4;
    unsigned voffA[2], voffB[2];
#pragma unroll
    for (int i = 0; i < 2; ++i) { int R, C; stage_rc(tid * 16 + i * 8192, R, C); const int Rb = ((R & ~31) + perm32(R & 31));
        voffA[i] = (unsigned)(R * K + C) * 2u; voffB[i] = (unsigned)(Rb * K + C) * 2u; }
    const size_t kstep = (size_t)(BK * 2);
    const size_t hstep = (size_t)HALF * K * 2;
    const unsigned ldsw = (unsigned)wid * 1024u;
    const int aoff = lds_byte(wr * 64 + fr, fq * 8), boff = lds_byte(wc * 32 + fr, fq * 8);
#define PG8_SA(b, h) (((b) * 2 + (h)) * HTB)
#define PG8_SB(b, h) ((4 + (b) * 2 + (h)) * HTB)
#define PG8_STAGE(bufoff, gbase, voff) do { _Pragma("unroll") for (int _i = 0; _i < 2; ++_i) \
        __builtin_amdgcn_global_load_lds((const unsigned*)((const char*)(gbase) + (voff)[_i]), (PG8_LAS unsigned*)(lds + (bufoff) + ldsw + _i * 8192), 16, 0, 0); } while (0)
#define PG8_LDA(dst, b, h) do { _Pragma("unroll") for (int m = 0; m < 4; ++m) _Pragma("unroll") for (int k = 0; k < 2; ++k) dst[m][k] = *(const PG8_LAS bf16x8*)(lds + PG8_SA(b, h) + aoff + m * 2048 + k * 1024); } while (0)
#define PG8_LDB(dst, b, h) do { _Pragma("unroll") for (int n = 0; n < 2; ++n) _Pragma("unroll") for (int k = 0; k < 2; ++k) dst[n][k] = *(const PG8_LAS bf16x8*)(lds + PG8_SB(b, h) + boff + n * 2048 + k * 1024); } while (0)
#define PG8_MMA(ai, bj, At, Bt) do { __builtin_amdgcn_s_setprio(1); \
        if constexpr (QM == 2) { _Pragma("unroll") for (int k = 0; k < 2; ++k) _Pragma("unroll") for (int m = 0; m < 4; ++m) _Pragma("unroll") for (int n = 0; n < 2; ++n) \
            asm volatile("v_mfma_i32_16x16x64_i8 %0, %1, %2, %0" : "+v"(acc[ai][bj][m][n]) : "v"(Bt[n][k]), "v"(At[m][k])); } \
        _Pragma("unroll") for (int m = 0; m < 4; ++m) _Pragma("unroll") for (int n = 0; n < 2; ++n) { \
        if constexpr (QM == 1) asm volatile("v_mfma_f32_16x16x128_f8f6f4 %0, %1, %2, %0" : "+v"(acc[ai][bj][m][n]) : "v"(cat32(Bt[n][0], Bt[n][1])), "v"(cat32(At[m][0], At[m][1]))); \
        else if constexpr (QM == 2) { } \
        else { _Pragma("unroll") for (int k = 0; k < 2; ++k) acc[ai][bj][m][n] = __builtin_amdgcn_mfma_f32_16x16x32_bf16(Bt[n][k], At[m][k], acc[ai][bj][m][n], 0, 0, 0); } } __builtin_amdgcn_s_setprio(0); } while (0)
#define PG8_WAIT_V(n) asm volatile("s_waitcnt vmcnt(" #n ")" ::: "memory")
#define PG8_WAIT_L(n) asm volatile("s_waitcnt lgkmcnt(" #n ")" ::: "memory")
#define PG8_BAR __builtin_amdgcn_s_barrier()
#define PG8_SCHED __builtin_amdgcn_sched_barrier(0)
    Unit cur, nxt; int ui = 0;
    if (!S.next(0, cur)) return;
    f32x4 acc[2][2][4][2];
#pragma unroll
    for (int a = 0; a < 2; ++a)
#pragma unroll
        for (int b = 0; b < 2; ++b)
#pragma unroll
            for (int m = 0; m < 4; ++m)
#pragma unroll
                for (int n = 0; n < 2; ++n) acc[a][b][m][n] = (f32x4){0.f, 0.f, 0.f, 0.f};
    bf16x8 At[4][2], B0[2][2], B1[2][2];
    const char* cA = cur.A; const char* cB = cur.B;
    cur.par = 0;
    if constexpr (epi_has_pre<Epi>::value) E.pre(cur, wid, lane);
    S.a_ready(cur);
    if constexpr (SP2) {
        PG8_STAGE(PG8_SB(0, 0), cB, voffB); PG8_STAGE(PG8_SB(0, 1), cB + hstep, voffB); PG8_STAGE(PG8_SA(0, 0), cA, voffA); PG8_STAGE(PG8_SA(0, 1), cA + hstep, voffA);
        if (wr == 1) PG8_BAR;
        PG8_WAIT_V(2); PG8_BAR;
        PG8_STAGE(PG8_SB(1, 0), cB + kstep, voffB); PG8_STAGE(PG8_SA(1, 0), cA + kstep, voffA); PG8_STAGE(PG8_SB(1, 1), cB + hstep + kstep, voffB);
        PG8_WAIT_V(6); PG8_BAR;
    } else {
        PG8_STAGE(PG8_SB(0, 0), cB, voffB); PG8_STAGE(PG8_SA(0, 0), cA, voffA); PG8_STAGE(PG8_SB(0, 1), cB + hstep, voffB); PG8_STAGE(PG8_SA(0, 1), cA + hstep, voffA);
        if (wr == 1) PG8_BAR;
        PG8_WAIT_V(4); PG8_BAR;
        PG8_STAGE(PG8_SB(1, 0), cB + kstep, voffB); PG8_STAGE(PG8_SA(1, 0), cA + kstep, voffA); PG8_STAGE(PG8_SB(1, 1), cB + hstep + kstep, voffB);
        PG8_WAIT_V(6); PG8_BAR;
    }
    for (;;) {
        const bool has_next = S.next(ui + 1, nxt);
        const char* nA = has_next ? nxt.A : cA; const char* nB = has_next ? nxt.B : cB;
        int nt = MIXED ? cur.nt : K / BK;
        if constexpr (QM != 0) asm volatile("" : "+s"(nt));
        for (int t = 0; t < nt; t += 2) {
            const bool last = (t == nt - 2);
            const char* a1 = cA + (size_t)(t + 1) * kstep;
            const char* a2 = last ? nA : cA + (size_t)(t + 2) * kstep; const char* b2 = last ? nB : cB + (size_t)(t + 2) * kstep;
            const char* a3 = a2 + kstep; const char* b3 = b2 + kstep;
            if (last && has_next) S.a_ready(nxt);
            if constexpr (SP2) {
            PG8_LDB(B0, 0, 0); PG8_LDB(B1, 0, 1); PG8_SCHED; PG8_LDA(At, 0, 0); PG8_STAGE(PG8_SA(1, 1), a1 + hstep, voffA);
            PG8_WAIT_V(8); PG8_WAIT_L(0); PG8_BAR; PG8_MMA(0, 0, At, B0); PG8_MMA(0, 1, At, B1); PG8_BAR; PG8_SCHED;
            PG8_LDA(At, 0, 1); PG8_STAGE(PG8_SB(0, 0), b2, voffB); PG8_STAGE(PG8_SB(0, 1), b2 + hstep, voffB); PG8_STAGE(PG8_SA(0, 0), a2, voffA);
            PG8_WAIT_V(8); PG8_WAIT_L(0); PG8_BAR; PG8_MMA(1, 0, At, B0); PG8_MMA(1, 1, At, B1); PG8_BAR; PG8_SCHED;
            PG8_LDB(B0, 1, 0); PG8_LDB(B1, 1, 1); PG8_SCHED; PG8_LDA(At, 1, 0); PG8_STAGE(PG8_SA(0, 1), a2 + hstep, voffA);
            PG8_WAIT_V(8); PG8_WAIT_L(0); PG8_BAR; PG8_MMA(0, 0, At, B0); PG8_MMA(0, 1, At, B1); PG8_BAR; PG8_SCHED;
            PG8_LDA(At, 1, 1); PG8_STAGE(PG8_SB(1, 0), b3, voffB); PG8_STAGE(PG8_SB(1, 1), b3 + hstep, voffB); PG8_STAGE(PG8_SA(1, 0), a3, voffA);
            PG8_WAIT_V(8); PG8_WAIT_L(0); PG8_BAR; PG8_MMA(1, 0, At, B0); PG8_MMA(1, 1, At, B1); PG8_BAR; PG8_SCHED;
            } else {
            PG8_LDB(B0, 0, 0); PG8_SCHED; PG8_LDA(At, 0, 0); PG8_STAGE(PG8_SA(1, 1), a1 + hstep, voffA);
            PG8_WAIT_L(8); PG8_BAR; PG8_WAIT_L(0); PG8_MMA(0, 0, At, B0); PG8_BAR; PG8_SCHED;
            PG8_LDB(B1, 0, 1); PG8_STAGE(PG8_SB(0, 0), b2, voffB);
            PG8_BAR; PG8_WAIT_L(0); PG8_MMA(0, 1, At, B1); PG8_BAR;
            PG8_LDA(At, 0, 1); PG8_STAGE(PG8_SA(0, 0), a2, voffA);
            PG8_BAR; PG8_WAIT_L(0); PG8_MMA(1, 0, At, B0); PG8_BAR; PG8_SCHED;
            PG8_STAGE(PG8_SB(0, 1), b2 + hstep, voffB);
            PG8_WAIT_V(6); PG8_BAR; PG8_MMA(1, 1, At, B1); PG8_BAR;
            PG8_LDB(B0, 1, 0); PG8_SCHED; PG8_LDA(At, 1, 0); PG8_STAGE(PG8_SA(0, 1), a2 + hstep, voffA);
            PG8_WAIT_L(8); PG8_BAR; PG8_WAIT_L(0); PG8_MMA(0, 0, At, B0); PG8_BAR; PG8_SCHED;
            PG8_LDB(B1, 1, 1); PG8_STAGE(PG8_SB(1, 0), b3, voffB);
            PG8_BAR; PG8_WAIT_L(0); PG8_MMA(0, 1, At, B1); PG8_BAR;
            PG8_LDA(At, 1, 1); PG8_STAGE(PG8_SA(1, 0), a3, voffA);
            PG8_BAR; PG8_WAIT_L(0); PG8_MMA(1, 0, At, B0); PG8_BAR; PG8_SCHED;
            PG8_STAGE(PG8_SB(1, 1), b3 + hstep, voffB);
            PG8_WAIT_V(6); PG8_BAR; PG8_MMA(1, 1, At, B1); PG8_BAR;
            }
        }
        if constexpr (QM != 0) asm volatile("s_nop 15\n\ts_nop 15" ::: "memory");
        if constexpr (ALIGN_EPI) { if (wr == 0) PG8_BAR; }
        E(acc, cur, wr, wc, fr, fq); S.done(cur);
        nxt.par = cur.par ^ 1;
        if constexpr (epi_has_pre<Epi>::value) { if (has_next) E.pre(nxt, wid, lane); }
        if (!has_next) break;
#pragma unroll
        for (int a = 0; a < 2; ++a)
#pragma unroll
            for (int b = 0; b < 2; ++b)
#pragma unroll
                for (int m = 0; m < 4; ++m)
#pragma unroll
                    for (int n = 0; n < 2; ++n) acc[a][b][m][n] = (f32x4){0.f, 0.f, 0.f, 0.f};
        cur = nxt; cA = nA; cB = nB; ++ui;
        if constexpr (ALIGN_EPI) { if (wr == 1) PG8_BAR; }
    }
    PG8_WAIT_V(0);
    if constexpr (!ALIGN_EPI) { if (wr == 0) PG8_BAR; }
    PG8_BAR;
#undef PG8_SA
#undef PG8_SB
#undef PG8_STAGE
#undef PG8_LDA
#undef PG8_LDB
#undef PG8_MMA
#undef PG8_WAIT_V
#undef PG8_WAIT_L
#undef PG8_BAR
#undef PG8_SCHED
}
}

constexpr int NWAVES = 8;
constexpr int D = 1024, NBATCH = 4, SEQ = 4096, CTXL = 256;
constexpr int NLAT = NBATCH * SEQ, NCTX = NBATCH * CTXL, NROW = NLAT + NCTX, NPAN = NROW / 256;
constexpr int INW_SRC = 4128, INW = 4608;
constexpr int FFD = 2816, FFE = 3584, NEXP = 8;
constexpr float EPS = 1e-6f;

constexpr size_t MiB = 1u << 20;
constexpr size_t WS_CTL = 0, CTL_ZERO_BYTES = 256 * 1024;
constexpr size_t WS_TAB = 1 * MiB;
constexpr size_t WS_LATX = 8 * MiB;
constexpr size_t WS_W = 76 * MiB;
constexpr size_t WS_XN = 120 * MiB;
constexpr size_t WS_IP = 154 * MiB;
constexpr size_t WS_DS = 324 * MiB;
constexpr size_t WS_S5F = 392 * MiB;
constexpr size_t WS_OG = 401 * MiB;
constexpr size_t WS_SG = 418 * MiB;
constexpr size_t WS_O32 = 435 * MiB;
constexpr size_t WS_Y32 = 469 * MiB;
constexpr size_t WS_SST = 435 * MiB;
constexpr size_t WS_BC = 478 * MiB;
constexpr size_t WS_S5H = 469 * MiB;
constexpr size_t WS_WM = 76 * MiB;
constexpr size_t WS_XG = 244 * MiB;
constexpr size_t WS_HM = 312 * MiB;
constexpr size_t WS_YS = 438 * MiB;
constexpr size_t WS_YT = 506 * MiB;
constexpr size_t WS_END = 534 * MiB;
constexpr size_t IP_K = 0, IP_V = IP_K + (size_t)NROW * 256 * 2, IP_GF = IP_V + (size_t)NROW * 512 * 2, IP_GB = IP_GF + (size_t)NROW * 256 * 4,
                 IP_U = IP_GB + (size_t)NROW * 256 * 4, IP_Q = IP_U + (size_t)NROW * 512 * 2, IP_R = IP_Q + (size_t)NROW * 256 * 2,
                 IP_GA = IP_R + (size_t)NROW * 512 * 2, IP_GM = IP_GA + (size_t)NROW * 1024 * 2, IP_END = IP_GM + (size_t)NROW * 1024 * 2;
static_assert(IP_END <= 170 * MiB, "in-proj region");
constexpr size_t IP_T = IP_K;
constexpr size_t IP_S2 = IP_U;
constexpr size_t IP_HMID = 0;
static_assert((size_t)NROW * 1024 * 2 <= IP_GB, "T overlay");
static_assert((size_t)NROW * FFD * 2 <= 170 * MiB, "HMID overlay");
constexpr size_t W_IN = 0;
constexpr size_t W_GLU = 18 * MiB;
constexpr size_t W_GP = 19 * MiB;
constexpr size_t W_SP = 21 * MiB;
constexpr size_t W_OUT = 23 * MiB;
constexpr size_t W_FGU = 27 * MiB;
constexpr size_t W_FD = 38 * MiB;
constexpr size_t WM_GU = 0;
constexpr size_t WM_D = 112 * MiB;
constexpr size_t T_MODV = 0;
constexpr size_t T_LAMB = 256 * 1024;
constexpr size_t T_BBAR = 512 * 1024;
constexpr size_t T_TOKE = 2 * MiB;
constexpr size_t T_TOKW = 2 * MiB + 256 * 1024;
constexpr size_t T_TOKS = 2 * MiB + 512 * 1024;
constexpr size_t T_BMT = 3 * MiB;
constexpr size_t T_CMT = 3 * MiB + 512 * 1024;
constexpr size_t T_DEC = 4 * MiB;
constexpr size_t T_PT = 5 * MiB;
constexpr size_t T_XSI = 6 * MiB;
constexpr size_t T_XNS = 6 * MiB + 256 * 1024;
constexpr int CW_TMO = 0, CW_CODE = 1;
constexpr int CW_BAR = 4096;
constexpr int CW_CNT = 16384;

constexpr int RING_OFF = 0, RING_BYTES = 135168;
constexpr int LDSCTL_OFF = RING_BYTES, MISC_OFF = LDSCTL_OFF + 320;
constexpr int LDS_BYTES = 147456;
constexpr int MOE_NPRE = 2;
constexpr int MOE_NCONV = 24;
constexpr int EPI_SB_OFF = 139264;

#define GAS __attribute__((address_space(1)))
#define LAS __attribute__((address_space(3)))
typedef unsigned short bf16;
typedef unsigned v4u __attribute__((ext_vector_type(4)));
typedef unsigned v2u __attribute__((ext_vector_type(2)));
typedef float f32x4 __attribute__((ext_vector_type(4)));
typedef float f32x2 __attribute__((ext_vector_type(2)));
typedef short bf16x8 __attribute__((ext_vector_type(8)));
typedef GAS unsigned gu32;
#define RLX_AGENT __ATOMIC_RELAXED, __HIP_MEMORY_SCOPE_AGENT
#define LDS_WAIT() asm volatile("s_waitcnt lgkmcnt(0)" ::: "memory")
#define VM_WAIT() asm volatile("s_waitcnt vmcnt(0)" ::: "memory")
__device__ __forceinline__ unsigned f2bf(float f) { unsigned u = __builtin_bit_cast(unsigned, f); return (u + 0x7fffu + ((u >> 16) & 1u)) >> 16; }
__device__ __forceinline__ unsigned pk2(float lo, float hi) { return f2bf(lo) | (f2bf(hi) << 16); }
__device__ __forceinline__ float bf2f(unsigned b) { return __builtin_bit_cast(float, b << 16); }
__device__ __forceinline__ float bflo(unsigned w) { return __builtin_bit_cast(float, w << 16); }
__device__ __forceinline__ float bfhi(unsigned w) { return __builtin_bit_cast(float, w & 0xffff0000u); }
__device__ __forceinline__ float sigmoidf_(float x) { return __builtin_amdgcn_rcpf(1.0f + __expf(-x)); }
__device__ __forceinline__ float siluf_(float x) { return x * __builtin_amdgcn_rcpf(1.0f + __expf(-x)); }
__device__ __forceinline__ float geluf_(float x) { const float t = 1.5957691216057308f * (x + 0.044715f * x * x * x); return x * __builtin_amdgcn_rcpf(1.0f + __expf(-t)); }
__device__ __forceinline__ float logsigmoidf_(float z) { return fminf(z, 0.f) - __logf(1.0f + __expf(-fabsf(z))); }

#define XB_TMO      128
#define XB_XCNT(j)  (256  + 64 * (j))
#define XB_XSUB(j)  (1280 + 64 * (j))
#define XB_XGEN(j)  (2304 + 64 * (j))
#define XB_TOP      3328
#define XB_TOPGEN   3392
#define XCD_BAR_WORDS 3456
#define XB_SPIN_CAP (1u << 18)
__device__ __forceinline__ unsigned xb_ld(unsigned* p)              { return __hip_atomic_load(p, __ATOMIC_RELAXED, __HIP_MEMORY_SCOPE_AGENT); }
__device__ __forceinline__ unsigned xb_add(unsigned* p, unsigned v) { return __hip_atomic_fetch_add(p, v, __ATOMIC_RELAXED, __HIP_MEMORY_SCOPE_AGENT); }
__device__ __forceinline__ unsigned xb_xcc_id() { return (unsigned)__builtin_amdgcn_s_getreg((3 << 11) | 20) & 0xFu; }
#define XB_SPIN(cond, bar) do { unsigned _sp = 0; while (cond) { __builtin_amdgcn_s_sleep(1); \
    if ((++_sp & 255u) == 0u) { if (xb_ld(&(bar)[XB_TMO])) break; if (_sp > XB_SPIN_CAP) { atomicAdd(&(bar)[XB_TMO], 1u); break; } } } } while (0)
struct XcdBarrier { unsigned* bar; unsigned x; volatile LAS unsigned* st; };
__device__ __forceinline__ XcdBarrier xcd_barrier_post(unsigned* bar, volatile LAS unsigned* st) {
    XcdBarrier b; b.bar = bar; b.x = xb_xcc_id(); b.st = st;
    if (threadIdx.x == 0) (void)xb_add(&bar[XB_XCNT(b.x)], 1u);
    return b;
}
__device__ __forceinline__ void xcd_barrier_complete(unsigned* bar, unsigned x, unsigned& nloc, unsigned& nx) {
    const unsigned G = gridDim.x * gridDim.y * gridDim.z;
    unsigned sum, cnt, mine, sp = 0u;
    for (;;) {
        sum = 0u; cnt = 0u; mine = 0u;
#pragma unroll
        for (unsigned j = 0; j < 16; ++j) { const unsigned c = xb_ld(&bar[XB_XCNT(j)]); sum += c; cnt += (c > 0u) ? 1u : 0u; mine = (j == x) ? c : mine; }
        if (sum == G) break;
        __builtin_amdgcn_s_sleep(1);
        if ((++sp & 255u) == 0u) { if (xb_ld(&bar[XB_TMO])) break; if (sp > XB_SPIN_CAP) { atomicAdd(&bar[XB_TMO], 1u); break; } }
    }
    nloc = mine > 0u ? mine : 1u; nx = cnt > 0u ? cnt : 1u;
}
__device__ __forceinline__ void xcd_barrier(const XcdBarrier& b) {
    asm volatile("s_waitcnt vmcnt(0)" ::: "memory");
    __syncthreads();
    if (threadIdx.x == 0) {
        unsigned* bar = b.bar;
        __builtin_amdgcn_s_waitcnt(0);
        unsigned nloc = b.st[0], nx = b.st[1];
        if (nloc == 0u) { xcd_barrier_complete(bar, b.x, nloc, nx); b.st[0] = nloc; b.st[1] = nx; }
        const unsigned old = xb_add(&bar[XB_XSUB(b.x)], 1u);
        const unsigned gen = old / nloc;
        if (old + 1u == (gen + 1u) * nloc) {
            __builtin_amdgcn_fence(__ATOMIC_RELEASE, "agent");
            asm volatile("s_waitcnt vmcnt(0)" ::: "memory");
            const unsigned og = xb_add(&bar[XB_TOP], 1u);
            const unsigned tg = og / nx;
            if (og + 1u != (tg + 1u) * nx) XB_SPIN(xb_ld(&bar[XB_TOP]) < (tg + 1u) * nx, bar);
            __builtin_amdgcn_fence(__ATOMIC_ACQUIRE, "");
            asm volatile("s_waitcnt vmcnt(0)" ::: "memory");
            xb_add(&bar[XB_XGEN(b.x)], 1u);
        } else {
            XB_SPIN(xb_ld(&bar[XB_XGEN(b.x)]) == gen, bar);
            __builtin_amdgcn_fence(__ATOMIC_ACQUIRE, "agent");
            asm volatile("s_waitcnt vmcnt(0)" ::: "memory");
        }
    }
    __syncthreads();
}

enum InIdx { I_X = 0, I_C, I_CTX, I_CCTX, I_WMOD, I_BMOD, I_N1W, I_N2W, I_FNW, I_WIN, I_LRF, I_LRB, I_BIASF, I_BIASB, I_GNW,
             I_AREF, I_AIMF, I_LDTF, I_AREB, I_AIMB, I_LDTB, I_BRE, I_BIM, I_CRE, I_CIM, I_S5D, I_WGLU, I_BGLU, I_WGP, I_WSP, I_WOUT,
             I_FG, I_FU, I_FD, I_ROUTER, I_MG, I_MU, I_MD, N_IN };
struct Args { const float* in[N_IN]; float* out; unsigned char* ws; int ph_lo, ph_hi; };

#define SHX(v, m) __builtin_bit_cast(float, __builtin_amdgcn_ds_bpermute((lane ^ (m)) << 2, __builtin_bit_cast(int, (float)(v))))
__device__ __forceinline__ float wave_sum(float v, const int lane) {
#pragma unroll
    for (int o = 1; o < 64; o <<= 1) v += SHX(v, o);
    return v;
}

typedef short tr_v4i16 __attribute__((ext_vector_type(4)));
__device__ __forceinline__ void transpose_item(const float* W, int ldw, int k0, int n0, bf16* WT, int ldt, int drow0, LAS unsigned char* scr, int lane) {
    const int kk = lane >> 4, n4 = (lane & 15) * 4;
    f32x4 v[16];
#pragma unroll
    for (int i = 0; i < 16; ++i) v[i] = *(const f32x4*)(W + (size_t)(k0 + 4 * i + kk) * ldw + n0 + n4);
#pragma unroll
    for (int i = 0; i < 16; ++i) { v2u o; o.x = pk2(v[i][0], v[i][1]); o.y = pk2(v[i][2], v[i][3]); *(LAS v2u*)(scr + (4 * i + kk) * 144 + n4 * 2) = o; }
    LDS_WAIT(); asm volatile("" ::: "memory");
    const int hh = lane >> 5, blk = (lane >> 4) & 1, q = (lane & 15) >> 2, p = lane & 3, li = lane & 15;
#pragma unroll
    for (int it = 0; it < 4; ++it)
#pragma unroll
        for (int ct = 0; ct < 2; ++ct) { const int kc = 2 * it + hh, col0 = 32 * ct;
            const LAS unsigned char* a0 = scr + (8 * kc + q) * 144 + (col0 + 16 * blk + 4 * p) * 2;
            const tr_v4i16 lo = __builtin_amdgcn_ds_read_tr16_b64_v4i16((LAS tr_v4i16*)a0), hi = __builtin_amdgcn_ds_read_tr16_b64_v4i16((LAS tr_v4i16*)(a0 + 4 * 144));
            const bf16x8 o = __builtin_shufflevector(lo, hi, 0, 1, 2, 3, 4, 5, 6, 7);
            *(bf16x8*)(WT + (size_t)(drow0 + col0 + 16 * blk + li) * ldt + k0 + 8 * kc) = o; }
    LDS_WAIT(); asm volatile("" ::: "memory");
}
constexpr float SC_MB = 32.f;
constexpr float SC_XIN = 20.f;
constexpr float SC_WGU = 1024.f, SC_WD = 2048.f, SC_H = 8.f;
__device__ __forceinline__ unsigned pk4_fp8(float a, float b, float c, float d) {
    a = __builtin_amdgcn_fmed3f(a, -448.f, 448.f); b = __builtin_amdgcn_fmed3f(b, -448.f, 448.f); c = __builtin_amdgcn_fmed3f(c, -448.f, 448.f); d = __builtin_amdgcn_fmed3f(d, -448.f, 448.f);
    int r = __builtin_amdgcn_cvt_pk_fp8_f32(a, b, 0, false); r = __builtin_amdgcn_cvt_pk_fp8_f32(c, d, r, true); return (unsigned)r; }
__device__ __forceinline__ unsigned pk4_i8(float a, float b, float c, float d) {
    a = __builtin_amdgcn_fmed3f(__builtin_rintf(a), -127.f, 127.f) + 128.f; b = __builtin_amdgcn_fmed3f(__builtin_rintf(b), -127.f, 127.f) + 128.f;
    c = __builtin_amdgcn_fmed3f(__builtin_rintf(c), -127.f, 127.f) + 128.f; d = __builtin_amdgcn_fmed3f(__builtin_rintf(d), -127.f, 127.f) + 128.f;
    unsigned r = __builtin_amdgcn_cvt_pk_u8_f32(a, 0, 0); r = __builtin_amdgcn_cvt_pk_u8_f32(b, 1, r); r = __builtin_amdgcn_cvt_pk_u8_f32(c, 2, r); r = __builtin_amdgcn_cvt_pk_u8_f32(d, 3, r);
    return r ^ 0x80808080u; }
template <int FMT> __device__ __forceinline__ unsigned pk4_q(float a, float b, float c, float d) { if constexpr (FMT == 2) return pk4_i8(a, b, c, d); else return pk4_fp8(a, b, c, d); }
template <int FMT> __device__ __forceinline__ unsigned pk4_q_bf(tr_v4i16 v, float sc) {
    return pk4_q<FMT>(__builtin_bit_cast(float, (unsigned)(unsigned short)v[0] << 16) * sc, __builtin_bit_cast(float, (unsigned)(unsigned short)v[1] << 16) * sc,
                      __builtin_bit_cast(float, (unsigned)(unsigned short)v[2] << 16) * sc, __builtin_bit_cast(float, (unsigned)(unsigned short)v[3] << 16) * sc); }
__device__ __forceinline__ unsigned pk4_fp8_bf(tr_v4i16 v, float sc) {
    return pk4_fp8(__builtin_bit_cast(float, (unsigned)(unsigned short)v[0] << 16) * sc, __builtin_bit_cast(float, (unsigned)(unsigned short)v[1] << 16) * sc,
                   __builtin_bit_cast(float, (unsigned)(unsigned short)v[2] << 16) * sc, __builtin_bit_cast(float, (unsigned)(unsigned short)v[3] << 16) * sc); }
template <int FMT> __device__ __forceinline__ void transpose_item_q(const float* W, int ldw, int k0, int n0, unsigned char* WT, int ldt, int drow0, float sc, LAS unsigned char* scr, int lane) {
    const int kk = lane >> 4, n4 = (lane & 15) * 4;
    f32x4 v[16];
#pragma unroll
    for (int i = 0; i < 16; ++i) v[i] = *(const f32x4*)(W + (size_t)(k0 + 4 * i + kk) * ldw + n0 + n4);
#pragma unroll
    for (int i = 0; i < 16; ++i) { v2u o; o.x = pk2(v[i][0], v[i][1]); o.y = pk2(v[i][2], v[i][3]); *(LAS v2u*)(scr + (4 * i + kk) * 144 + n4 * 2) = o; }
    LDS_WAIT(); asm volatile("" ::: "memory");
    const int hh = lane >> 5, blk = (lane >> 4) & 1, q = (lane & 15) >> 2, p = lane & 3, li = lane & 15;
#pragma unroll
    for (int it = 0; it < 2; ++it)
#pragma unroll
        for (int ct = 0; ct < 2; ++ct) { const int kc = 4 * it + 2 * hh, col0 = 32 * ct;
            const LAS unsigned char* a0 = scr + (8 * kc + q) * 144 + (col0 + 16 * blk + 4 * p) * 2;
            const tr_v4i16 t0 = __builtin_amdgcn_ds_read_tr16_b64_v4i16((LAS tr_v4i16*)a0), t1 = __builtin_amdgcn_ds_read_tr16_b64_v4i16((LAS tr_v4i16*)(a0 + 4 * 144)),
                           t2 = __builtin_amdgcn_ds_read_tr16_b64_v4i16((LAS tr_v4i16*)(a0 + 8 * 144)), t3 = __builtin_amdgcn_ds_read_tr16_b64_v4i16((LAS tr_v4i16*)(a0 + 12 * 144));
            v4u o; o.x = pk4_q_bf<FMT>(t0, sc); o.y = pk4_q_bf<FMT>(t1, sc); o.z = pk4_q_bf<FMT>(t2, sc); o.w = pk4_q_bf<FMT>(t3, sc);
            *(v4u*)(WT + (size_t)(drow0 + col0 + 16 * blk + li) * ldt + k0 + 8 * kc) = o; }
    LDS_WAIT(); asm volatile("" ::: "memory");
}
__device__ __forceinline__ bool conv_matrix(int& r, const float* W, int K, int N, bf16* WT, int mode, int roff, LAS unsigned char* scr, int lane) {
    const int nblk = mode == 1 ? 64 : N / 64, items = (K / 64) * nblk;
    if (r >= items) { r -= items; return false; }
    const int kb = r / nblk, nb = r % nblk, k0 = 64 * kb;
    int n0, drow0;
    if (mode == 0) { n0 = 64 * nb; drow0 = n0 + roff; }
    else if (mode == 1) { n0 = nb < 12 ? 64 * nb : 800 + 64 * (nb - 12); drow0 = nb < 12 ? n0 : n0 + 480; }
    else { n0 = 64 * nb; drow0 = (n0 >> 7) * 256 + (n0 & 127) + roff; }
    transpose_item(W, N, k0, n0, WT, K, drow0, scr, lane);
    return true;
}
template <int FMT> __device__ __forceinline__ bool conv_matrix_q(int& r, const float* W, int K, int N, unsigned char* WT, int mode, int roff, float sc, LAS unsigned char* scr, int lane) {
    const int nblk = mode == 1 ? 64 : N / 64, items = (K / 64) * nblk;
    if (r >= items) { r -= items; return false; }
    const int kb = r / nblk, nb = r % nblk, k0 = 64 * kb;
    int n0 = 64 * nb, drow0;
    if (mode == 0) drow0 = n0 + roff;
    else if (mode == 1) { n0 = nb < 12 ? 64 * nb : 800 + 64 * (nb - 12); drow0 = nb < 12 ? n0 : n0 + 480; }
    else drow0 = (n0 >> 7) * 256 + (n0 & 127) + roff;
    transpose_item_q<FMT>(W, N, k0, n0, WT, K, drow0, sc, scr, lane);
    return true;
}

using pg8::Unit; using pg8::cvt_pk_bf16;
typedef pg8::f32x4 accv;
#define EPI_ARGS const accv (&acc)[2][2][4][2], const Unit& u, int wr, int wc, int fr, int fq
__device__ __forceinline__ v4u pack8(f32x4 a, f32x4 b) { v4u w; w.x = cvt_pk_bf16(a[0], a[1]); w.y = cvt_pk_bf16(a[2], a[3]); w.z = cvt_pk_bf16(b[0], b[1]); w.w = cvt_pk_bf16(b[2], b[3]); return w; }
__device__ __forceinline__ void unpack8(v4u w, f32x4& a, f32x4& b) { a = (f32x4){bflo(w.x), bfhi(w.x), bflo(w.y), bfhi(w.y)}; b = (f32x4){bflo(w.z), bfhi(w.z), bflo(w.w), bfhi(w.w)}; }

struct EpiInProj {
    bf16 *Kb, *Vb, *Ub, *Qb, *Rb, *GAb, *GMb; float *GF, *GB; const float *bias_f, *bias_b; const float* xsi; LAS float* sb;
    __device__ __forceinline__ void pre(const Unit& u, int wid, int lane) const {
        if (wid < 4) __builtin_amdgcn_global_load_lds((const unsigned*)(xsi + (size_t)u.pm * 256 + wid * 64 + lane), (LAS unsigned*)(sb + u.par * 256 + wid * 64), 4, 0, 0);
    }
    static __device__ __forceinline__ f32x4 cv(const accv& a, float is) { const float a0 = a[0], a1 = a[1], a2 = a[2], a3 = a[3];
        return (f32x4){(float)__builtin_bit_cast(int, a0) * is, (float)__builtin_bit_cast(int, a1) * is, (float)__builtin_bit_cast(int, a2) * is, (float)__builtin_bit_cast(int, a3) * is}; }
    __device__ __forceinline__ void operator()(EPI_ARGS) const {
        const int pn = u.pn, row0 = u.pm * 256 + wr * 64 + fr, cw = wc * 32 + 8 * fq;
        float is[2][4];
#pragma unroll
        for (int ai = 0; ai < 2; ++ai)
#pragma unroll
            for (int m = 0; m < 4; ++m) is[ai][m] = sb[u.par * 256 + wr * 64 + fr + ai * 128 + m * 16] * (1.f / SC_WGU);
        if (pn == 3 || pn == 4) {
            float* dst = pn == 3 ? GF : GB; const float* bias = pn == 3 ? bias_f : bias_b;
#pragma unroll
            for (int bj = 0; bj < 2; ++bj) { const int c = cw + bj * 128; const f32x4 b0 = *(const f32x4*)(bias + c), b1 = *(const f32x4*)(bias + c + 4);
#pragma unroll
                for (int ai = 0; ai < 2; ++ai)
#pragma unroll
                    for (int m = 0; m < 4; ++m) { float* p = dst + (size_t)(row0 + ai * 128 + m * 16) * 256 + c; f32x4 v0 = cv(acc[ai][bj][m][0], is[ai][m]) + b0, v1 = cv(acc[ai][bj][m][1], is[ai][m]) + b1;
#pragma unroll
                        for (int j = 0; j < 4; ++j) { v0[j] = logsigmoidf_(v0[j]) * 0.0625f; v1[j] = logsigmoidf_(v1[j]) * 0.0625f; }
                        *(f32x4*)p = v0; *(f32x4*)(p + 4) = v1; } }
            return;
        }
        bf16* dst; int ld, cb, act;
        if (pn == 0) { dst = Kb; ld = 256; cb = 0; act = 0; }
        else if (pn <= 2) { dst = Vb; ld = 512; cb = (pn - 1) * 256; act = 0; }
        else if (pn <= 6) { dst = Ub; ld = 512; cb = (pn - 5) * 256; act = 0; }
        else if (pn == 7) { dst = Qb; ld = 256; cb = 0; act = 1; }
        else if (pn <= 9) { dst = Rb; ld = 512; cb = (pn - 8) * 256; act = 2; }
        else if (pn <= 13) { dst = GAb; ld = 1024; cb = (pn - 10) * 256; act = 3; }
        else { dst = GMb; ld = 1024; cb = (pn - 14) * 256; act = 3; }
#pragma unroll
        for (int ai = 0; ai < 2; ++ai)
#pragma unroll
            for (int m = 0; m < 4; ++m) { bf16* rowp = dst + (size_t)(row0 + ai * 128 + m * 16) * ld + cb + cw;
#pragma unroll
                for (int bj = 0; bj < 2; ++bj) { f32x4 v0 = cv(acc[ai][bj][m][0], is[ai][m]), v1 = cv(acc[ai][bj][m][1], is[ai][m]);
                    if (act == 1) { v0 = v0 * 0.125f; v1 = v1 * 0.125f; }
                    else if (act == 2) {
#pragma unroll
                        for (int j = 0; j < 4; ++j) { v0[j] = siluf_(v0[j]); v1[j] = siluf_(v1[j]); } }
                    else if (act == 3) {
#pragma unroll
                        for (int j = 0; j < 4; ++j) { v0[j] = sigmoidf_(v0[j]); v1[j] = sigmoidf_(v1[j]); } }
                    *(v4u*)(rowp + bj * 128) = pack8(v0, v1); } }
    }
};
struct EpiD12 {
    const bf16* SG; bf16* S2; const float* bglu; const bf16* GA; bf16* T;
    __device__ __forceinline__ void operator()(EPI_ARGS) const {
        const int row0 = u.pm * 256 + wr * 64 + fr, c0 = u.pn * 256 + wc * 32 + 8 * fq;
        if (u.kind == 0) {
            f32x4 b0[2], b1[2];
#pragma unroll
            for (int bj = 0; bj < 2; ++bj) { b0[bj] = *(const f32x4*)(bglu + c0 + bj * 128); b1[bj] = *(const f32x4*)(bglu + c0 + bj * 128 + 4); }
#pragma unroll
            for (int ai = 0; ai < 2; ++ai)
#pragma unroll
                for (int m = 0; m < 4; ++m) { const size_t row = (size_t)(row0 + ai * 128 + m * 16);
#pragma unroll
                    for (int bj = 0; bj < 2; ++bj) { const int c = c0 + bj * 128; f32x4 v0 = acc[ai][bj][m][0], v1 = acc[ai][bj][m][1], s0, s1;
                        unpack8(*(const v4u*)(SG + row * 512 + c), s0, s1);
#pragma unroll
                        for (int j = 0; j < 4; ++j) { v0[j] = s0[j] * sigmoidf_(v0[j] + b0[bj][j]); v1[j] = s1[j] * sigmoidf_(v1[j] + b1[bj][j]); }
                        *(v4u*)(S2 + row * 512 + c) = pack8(v0, v1); } }
        } else {
#pragma unroll
            for (int ai = 0; ai < 2; ++ai)
#pragma unroll
                for (int m = 0; m < 4; ++m) { const size_t row = (size_t)(row0 + ai * 128 + m * 16);
#pragma unroll
                    for (int bj = 0; bj < 2; ++bj) { const int c = c0 + bj * 128; f32x4 s0, s1;
                        unpack8(*(const v4u*)(GA + row * 1024 + c), s0, s1); *(v4u*)(T + row * 1024 + c) = pack8(acc[ai][bj][m][0] * s0, acc[ai][bj][m][1] * s1); } }
        }
    }
};
struct EpiD3 {
    const bf16* T; const bf16* GM; bf16* MB;
    __device__ __forceinline__ void operator()(EPI_ARGS) const {
        const int row0 = u.pm * 256 + wr * 64 + fr, c0 = u.pn * 256 + wc * 32 + 8 * fq;
#pragma unroll
        for (int ai = 0; ai < 2; ++ai)
#pragma unroll
            for (int m = 0; m < 4; ++m) { const size_t row = (size_t)(row0 + ai * 128 + m * 16);
#pragma unroll
                for (int bj = 0; bj < 2; ++bj) { const int c = c0 + bj * 128; f32x4 t0, t1, g0, g1; unpack8(*(const v4u*)(T + row * 1024 + c), t0, t1); unpack8(*(const v4u*)(GM + row * 1024 + c), g0, g1);
                    const f32x4 m0 = (t0 + g0 * acc[ai][bj][m][0]) * SC_MB, m1 = (t1 + g1 * acc[ai][bj][m][1]) * SC_MB;
                    v2u o; o.x = pk4_i8(m0[0], m0[1], m0[2], m0[3]); o.y = pk4_i8(m1[0], m1[1], m1[2], m1[3]);
                    *(v2u*)((unsigned char*)MB + row * 1024 + c) = o; } }
    }
};
template <bool I32>
struct EpiResidT {
    const float* rl; const float* rc; float* out; const float* modv; int gidx; float* part; float osc;
    static __device__ __forceinline__ f32x4 cv(const accv& a, float sc) { if constexpr (I32) { const float a0 = a[0], a1 = a[1], a2 = a[2], a3 = a[3];
            return (f32x4){(float)__builtin_bit_cast(int, a0) * sc, (float)__builtin_bit_cast(int, a1) * sc, (float)__builtin_bit_cast(int, a2) * sc, (float)__builtin_bit_cast(int, a3) * sc}; } else return a; }
    __device__ __forceinline__ void operator()(EPI_ARGS) const {
        const int row0 = u.pm * 256 + wr * 64 + fr, c0 = u.pn * 256 + wc * 32 + 8 * fq;
        if (u.kind == 1) {
            float* pp = part + (size_t)u.slice * NCTX * 1024;
#pragma unroll
            for (int ai = 0; ai < 2; ++ai)
#pragma unroll
                for (int m = 0; m < 4; ++m)
#pragma unroll
                    for (int bj = 0; bj < 2; ++bj) { float* op = pp + (size_t)(row0 - NLAT + ai * 128 + m * 16) * 1024 + c0 + bj * 128; *(f32x4*)op = cv(acc[ai][bj][m][0], osc); *(f32x4*)(op + 4) = cv(acc[ai][bj][m][1], osc); }
            return;
        }
        const int bi = u.pm < NLAT / 256 ? (u.pm >> 4) : 4;
        const float* gp = modv + bi * 6144 + gidx * 1024;
#pragma unroll
        for (int bj = 0; bj < 2; ++bj) { const int c = c0 + bj * 128; const f32x4 g0 = *(const f32x4*)(gp + c), g1 = *(const f32x4*)(gp + c + 4);
#pragma unroll
            for (int ai = 0; ai < 2; ++ai)
#pragma unroll
                for (int m = 0; m < 4; ++m) { const int row = row0 + ai * 128 + m * 16;
                    const float* rp = (row < NLAT ? rl + (size_t)row * 1024 : rc + (size_t)(row - NLAT) * 1024) + c; float* op = out + (size_t)row * 1024 + c;
                    const f32x4 r0 = *(const f32x4*)rp, r1 = *(const f32x4*)(rp + 4);
                    *(f32x4*)op = r0 + g0 * cv(acc[ai][bj][m][0], osc); *(f32x4*)(op + 4) = r1 + g1 * cv(acc[ai][bj][m][1], osc); } }
    }
};
typedef EpiResidT<false> EpiResid;
struct EpiSwiglu {
    bf16* H; int ld; int pmoff;
    __device__ __forceinline__ void operator()(EPI_ARGS) const {
        const int row0 = (u.pm - pmoff) * 256 + wr * 64 + fr, c = u.pn * 128 + wc * 32 + 8 * fq;
#pragma unroll
        for (int ai = 0; ai < 2; ++ai)
#pragma unroll
            for (int m = 0; m < 4; ++m) { f32x4 g0 = acc[ai][0][m][0], g1 = acc[ai][0][m][1]; const f32x4 u0 = acc[ai][1][m][0], u1 = acc[ai][1][m][1];
#pragma unroll
                for (int j = 0; j < 4; ++j) { g0[j] = siluf_(g0[j]) * u0[j]; g1[j] = siluf_(g1[j]) * u1[j]; }
                *(v4u*)(H + (size_t)(row0 + ai * 128 + m * 16) * ld + c) = pack8(g0, g1); }
    }
};
template <bool I32, bool OUT8>
struct EpiSwigluS {
    unsigned char* H; int ld; int pmoff; const float* xsi; float wsi, hs; LAS float* sb;
    static __device__ __forceinline__ float cv(float x) { if constexpr (I32) return (float)__builtin_bit_cast(int, x); else return x; }
    __device__ __forceinline__ void pre(const Unit& u, int wid, int lane) const {
        if (wid < 4) __builtin_amdgcn_global_load_lds((const unsigned*)(xsi + (size_t)u.pm * 256 + wid * 64 + lane), (LAS unsigned*)(sb + u.par * 256 + wid * 64), 4, 0, 0);
    }
    __device__ __forceinline__ void operator()(EPI_ARGS) const {
        const int row0 = (u.pm - pmoff) * 256 + wr * 64 + fr, c = u.pn * 128 + wc * 32 + 8 * fq;
        const LAS float* xp = sb + u.par * 256 + wr * 64 + fr;
#pragma unroll
        for (int ai = 0; ai < 2; ++ai)
#pragma unroll
            for (int m = 0; m < 4; ++m) { const float is = xp[ai * 128 + m * 16] * wsi, is2 = is * hs;
                f32x4 g0 = acc[ai][0][m][0], g1 = acc[ai][0][m][1]; const f32x4 u0 = acc[ai][1][m][0], u1 = acc[ai][1][m][1];
#pragma unroll
                for (int j = 0; j < 4; ++j) { g0[j] = siluf_(cv(g0[j]) * is) * (cv(u0[j]) * is2); g1[j] = siluf_(cv(g1[j]) * is) * (cv(u1[j]) * is2); }
                if constexpr (OUT8) { v2u o; o.x = pk4_fp8(g0[0], g0[1], g0[2], g0[3]); o.y = pk4_fp8(g1[0], g1[1], g1[2], g1[3]); *(v2u*)(H + (size_t)(row0 + ai * 128 + m * 16) * ld + c) = o; }
                else *(v4u*)((bf16*)H + (size_t)(row0 + ai * 128 + m * 16) * ld + c) = pack8(g0, g1); }
    }
};
struct EpiPlain {
    bf16* Y; bf16* YT; float osc;
    __device__ __forceinline__ void operator()(EPI_ARGS) const {
        const int row0 = u.pm * 256 + wr * 64 + fr, c0 = u.pn * 256 + wc * 32 + 8 * fq;
        if (u.kind == 1) {
            bf16* yp = YT + (size_t)u.slice * 2048 * 1024;
#pragma unroll
            for (int ai = 0; ai < 2; ++ai)
#pragma unroll
                for (int m = 0; m < 4; ++m)
#pragma unroll
                    for (int bj = 0; bj < 2; ++bj) *(v4u*)(yp + (size_t)(row0 - 32768 + ai * 128 + m * 16) * 1024 + c0 + bj * 128) = pack8(acc[ai][bj][m][0] * osc, acc[ai][bj][m][1] * osc);
            return;
        }
#pragma unroll
        for (int ai = 0; ai < 2; ++ai)
#pragma unroll
            for (int m = 0; m < 4; ++m)
#pragma unroll
                for (int bj = 0; bj < 2; ++bj) *(v4u*)(Y + (size_t)(row0 + ai * 128 + m * 16) * 1024 + c0 + bj * 128) = pack8(acc[ai][bj][m][0] * osc, acc[ai][bj][m][1] * osc);
    }
};

#define PHASE_BEGIN() int tid_; asm volatile("v_mbcnt_lo_u32_b32 %0, -1, 0\n\tv_mbcnt_hi_u32_b32 %0, -1, %0" : "=v"(tid_)); tid_ += wave_s_ * 64; GAS unsigned char* wsg_ = (GAS unsigned char*)args.ws; asm volatile("" : "+s"(wsg_)); unsigned char* ws = (unsigned char*)wsg_; \
    const int tid = tid_, lane = tid & 63, wave = __builtin_amdgcn_readfirstlane(tid >> 6), gw = vcu * NWAVES + wave; (void)lane; (void)gw; \
    const float* const* in = args.in; (void)in; gu32* ctl = (gu32*)(ws + WS_CTL); (void)ctl; int bxp = bx; asm volatile("" : "+s"(bxp)); (void)bxp;
#define LATX ((float*)(ws + WS_LATX))
#define XN ((bf16*)(ws + WS_XN))
#define Kb ((bf16*)(ws + WS_IP + IP_K))
#define Vb ((bf16*)(ws + WS_IP + IP_V))
#define GF ((float*)(ws + WS_IP + IP_GF))
#define GB ((float*)(ws + WS_IP + IP_GB))
#define Ub ((bf16*)(ws + WS_IP + IP_U))
#define Qb ((bf16*)(ws + WS_IP + IP_Q))
#define Rb ((bf16*)(ws + WS_IP + IP_R))
#define GAb ((bf16*)(ws + WS_IP + IP_GA))
#define GMb ((bf16*)(ws + WS_IP + IP_GM))
#define Tb ((bf16*)(ws + WS_IP + IP_T))
#define S2 ((bf16*)(ws + WS_IP + IP_S2))
#define HMID ((bf16*)(ws + WS_IP + IP_HMID))
#define OG ((bf16*)(ws + WS_OG))
#define SG ((bf16*)(ws + WS_SG))
#define O32 ((float*)(ws + WS_O32))
#define Y32 ((float*)(ws + WS_Y32))
#define MODV ((float*)(ws + WS_TAB + T_MODV))
#define LAMB ((f32x2*)(ws + WS_TAB + T_LAMB))
#define BBAR ((f32x2*)(ws + WS_TAB + T_BBAR))
#define BMT ((bf16*)(ws + WS_TAB + T_BMT))
#define CMT ((bf16*)(ws + WS_TAB + T_CMT))
#define PT32 ((bf16*)(ws + WS_TAB + T_PT))
#define S5F ((f32x2*)(ws + WS_S5F))
#define S5H ((f32x2*)(ws + WS_S5H))
#define DSB ((bf16*)(ws + WS_DS))
#define SSTB ((bf16*)(ws + WS_SST))
#define QDB ((bf16*)(ws + WS_BC))
#define KDB ((bf16*)(ws + WS_BC + (size_t)2 * NROW * 256 * 2))
#define DECB ((float*)(ws + WS_TAB + T_DEC))
#define TOKE ((int4*)(ws + WS_TAB + T_TOKE))
#define TOKW ((f32x2*)(ws + WS_TAB + T_TOKW))
#define TOKS ((int2*)(ws + WS_TAB + T_TOKS))
#define wb (ws + WS_W)
#define WMGU ((unsigned char*)(ws + WS_WM + WM_GU))
#define WMD ((unsigned char*)(ws + WS_WM + WM_D))
#define XG ((unsigned char*)(ws + WS_XG))
#define HM ((unsigned char*)(ws + WS_HM))
#define XSI ((float*)(ws + WS_TAB + T_XSI))
#define XNS ((float*)(ws + WS_TAB + T_XNS))
#define XN2 ((unsigned char*)(ws + 216 * MiB))
#define XNS1 ((float*)(ws + WS_TAB + T_XNS + 128 * 1024 + (size_t)l * 128 * 1024))
#define YS ((bf16*)(ws + WS_YS))
#define YTP ((bf16*)(ws + WS_YT))
#define FPART ((float*)(ws + WS_DS))


typedef __bf16 bf16x2_t __attribute__((ext_vector_type(2)));
__device__ __forceinline__ unsigned cvtpk(float lo, float hi) { const f32x2 v = {lo, hi}; const bf16x2_t b = __builtin_convertvector(v, bf16x2_t); return __builtin_bit_cast(unsigned, b); }
typedef float f32x16 __attribute__((ext_vector_type(16)));
#define MFMA32(a, b, c) __builtin_amdgcn_mfma_f32_32x32x16_bf16((a), (b), (c), 0, 0, 0)
#define MFMA_FENCE() do { __builtin_amdgcn_sched_barrier(0); asm volatile("s_nop 15\n\ts_nop 15" ::: "memory"); __builtin_amdgcn_sched_barrier(0); } while (0)
#define MFMA16(a, b, c) __builtin_amdgcn_mfma_f32_16x16x32_bf16((a), (b), (c), 0, 0, 0)
__device__ __forceinline__ void cmul(float& ar, float& ai, float br, float bi) { const float r = ar * br - ai * bi, i = ar * bi + ai * br; ar = r; ai = i; }
template <int DIR> __device__ __forceinline__ void s5_scan(f32x16 (&tre)[2], f32x16 (&tim)[2], const float lr, const float li, float& sr, float& si) {
#pragma unroll
    for (int q = 0; q < 32; ++q) { const int idx = DIR ? 31 - q : q, mt = idx >> 4, i = idx & 15;
        const float nr = lr * sr - li * si + tre[mt][i], ni = lr * si + li * sr + tim[mt][i]; sr = nr; si = ni; tre[mt][i] = sr; tim[mt][i] = si; }
}
template <int DIR> __device__ __forceinline__ void s5_fix(f32x16 (&tre)[2], f32x16 (&tim)[2], const float lr, const float li, const float xr, const float xi) {
    float fr = lr, fi = li;
#pragma unroll
    for (int q = 0; q < 32; ++q) { const int idx = DIR ? 31 - q : q, mt = idx >> 4, i = idx & 15;
        tre[mt][i] += fr * xr - fi * xi; tim[mt][i] += fr * xi + fi * xr; cmul(fr, fi, lr, li); }
}
__device__ __forceinline__ void ts_rows(int b, int ts, int& rb, int& rs) { if (ts < 4) { rb = NLAT + b * CTXL + 64 * ts; rs = 1; } else { rb = b * SEQ + (ts - 4); rs = 64; } }
__device__ __forceinline__ int chain_pos(int dir, int ts) { return dir == 0 ? ts : (ts < 4 ? 3 - ts : 71 - ts); }

template <int MODE> __device__ __forceinline__ void s5_unit(unsigned char* ws, const float* const* in, LAS unsigned char* hbuf_raw, const int l, const int b, const int ts, const int g, const int lane) {
    const int r = lane & 31, hh = lane >> 5;
    int rb, rs; ts_rows(b, ts, rb, rs);
    bf16x8 ua[2];
#pragma unroll
    for (int mt = 0; mt < 2; ++mt) { const int tokA = 32 * ((r >> 2) & 1) + 16 * mt + (r & 3) + 4 * (r >> 3);
        ua[mt] = *(const bf16x8*)(Ub + (size_t)(rb + tokA * rs) * 512 + 16 * g + 8 * hh); }
    f32x4 yacc[4];
#pragma unroll
    for (int i = 0; i < 4; ++i) yacc[i] = (f32x4){0.f, 0.f, 0.f, 0.f};
    unsigned ue[4][2];
    LAS unsigned* hbuf = (LAS unsigned*)hbuf_raw;
    bf16x8 bre4[4], bim4[4]; f32x2 lam4[4], h04[4];
#pragma unroll
    for (int it = 0; it < 4; ++it) { const int dir = it >> 1, ph = it & 1, p = 32 * ph + r;
        const bf16* bm = BMT + ((size_t)((((l * 2 + dir) * 32 + g) * 2 + ph) * 2)) * 512 + r * 16 + 8 * hh;
        bre4[it] = *(const bf16x8*)bm; bim4[it] = *(const bf16x8*)(bm + 512); lam4[it] = LAMB[((l * 2 + dir) * 32 + g) * 64 + p];
        if (MODE == 1) h04[it] = S5H[((size_t)((dir * 4 + b) * 32 + g) * 68 + chain_pos(dir, ts)) * 64 + p];
        else h04[it] = (f32x2){0.f, 0.f}; }
#pragma unroll
    for (int dir = 0; dir < 2; ++dir) {
        const int cpos = chain_pos(dir, ts);
#pragma unroll
        for (int ph = 0; ph < 2; ++ph) {
            const bf16x8 bre = bre4[dir * 2 + ph], bim = bim4[dir * 2 + ph];
            f32x16 tre[2], tim[2];
            __builtin_amdgcn_sched_barrier(0);
#pragma unroll
            for (int mt = 0; mt < 2; ++mt) { f32x16 z;
#pragma unroll
                for (int i = 0; i < 16; ++i) z[i] = 0.f;
                tre[mt] = MFMA32(ua[mt], bre, z); tim[mt] = MFMA32(ua[mt], bim, z); }
            MFMA_FENCE(); MFMA_FENCE();
            const int p = 32 * ph + r;
            const f32x2 lam = lam4[dir * 2 + ph];
            const size_t fidx = ((size_t)((dir * 4 + b) * 32 + g) * 68 + cpos) * 64 + p;
            const bool first = (hh == dir);
            bf16x8 cb2[2], pa2[2][2];
            if (MODE == 1 && dir == 1 && ph == 1) {
#pragma unroll
                for (int m4 = 0; m4 < 4; ++m4)
#pragma unroll
                    for (int i = 0; i < 4; i += 2) ue[m4][i >> 1] = (unsigned)Ub[(size_t)(rb + (16 * m4 + 4 * (lane >> 4) + i) * rs) * 512 + 16 * g + (lane & 15)]
                                                                  | ((unsigned)Ub[(size_t)(rb + (16 * m4 + 4 * (lane >> 4) + i + 1) * rs) * 512 + 16 * g + (lane & 15)] << 16);
            }
            if (MODE == 1) {
                const bf16* ptb = PT32 + ((size_t)((((l * 2 + dir) * 32 + g) * 2 + ph) * 32) + (lane & 15)) * 64 + 8 * (lane >> 4);
#pragma unroll
                for (int ks = 0; ks < 2; ++ks) { cb2[ks] = *(const bf16x8*)(CMT + ((size_t)((l * 32 + g) * 16 + (lane & 15)) * 2 + ph) * 64 + 32 * ks + 8 * (lane >> 4));
                    pa2[ks][0] = *(const bf16x8*)(ptb + 32 * ks); pa2[ks][1] = *(const bf16x8*)(ptb + (size_t)16 * 64 + 32 * ks); }
            }
            float sr = 0.f, si = 0.f;
            if (MODE == 1) { const f32x2 h0 = h04[dir * 2 + ph]; if (first) { sr = h0[0]; si = h0[1]; } }
            if (dir == 0) s5_scan<0>(tre, tim, lam[0], lam[1], sr, si); else s5_scan<1>(tre, tim, lam[0], lam[1], sr, si);
            const float orr = SHX(sr, 32), oi = SHX(si, 32);
            if (MODE == 0) {
                float l32r = lam[0], l32i = lam[1];
#pragma unroll
                for (int q = 0; q < 5; ++q) cmul(l32r, l32i, l32r, l32i);
                const float fr_ = first ? sr : orr, fi_ = first ? si : oi, sr_ = first ? orr : sr, si_ = first ? oi : si;
                const f32x2 fv = (f32x2){l32r * fr_ - l32i * fi_ + sr_, l32r * fi_ + l32i * fr_ + si_};
                asm volatile("s_waitcnt lgkmcnt(0)" ::: "memory");
                if (hh == 0) S5F[fidx] = fv;
            } else {
#pragma unroll
                for (int mt = 0; mt < 2; ++mt)
#pragma unroll
                    for (int i = 0; i < 16; ++i) hbuf[(32 * hh + 16 * mt + i) * 36 + r] = cvt_pk_bf16(tre[mt][i], tim[mt][i]);
                (void)orr; (void)oi;
                float xq[2][4][2];
#pragma unroll
                for (int ks = 0; ks < 2; ++ks)
#pragma unroll
                    for (int q = 0; q < 4; ++q) { const int src = (16 * ks + 4 * (lane >> 4) + q + 32 * dir) << 2;
                        xq[ks][q][0] = __builtin_bit_cast(float, __builtin_amdgcn_ds_bpermute(src, __builtin_bit_cast(int, sr))); xq[ks][q][1] = __builtin_bit_cast(float, __builtin_amdgcn_ds_bpermute(src, __builtin_bit_cast(int, si))); }
                LDS_WAIT();
#pragma unroll
                for (int ks = 0; ks < 2; ++ks) {
                    const bf16x8 cb = cb2[ks];
#pragma unroll
                    for (int m4 = 0; m4 < 4; ++m4) { const bf16x8 ha = *(const LAS bf16x8*)(hbuf + (16 * m4 + (lane & 15)) * 36 + 16 * ks + 4 * (lane >> 4)); yacc[m4] = MFMA16(ha, cb, yacc[m4]); }
                    v4u zp;
                    { const v4u cw = __builtin_bit_cast(v4u, cb); const unsigned cwa[4] = {cw.x, cw.y, cw.z, cw.w}; unsigned zz[4];
#pragma unroll
                      for (int q = 0; q < 4; ++q) { const float c0 = bflo(cwa[q]), c1 = bfhi(cwa[q]); zz[q] = cvtpk(c0 * xq[ks][q][0] + c1 * xq[ks][q][1], c1 * xq[ks][q][0] - c0 * xq[ks][q][1]); }
                      zp.x = zz[0]; zp.y = zz[1]; zp.z = zz[2]; zp.w = zz[3]; }
                    const bf16x8 zb = __builtin_bit_cast(bf16x8, zp);
#pragma unroll
                    for (int m = 0; m < 2; ++m) { const bf16x8 pa = pa2[ks][m];
                        if (dir == 0) yacc[2 + m] = MFMA16(pa, zb, yacc[2 + m]); else yacc[m] = MFMA16(pa, zb, yacc[m]); }
                    MFMA_FENCE();
                }
                LDS_WAIT();
            }
        }
    }
    if (MODE == 1) {
        const int hc = lane & 15; const float dsk = in[I_S5D][l * 512 + 16 * g + hc];
#pragma unroll
        for (int m4 = 0; m4 < 4; ++m4)
#pragma unroll
            for (int i = 0; i < 4; ++i) { const int tok = 16 * m4 + 4 * (lane >> 4) + i; const size_t o = (size_t)(rb + tok * rs) * 512 + 16 * g + hc;
                SG[o] = (bf16)f2bf(geluf_(yacc[m4][i] + dsk * ((i & 1) ? bfhi(ue[m4][i >> 1]) : bflo(ue[m4][i >> 1])))); }
    }
}


__device__ __forceinline__ int gla_rowbase(int b, int ts) { return ts < 4 ? NLAT + b * CTXL + 64 * ts : b * SEQ + 64 * (ts - 4); }
constexpr int VROW = 1040, VIMG_BYTES = 64 * VROW;
typedef short v4i16_t __attribute__((ext_vector_type(4)));
__device__ __forceinline__ void gla_v_image(unsigned char* ws, LAS unsigned char* img, int rb, int tid) {
#pragma unroll
    for (int i = 0; i < 8; ++i) { const int ci = tid + 512 * i, row = ci >> 6, ch = ci & 63; *(LAS v4u*)(img + row * VROW + ch * 16) = *(const v4u*)(Vb + (size_t)(rb + row) * 512 + ch * 8); }
}
__device__ __forceinline__ v4i16_t gla_vtr(LAS unsigned char* img, int row0, int col0, int lane) {
    const int blk = (lane >> 4) & 1, q = (lane & 15) >> 2, p = lane & 3;
    return __builtin_amdgcn_ds_read_tr16_b64_v4i16((LAS v4i16_t*)(img + (row0 + q) * VROW + (col0 + 16 * blk + 4 * p) * 2));
}
__device__ __forceinline__ bf16x8 cat8(v4i16_t lo, v4i16_t hi) { return __builtin_shufflevector(lo, hi, 0, 1, 2, 3, 4, 5, 6, 7); }
__device__ __forceinline__ void gla_c1_unit(unsigned char* ws, LAS unsigned char* lds, const int b, const int ts, const int tid) {
    const int lane = tid & 63, w = __builtin_amdgcn_readfirstlane(tid >> 6), dir = w >> 2, h = w & 3;
    const int rb = gla_rowbase(b, ts), chain = (dir * 4 + b) * 4 + h, cpos = chain_pos(dir, ts);
    gla_v_image(ws, lds + 65536, rb, tid);
    {
        const int c4 = lane & 15, tq = lane >> 4, d0 = 4 * c4;
        const float* gp = (dir ? GB : GF) + (size_t)(rb + 16 * tq) * 256 + h * 64 + d0;
        const bf16* kp = Kb + (size_t)(rb + 16 * tq) * 256 + h * 64 + d0;
        const bf16* qp = Qb + (size_t)(rb + 16 * tq) * 256 + h * 64 + d0;
        f32x4 P[16]; v2u kv[16], qv[16];
#pragma unroll
        for (int j = 0; j < 16; ++j) { P[j] = *(const f32x4*)(gp + j * 256); kv[j] = *(const v2u*)(kp + j * 256); qv[j] = *(const v2u*)(qp + j * 256); }
        f32x4 gsave[16];
#pragma unroll
        for (int j = 0; j < 16; ++j) gsave[j] = P[j];
#pragma unroll
        for (int j = 1; j < 16; ++j) P[j] = P[j] + P[j - 1];
        const f32x4 S = P[15];
        f32x4 Qa, Qb_, Qc;
#pragma unroll
        for (int e = 0; e < 4; ++e) { Qa[e] = SHX(S[e], 16); Qb_[e] = SHX(S[e], 32); Qc[e] = SHX(S[e], 48); }
        const f32x4 total = (S + Qa) + (Qb_ + Qc);
        f32x4 off = (f32x4){0.f, 0.f, 0.f, 0.f};
        if ((tq ^ 1) < tq) off = off + Qa;
        if ((tq ^ 2) < tq) off = off + Qb_;
        if ((tq ^ 3) < tq) off = off + Qc;
        f32x4 dec;
#pragma unroll
        for (int e = 0; e < 4; ++e) dec[e] = __expf(total[e]);
        bf16* qdp = QDB + ((size_t)dir * NROW + rb + 16 * tq) * 256 + h * 64 + d0;
        bf16* kdp = KDB + ((size_t)dir * NROW + rb + 16 * tq) * 256 + h * 64 + d0;
        unsigned klp[4][8];
#pragma unroll
        for (int j = 0; j < 16; ++j) {
            const f32x4 pf = P[j] + off;
            f32x4 bc; if (dir == 0) bc = pf; else bc = total - pf + gsave[j];
            const f32x4 kk = (f32x4){bflo(kv[j].x), bfhi(kv[j].x), bflo(kv[j].y), bfhi(kv[j].y)}, qq = (f32x4){bflo(qv[j].x), bfhi(qv[j].x), bflo(qv[j].y), bfhi(qv[j].y)};
            f32x4 kd, qd, kl;
#pragma unroll
            for (int e = 0; e < 4; ++e) { const float ex = __expf(bc[e]); qd[e] = qq[e] * ex; kd[e] = kk[e] * __builtin_amdgcn_rcpf(ex); kl[e] = kd[e] * dec[e]; }
            v2u qo, ko; qo.x = cvtpk(qd[0], qd[1]); qo.y = cvtpk(qd[2], qd[3]); ko.x = cvtpk(kd[0], kd[1]); ko.y = cvtpk(kd[2], kd[3]);
            *(v2u*)(qdp + j * 256) = qo; *(v2u*)(kdp + j * 256) = ko;
            if (j & 1) {
#pragma unroll
                for (int e = 0; e < 4; ++e) klp[e][j >> 1] = cvtpk(__uint_as_float(klp[e][j >> 1]), kl[e]);
            } else {
#pragma unroll
                for (int e = 0; e < 4; ++e) klp[e][j >> 1] = __float_as_uint(kl[e]);
            }
        }
#pragma unroll
        for (int e = 0; e < 4; ++e) { const int d = d0 + e, sw = (d >> 1) & 7;
            v4u v0, v1; v0.x = klp[e][0]; v0.y = klp[e][1]; v0.z = klp[e][2]; v0.w = klp[e][3]; v1.x = klp[e][4]; v1.y = klp[e][5]; v1.z = klp[e][6]; v1.w = klp[e][7];
            *(LAS v4u*)(lds + w * 8192 + d * 128 + (((2 * tq) ^ sw) * 16)) = v0; *(LAS v4u*)(lds + w * 8192 + d * 128 + (((2 * tq + 1) ^ sw) * 16)) = v1; }
        if (tq == 0) *(f32x4*)(DECB + (size_t)(chain * 68 + cpos) * 64 + d0) = dec;
    }
    __syncthreads();
    {
        const int r = lane & 31, hh = lane >> 5;
        bf16x8 afr[2][4];
#pragma unroll
        for (int dt = 0; dt < 2; ++dt)
#pragma unroll
            for (int ks = 0; ks < 4; ++ks) { const int d = 32 * dt + r; afr[dt][ks] = *(const LAS bf16x8*)(lds + w * 8192 + d * 128 + (((2 * ks + hh) ^ ((d >> 1) & 7)) * 16)); }
        bf16* dsp = DSB + (size_t)(chain * 68 + cpos) * 8192 + (size_t)r * 64 + 4 * hh;
#pragma unroll 1
        for (int et = 0; et < 4; ++et) {
            f32x16 acc[2];
#pragma unroll
            for (int i = 0; i < 16; ++i) { acc[0][i] = 0.f; acc[1][i] = 0.f; }
#pragma unroll
            for (int ks = 0; ks < 4; ++ks) { const bf16x8 bfrag = cat8(gla_vtr(lds + 65536, 16 * ks + 8 * hh, h * 128 + 32 * et, lane), gla_vtr(lds + 65536, 16 * ks + 8 * hh + 4, h * 128 + 32 * et, lane));
                acc[0] = MFMA32(afr[0][ks], bfrag, acc[0]); acc[1] = MFMA32(afr[1][ks], bfrag, acc[1]); MFMA_FENCE(); }
#pragma unroll
            for (int dt = 0; dt < 2; ++dt)
#pragma unroll
                for (int a = 0; a < 4; ++a) { v2u o; o.x = cvtpk(acc[dt][4 * a], acc[dt][4 * a + 1]); o.y = cvtpk(acc[dt][4 * a + 2], acc[dt][4 * a + 3]); *(v2u*)(dsp + (size_t)(32 * et) * 64 + 32 * dt + 8 * a) = o; }
        }
    }
    __syncthreads();
}
__device__ __forceinline__ void gla_c3_unit(unsigned char* ws, const float* const* in, LAS unsigned char* lds, const int l, const int b, const int ts, const int tid) {
    const int lane = tid & 63, w = __builtin_amdgcn_readfirstlane(tid >> 6), h = w >> 1, eh = w & 1, r = lane & 31, hh = lane >> 5;
    const int rb = gla_rowbase(b, ts);
    gla_v_image(ws, lds, rb, tid);
    __syncthreads();
    f32x16 acc[2][2];
#pragma unroll
    for (int a = 0; a < 2; ++a)
#pragma unroll
        for (int c = 0; c < 2; ++c)
#pragma unroll
            for (int i = 0; i < 16; ++i) acc[a][c][i] = 0.f;
#pragma unroll 1
    for (int dir = 0; dir < 2; ++dir) {
        const int chain = (dir * 4 + b) * 4 + h, cpos = chain_pos(dir, ts);
        bf16x8 QD[2][4], KD[2][4];
        {
            const bf16* qb = QDB + ((size_t)dir * NROW + rb + r) * 256 + h * 64 + 8 * hh; const bf16* kb = KDB + ((size_t)dir * NROW + rb + r) * 256 + h * 64 + 8 * hh;
#pragma unroll
            for (int tile = 0; tile < 2; ++tile)
#pragma unroll
                for (int ks = 0; ks < 4; ++ks) { QD[tile][ks] = *(const bf16x8*)(qb + (size_t)(32 * tile) * 256 + 16 * ks); KD[tile][ks] = *(const bf16x8*)(kb + (size_t)(32 * tile) * 256 + 16 * ks); }
        }
#pragma unroll
        for (int st = 0; st < 2; ++st) {
#pragma unroll
            for (int tt = 0; tt < 2; ++tt) {
                const bool dead = dir == 0 ? (st == 1 && tt == 0) : (st == 0 && tt == 1);
                if (!dead) {
                    f32x16 at;
#pragma unroll
                    for (int i = 0; i < 16; ++i) at[i] = 0.f;
#pragma unroll
                    for (int ks = 0; ks < 4; ++ks) at = MFMA32(KD[st][ks], QD[tt][ks], at);
                    MFMA_FENCE();
                    const int tq = 32 * tt + r;
#pragma unroll
                    for (int i = 0; i < 16; ++i) { const int sq = 32 * st + (i & 3) + 8 * (i >> 2) + 4 * hh; const bool keep = dir == 0 ? (sq <= tq) : (sq >= tq); at[i] = keep ? at[i] : 0.f; }
#pragma unroll
                    for (int sp = 0; sp < 2; ++sp) {
                        v4u pp; pp.x = cvtpk(at[8 * sp], at[8 * sp + 1]); pp.y = cvtpk(at[8 * sp + 2], at[8 * sp + 3]); pp.z = cvtpk(at[8 * sp + 4], at[8 * sp + 5]); pp.w = cvtpk(at[8 * sp + 6], at[8 * sp + 7]);
                        const bf16x8 p = __builtin_bit_cast(bf16x8, pp);
#pragma unroll
                        for (int et = 0; et < 2; ++et) { const int col0 = h * 128 + 64 * eh + 32 * et, row0 = 32 * st + 16 * sp + 4 * hh;
                            acc[et][tt] = MFMA32(cat8(gla_vtr(lds, row0, col0, lane), gla_vtr(lds, row0 + 8, col0, lane)), p, acc[et][tt]); }
                        MFMA_FENCE();
                    }
                }
            }
        }
        {
            const bf16* sst = SSTB + ((size_t)(chain * 68 + cpos) * 128 + 64 * eh + r) * 64 + 8 * hh;
            bf16x8 SF[2][4];
#pragma unroll
            for (int et = 0; et < 2; ++et)
#pragma unroll
                for (int ks = 0; ks < 4; ++ks) SF[et][ks] = *(const bf16x8*)(sst + (size_t)(32 * et) * 64 + 16 * ks);
#pragma unroll
            for (int et = 0; et < 2; ++et)
#pragma unroll
                for (int ks = 0; ks < 4; ++ks) { acc[et][0] = MFMA32(SF[et][ks], QD[0][ks], acc[et][0]); acc[et][1] = MFMA32(SF[et][ks], QD[1][ks], acc[et][1]); }
            MFMA_FENCE();
        }
    }
    float ss[2];
#pragma unroll
    for (int tt = 0; tt < 2; ++tt) { float s = 0.f;
#pragma unroll
        for (int et = 0; et < 2; ++et)
#pragma unroll
            for (int i = 0; i < 16; ++i) s += acc[et][tt][i] * acc[et][tt][i];
        s += SHX(s, 32); ss[tt] = s; }
    LAS float* sqb = (LAS float*)(lds + 67584);
    asm volatile("s_waitcnt lgkmcnt(0)" ::: "memory");
    if (hh == 0) { sqb[w * 64 + r] = ss[0]; sqb[w * 64 + 32 + r] = ss[1]; }
    __syncthreads();
    const float* gnw = in[I_GNW] + l * 128;
    f32x4 gn[2][4]; v2u rr[2][2][4];
#pragma unroll
    for (int et = 0; et < 2; ++et)
#pragma unroll
        for (int a = 0; a < 4; ++a) { const int e0 = 64 * eh + 32 * et + 8 * a + 4 * hh; gn[et][a] = *(const f32x4*)(gnw + e0);
#pragma unroll
            for (int tt = 0; tt < 2; ++tt) rr[tt][et][a] = *(const v2u*)(Rb + (size_t)(rb + 32 * tt + r) * 512 + h * 128 + e0); }
#pragma unroll
    for (int tt = 0; tt < 2; ++tt) {
        const float rstd = rsqrtf((ss[tt] + sqb[(w ^ 1) * 64 + 32 * tt + r]) * (1.f / 128.f) + EPS);
        const size_t row = (size_t)(rb + 32 * tt + r);
#pragma unroll
        for (int et = 0; et < 2; ++et)
#pragma unroll
            for (int a = 0; a < 4; ++a) { const int e0 = 64 * eh + 32 * et + 8 * a + 4 * hh; const v2u rv = rr[tt][et][a]; const f32x4 g4 = gn[et][a];
                v2u o; o.x = cvtpk(acc[et][tt][4 * a] * rstd * g4[0] * bflo(rv.x), acc[et][tt][4 * a + 1] * rstd * g4[1] * bfhi(rv.x));
                o.y = cvtpk(acc[et][tt][4 * a + 2] * rstd * g4[2] * bflo(rv.y), acc[et][tt][4 * a + 3] * rstd * g4[3] * bfhi(rv.y));
                *(v2u*)(OG + row * 512 + h * 128 + e0) = o; }
    }
    __syncthreads();
}

constexpr int NPH = 25;

__global__ void __launch_bounds__(NWAVES * 64, 2) fwd_kernel(Args args) {
    extern __shared__ __attribute__((aligned(16))) unsigned char lds_raw[];
    LAS unsigned char* lds = (LAS unsigned char*)lds_raw;
    volatile LAS unsigned* MISC = (volatile LAS unsigned*)(lds + MISC_OFF);
    const int G = gridDim.x; const int bx = blockIdx.x; const int vcu = (G % 8 == 0) ? (bx % 8) * (G / 8) + bx / 8 : bx;
    const int NGW = G * NWAVES;
    const int wave_s_ = __builtin_amdgcn_readfirstlane((int)threadIdx.x >> 6);
    for (int i = threadIdx.x; i < (LDS_BYTES - LDSCTL_OFF) / 4; i += NWAVES * 64) ((LAS unsigned*)(lds + LDSCTL_OFF))[i] = 0u;
    __syncthreads();
    XcdBarrier bar; bar.bar = (unsigned*)(args.ws + WS_CTL) + CW_BAR; bar.x = 0; bar.st = nullptr;
    if (MK_ONE_LAUNCH) bar = xcd_barrier_post((unsigned*)(args.ws + WS_CTL) + CW_BAR, MISC + 8);
    const int lo = args.ph_lo, hi = args.ph_hi;
#define IN(k) (lo <= (k) && (k) < hi)
#ifdef PROBE_LO
#define STAMP(k) do { if (blockIdx.x == 0 && threadIdx.x == 0) ((unsigned long long*)(args.ws + WS_CTL + 131072))[(k)] = __builtin_amdgcn_s_memrealtime(); } while (0)
#else
#define STAMP(k) do {} while (0)
#endif
#define SEAM(k) do { if (lo <= (k) && (k) + 1 < hi) xcd_barrier(bar); STAMP((k) + 1); } while (0)
    STAMP(0);

    if (IN(0)) { PHASE_BEGIN();
        {
            LAS float* sil = (LAS float*)(lds + 73728);
            LAS float* red = (LAS float*)(lds + 73728 + 20480);
            for (int i = tid; i < 5 * 1024; i += 512) { const int bi = i >> 10, k = i & 1023; const float v = bi < 4 ? in[I_C][bi * 1024 + k] : in[I_CCTX][k]; sil[i] = siluf_(v); }
            __syncthreads();
            for (int it = vcu; it < 2 * 96; it += G) {
                const int l = it / 96, n0 = (it % 96) * 64, kk = lane >> 4, q = lane & 15;
                f32x4 a[5];
#pragma unroll
                for (int bi = 0; bi < 5; ++bi) a[bi] = (f32x4){0.f, 0.f, 0.f, 0.f};
                const float* wp = in[I_WMOD] + (size_t)l * 1024 * 6144 + n0 + 4 * q;
#pragma unroll 8
                for (int i2 = 0; i2 < 32; ++i2) { const int k = wave * 128 + i2 * 4 + kk; const f32x4 w = *(const f32x4*)(wp + (size_t)k * 6144);
#pragma unroll
                    for (int bi = 0; bi < 5; ++bi) a[bi] = a[bi] + w * sil[bi * 1024 + k]; }
#pragma unroll
                for (int bi = 0; bi < 5; ++bi)
#pragma unroll
                    for (int j = 0; j < 4; ++j) { float v = a[bi][j]; v += SHX(v, 16); v += SHX(v, 32); a[bi][j] = v; }
                if (lane < 16) {
#pragma unroll
                    for (int bi = 0; bi < 5; ++bi)
#pragma unroll
                        for (int j = 0; j < 4; ++j) red[(wave * 5 + bi) * 64 + 4 * q + j] = a[bi][j]; }
                __syncthreads();
                if (tid < 320) { const int bi = tid >> 6, cc = tid & 63; float s = 0.f;
#pragma unroll
                    for (int w = 0; w < 8; ++w) s += red[(w * 5 + bi) * 64 + cc];
                    MODV[(l * 5 + bi) * 6144 + n0 + cc] = s + in[I_BMOD][l * 6144 + n0 + cc]; }
                __syncthreads();
            }
        }
        for (int i = gw * 64 + lane; i < 2 * 2 * 32 * 64; i += NGW * 64) {
            const int p = i & 63, g = (i >> 6) & 31, dir = (i >> 11) & 1, l = i >> 12;
            const float* are = in[dir ? I_AREB : I_AREF]; const float* aim = in[dir ? I_AIMB : I_AIMF]; const float* ldt = in[dir ? I_LDTB : I_LDTF];
            const double ar = are[(l * 32 + g) * 64 + p], ai = aim[(l * 32 + g) * 64 + p], dt = exp((double)ldt[l * 32 + g]);
            const double mag = exp(ar * dt), lr = mag * cos(ai * dt), li = mag * sin(ai * dt);
            LAMB[i] = (f32x2){(float)lr, (float)li};
            {
                bf16* pt = PT32 + ((size_t)(((l * 2 + dir) * 32 + g) * 2 + (p >> 5)) * 32) * 64 + 2 * (p & 31); float pr = (float)lr, pi = (float)li;
                for (int k = 1; k <= 32; ++k) { const int j = dir ? 32 - k : k - 1; *(unsigned*)(pt + j * 64) = pk2(pr, pi); const float nr = pr * (float)lr - pi * (float)li, ni = pr * (float)li + pi * (float)lr; pr = nr; pi = ni; }
            }
            const double nr = lr - 1.0, ni = li, den = ar * ar + ai * ai, cr = (nr * ar + ni * ai) / den, ci = (ni * ar - nr * ai) / den;
            const float* bre = in[I_BRE] + ((size_t)(l * 32 + g) * 64 + p) * 16; const float* bim = in[I_BIM] + ((size_t)(l * 32 + g) * 64 + p) * 16;
            bf16* bm = BMT + ((size_t)(((l * 2 + dir) * 32 + g) * 2 + (p >> 5)) * 2) * 512 + (p & 31) * 16;
            for (int j = 0; j < 16; ++j) { const double br = bre[j], bi2 = bim[j]; const float vr = (float)(cr * br - ci * bi2), vi = (float)(cr * bi2 + ci * br);
                BBAR[(size_t)i * 16 + j] = (f32x2){vr, vi}; bm[j] = (bf16)f2bf(vr); bm[512 + j] = (bf16)f2bf(vi); }
        }
        for (int i = gw * 64 + lane; i < 2 * 32 * 16 * 2 * 64; i += NGW * 64) {
            const int k = i & 63, ph = (i >> 6) & 1, hh = (i >> 7) & 15, g = (i >> 11) & 31, l = i >> 16, p = 32 * ph + (k >> 1);
            const size_t ci = ((size_t)(l * 32 + g) * 16 + hh) * 64 + p;
            CMT[i] = (bf16)f2bf((k & 1) ? -in[I_CIM][ci] : in[I_CRE][ci]);
        }
        for (int i = gw * 64 + lane; i < 2 * 2 * 256 * 128; i += NGW * 64) {
            const int n = i & 255, kc = (i >> 8) & 127, dir = (i >> 15) & 1, l = i >> 16;
            const float* lr = in[dir ? I_LRB : I_LRF] + (size_t)l * 16 * 256 + n; float lrv[16];
#pragma unroll
            for (int j = 0; j < 16; ++j) lrv[j] = lr[j * 256];
            float o[8];
#pragma unroll
            for (int kk = 0; kk < 8; ++kk) { const float* wr_ = in[I_WIN] + ((size_t)l * 1024 + kc * 8 + kk) * INW_SRC + 768 + 16 * dir; float s = 0.f;
#pragma unroll
                for (int j4 = 0; j4 < 4; ++j4) { const f32x4 w = *(const f32x4*)(wr_ + 4 * j4); s += w[0] * lrv[4 * j4] + w[1] * lrv[4 * j4 + 1] + w[2] * lrv[4 * j4 + 2] + w[3] * lrv[4 * j4 + 3]; }
                o[kk] = s; }
            v2u w; w.x = pk4_i8(o[0] * SC_WGU, o[1] * SC_WGU, o[2] * SC_WGU, o[3] * SC_WGU); w.y = pk4_i8(o[4] * SC_WGU, o[5] * SC_WGU, o[6] * SC_WGU, o[7] * SC_WGU);
            *(v2u*)((unsigned char*)(wb + W_IN) + ((size_t)l * INW + 768 + 256 * dir + n) * 1024 + kc * 8) = w;
        }
        {
            LAS unsigned char* scr = lds + wave * 9216;
            constexpr int IT_IN = 16 * 64, IT_GLU = 8 * 8, IT_P = 8 * 16, IT_OUT = 16 * 16, IT_F = 16 * 44, IT_FD = 44 * 16;
            constexpr int IT_L = IT_IN + IT_GLU + 2 * IT_P + IT_OUT, NIT = 2 * IT_L + 2 * IT_F + IT_FD;
            const int dgw = NGW > 256 ? gw - 128 : gw, dng = NGW > 256 ? NGW - 128 : NGW;
            if (dgw >= 0) for (int it = dgw; it < NIT; it += dng) {
                int r = it;
                if (r < 2 * IT_L) { const int l = r / IT_L; r -= l * IT_L;
                    if (conv_matrix_q<2>(r, in[I_WIN] + (size_t)l * 1024 * INW_SRC, 1024, INW_SRC, (unsigned char*)(wb + W_IN) + (size_t)l * INW * 1024, 1, 0, SC_WGU, scr, lane)) continue;
                    if (conv_matrix(r, in[I_WGLU] + (size_t)l * 512 * 512, 512, 512, (bf16*)(wb + W_GLU) + (size_t)l * 512 * 512, 0, 0, scr, lane)) continue;
                    if (conv_matrix(r, in[I_WGP] + (size_t)l * 512 * 1024, 512, 1024, (bf16*)(wb + W_GP) + (size_t)l * 1024 * 512, 0, 0, scr, lane)) continue;
                    if (conv_matrix(r, in[I_WSP] + (size_t)l * 512 * 1024, 512, 1024, (bf16*)(wb + W_SP) + (size_t)l * 1024 * 512, 0, 0, scr, lane)) continue;
                    conv_matrix_q<2>(r, in[I_WOUT] + (size_t)l * 1024 * 1024, 1024, 1024, (unsigned char*)(wb + W_OUT) + (size_t)l * 1024 * 1024, 0, 0, SC_WGU, scr, lane); continue; }
                r -= 2 * IT_L;
                if (conv_matrix_q<2>(r, in[I_FG], 1024, FFD, (unsigned char*)(wb + W_FGU), 2, 0, SC_WGU, scr, lane)) continue;
                if (conv_matrix_q<2>(r, in[I_FU], 1024, FFD, (unsigned char*)(wb + W_FGU), 2, 128, SC_WGU, scr, lane)) continue;
                conv_matrix(r, in[I_FD], FFD, 1024, (bf16*)(wb + W_FD), 0, 0, scr, lane);
            }
        }
    }
    SEAM(0);

    for (int l = 0; l < 2; ++l) {
        const int pb = 1 + 11 * l;
#define MODVL (MODV + (size_t)l * 5 * 6144)
#define RES_L (l == 0 ? in[I_X] : (const float*)LATX)
#define RES_C (l == 0 ? in[I_CTX] : (const float*)(LATX + (size_t)NLAT * 1024))
        const int nrows = NROW;
        const int mpan = l == 0 ? NPAN : NLAT / 256;
        if (IN(pb + 0)) { PHASE_BEGIN();
            const float* nw = in[I_N1W] + l * 1024;
            for (int row = gw; row < nrows; row += NGW) {
                const float* xr = row < NLAT ? RES_L + (size_t)row * 1024 : RES_C + (size_t)(row - NLAT) * 1024;
                const int bi = row < NLAT ? row >> 12 : 4; const float* sh = MODVL + bi * 6144; const float* sc = sh + 1024;
                f32x4 v[4]; float ss = 0.f;
#pragma unroll
                for (int j = 0; j < 4; ++j) { v[j] = *(const f32x4*)(xr + 4 * lane + 256 * j);
                    if (l == 1 && row >= NLAT) {
                        f32x4 a = (f32x4){0.f, 0.f, 0.f, 0.f};
#pragma unroll
                        for (int k11 = 0; k11 < 11; ++k11) a = a + *(const f32x4*)(FPART + ((size_t)k11 * NCTX + (row - NLAT)) * 1024 + 4 * lane + 256 * j);
                        v[j] = v[j] + *(const f32x4*)(MODV + 4 * 6144 + 5 * 1024 + 4 * lane + 256 * j) * a; }
                    ss += v[j][0] * v[j][0] + v[j][1] * v[j][1] + v[j][2] * v[j][2] + v[j][3] * v[j][3]; }
                const float rstd = rsqrtf(wave_sum(ss, lane) * (1.f / 1024.f) + EPS);
                float am = 1e-20f;
#pragma unroll
                for (int j = 0; j < 4; ++j) { const int c = 4 * lane + 256 * j; const f32x4 w = *(const f32x4*)(nw + c), s1 = *(const f32x4*)(sc + c), s0 = *(const f32x4*)(sh + c);
#pragma unroll
                    for (int e = 0; e < 4; ++e) { v[j][e] = v[j][e] * rstd * w[e] * (1.f + s1[e]) + s0[e]; am = fmaxf(am, fabsf(v[j][e])); } }
#pragma unroll
                for (int o = 1; o < 64; o <<= 1) am = fmaxf(am, SHX(am, o));
                const float sx = 127.f * __builtin_amdgcn_rcpf(am);
#pragma unroll
                for (int j = 0; j < 4; ++j) *(unsigned*)((unsigned char*)XN + (size_t)row * 1024 + 4 * lane + 256 * j) = pk4_i8(v[j][0] * sx, v[j][1] * sx, v[j][2] * sx, v[j][3] * sx);
                LDS_WAIT();
                if (lane == 0) XNS1[row] = am * (1.f / 127.f);
            }
        }
        SEAM(pb + 0);
        if (IN(pb + 1)) { PHASE_BEGIN();
            pg8::Order S; S.init1(G, bxp, XN, (unsigned char*)(wb + W_IN) + (size_t)l * INW * 1024, NPAN, 18, 512);
            EpiInProj E{Kb, Vb, Ub, Qb, Rb, GAb, GMb, GF, GB, in[I_BIASF] + l * 256, in[I_BIASB] + l * 256, XNS1, (LAS float*)(lds + EPI_SB_OFF)};
            pg8::gemm_phase<EpiInProj, pg8::Order, false, true, true, 2>(lds + RING_OFF, tid, 512, S, E);
        }
        SEAM(pb + 1);
        if (IN(pb + 2)) { PHASE_BEGIN();
            for (int u = vcu; u < 4 * 68; u += G) gla_c1_unit(ws, lds, u / 68, u % 68, tid);
            {
                const int extra = 4 * 68 > G ? 4 * 68 - G : 0;
                if (vcu >= extra) for (int wu = (vcu - extra) * NWAVES + wave; wu < 4 * 68 * 32; wu += (G - extra) * NWAVES) {
                    const int g = wu & 31, ts = (wu >> 5) % 68, b = (wu >> 5) / 68;
                    s5_unit<0>(ws, in, lds + wave * 9216, l, b, ts, g, lane);
                }
            }
        }
        SEAM(pb + 2);
        if (IN(pb + 3)) { PHASE_BEGIN();
            for (int i = gw * 64 + lane; i < 32 * 128 * 32; i += NGW * 64) {
                const int dp = i & 31, e = (i >> 5) & 127, chain = i >> 12;
                const bf16* dsp = DSB + (size_t)chain * 68 * 8192 + e * 64 + 2 * dp; bf16* sp = SSTB + (size_t)chain * 68 * 8192 + e * 64 + 2 * dp; const float* dcp = DECB + (size_t)chain * 68 * 64 + 2 * dp;
                float s0 = 0.f, s1 = 0.f;
#pragma unroll 1
                for (int cb = 0; cb < 68; cb += 17) {
                    f32x2 t[17], dc[17];
#pragma unroll
                    for (int j = 0; j < 17; ++j) { const unsigned tw = *(const unsigned*)(dsp + (size_t)(cb + j) * 8192); t[j] = (f32x2){bflo(tw), bfhi(tw)}; dc[j] = *(const f32x2*)(dcp + (cb + j) * 64); }
#pragma unroll
                    for (int j = 0; j < 17; ++j) { *(unsigned*)(sp + (size_t)(cb + j) * 8192) = cvtpk(s0, s1); s0 = dc[j][0] * s0 + t[j][0]; s1 = dc[j][1] * s1 + t[j][1]; }
                }
            }
            if (wave == 0) for (int i = vcu * 64 + lane; i < 2 * 4 * 32 * 64; i += G * 64) {
                const int p = i & 63, g = (i >> 6) & 31, dir = i >> 13;
                const f32x2 lam = LAMB[((l * 2 + dir) * 32 + g) * 64 + p];
                float ar = lam[0], ai = lam[1];
#pragma unroll
                for (int q = 0; q < 6; ++q) cmul(ar, ai, ar, ai);
                const f32x2* f = S5F + (size_t)(i >> 6) * 68 * 64 + p; f32x2* fo = S5H + (size_t)(i >> 6) * 68 * 64 + p;
                float hr = 0.f, hi_ = 0.f;
#pragma unroll 1
                for (int cb = 0; cb < 68; cb += 17) { f32x2 t[17];
#pragma unroll
                    for (int j = 0; j < 17; ++j) t[j] = f[(cb + j) * 64];
#pragma unroll
                    for (int j = 0; j < 17; ++j) { fo[(cb + j) * 64] = (f32x2){hr, hi_}; const float nr = ar * hr - ai * hi_ + t[j][0], ni = ar * hi_ + ai * hr + t[j][1]; hr = nr; hi_ = ni; } }
            }
        }
        SEAM(pb + 3);
        if (IN(pb + 4)) { PHASE_BEGIN();
            {
                const int skip = l == 1 ? 4 : 0, nts = 68 - skip;
                for (int u = vcu; u < 4 * nts; u += G) gla_c3_unit(ws, in, lds, l, u / nts, skip + u % nts, tid);
                const int extra = 4 * nts > G ? 4 * nts - G : 0;
                if (vcu >= extra) for (int wu = vcu - extra; wu < 4 * nts * 4; wu += G - extra) {
                    const int g = 8 * (wu & 3) + wave, ts = skip + (wu >> 2) % nts, b = (wu >> 2) / nts;
                    s5_unit<1>(ws, in, lds + wave * 9216, l, b, ts, g, lane);
                }
            }
        }
        SEAM(pb + 4);
        if (IN(pb + 5)) { PHASE_BEGIN();
            pg8::Order S; S.init1(G, bxp, SG, (bf16*)(wb + W_GLU) + (size_t)l * 512 * 512, mpan, 2, 512);
            S.A1 = (const char*)OG; S.B1 = (const char*)((bf16*)(wb + W_GP) + (size_t)l * 1024 * 512); S.nM1 = mpan; S.nN1 = 4; S.kind1 = 1;
            EpiD12 E{SG, S2, in[I_BGLU] + l * 512, GAb, Tb};
            pg8::gemm_phase<EpiD12, pg8::Order>(lds + RING_OFF, tid, 512, S, E);
        }
        SEAM(pb + 5);
        if (IN(pb + 6)) { PHASE_BEGIN();
            pg8::Order S; S.init1(G, bxp, S2, (bf16*)(wb + W_SP) + (size_t)l * 1024 * 512, mpan, 4, 512);
            EpiD3 E{Tb, GMb, XN};
            pg8::gemm_phase<EpiD3, pg8::Order>(lds + RING_OFF, tid, 512, S, E);
            if (l == 0 && G == 256 && bxp >= NPAN * 4 - G) {
                int lane2; asm volatile("v_mbcnt_lo_u32_b32 %0, -1, 0\n\tv_mbcnt_hi_u32_b32 %0, -1, %0" : "=v"(lane2));
                LAS unsigned char* scr = lds + wave * 9216;
                constexpr int IT_G = 16 * 56;
                const int nidle = 2 * G - NPAN * 4;
                for (int it = (bxp - (NPAN * 4 - G)) * NWAVES + wave; it < MOE_NPRE * 2 * IT_G; it += nidle * NWAVES) {
                    const int e = it / (2 * IT_G); int r = it - e * 2 * IT_G; unsigned char* dst = ws + WS_XN + 17 * MiB + (size_t)e * 7168 * 1024;
                    if (conv_matrix_q<2>(r, in[I_MG] + (size_t)e * 1024 * FFE, 1024, FFE, dst, 2, 0, SC_WGU, scr, lane2)) continue;
                    conv_matrix_q<2>(r, in[I_MU] + (size_t)e * 1024 * FFE, 1024, FFE, dst, 2, 128, SC_WGU, scr, lane2);
                }
            }
        }
        SEAM(pb + 6);
        if (IN(pb + 7)) { PHASE_BEGIN();
            pg8::Order S; S.init1(G, bxp, XN, (unsigned char*)(wb + W_OUT) + (size_t)l * 1024 * 1024, NLAT / 256, 4, 512);
            if (l == 0) { S.A1 = S.A0; S.B1 = S.B0; S.nM1 = NPAN - NLAT / 256; S.nN1 = 4; S.kind1 = 1; S.nt1 = 2; S.ksl1 = 4; S.kbytes1 = (size_t)256; S.pm1off = NLAT / 256; }
            EpiResidT<true> E{RES_L, RES_C, LATX, MODVL, 2, FPART, 1.f / (SC_MB * SC_WGU)};
            pg8::gemm_phase<EpiResidT<true>, pg8::Order, true, true, true, 2>(lds + RING_OFF, tid, 512, S, E);
        }
        SEAM(pb + 7);
        if (IN(pb + 8)) { PHASE_BEGIN();
            const float* nw = in[I_N2W] + l * 1024;
            LAS float* rw = (LAS float*)(lds);
            if (l == 1) { for (int i = tid; i < 8192; i += 512) rw[i] = in[I_ROUTER][i]; __syncthreads(); }
            const int nr2 = l == 0 ? NROW : NLAT;
            for (int row = gw; row < nr2; row += NGW) {
                const float* xr = LATX + (size_t)row * 1024;
                const int bi = row < NLAT ? row >> 12 : 4; const float* sh = MODVL + bi * 6144 + 3 * 1024; const float* sc = sh + 1024;
                f32x4 v[4]; float ss = 0.f;
#pragma unroll
                for (int j = 0; j < 4; ++j) {
                    if (l == 0 && row >= NLAT) {
                        f32x4 a = (f32x4){0.f, 0.f, 0.f, 0.f};
#pragma unroll 1
                        for (int k4 = 0; k4 < 4; ++k4) a = a + *(const f32x4*)(FPART + ((size_t)k4 * NCTX + (row - NLAT)) * 1024 + 4 * lane + 256 * j);
                        v[j] = *(const f32x4*)(in[I_CTX] + (size_t)(row - NLAT) * 1024 + 4 * lane + 256 * j) + *(const f32x4*)(MODV + 4 * 6144 + 2 * 1024 + 4 * lane + 256 * j) * a;
                        *(f32x4*)(LATX + (size_t)row * 1024 + 4 * lane + 256 * j) = v[j];
                    } else v[j] = *(const f32x4*)(xr + 4 * lane + 256 * j);
                    ss += v[j][0] * v[j][0] + v[j][1] * v[j][1] + v[j][2] * v[j][2] + v[j][3] * v[j][3]; }
                const float rstd = rsqrtf(wave_sum(ss, lane) * (1.f / 1024.f) + EPS);
                float lg[8]; float am1 = 1e-20f;
#pragma unroll
                for (int e = 0; e < 8; ++e) lg[e] = 0.f;
                if (l == 0) {
                    float am = 1e-20f;
#pragma unroll
                    for (int j = 0; j < 4; ++j) { const int c = 4 * lane + 256 * j; const f32x4 w = *(const f32x4*)(nw + c), s1 = *(const f32x4*)(sc + c), s0 = *(const f32x4*)(sh + c);
#pragma unroll
                        for (int e = 0; e < 4; ++e) { v[j][e] = v[j][e] * rstd * w[e] * (1.f + s1[e]) + s0[e]; am = fmaxf(am, fabsf(v[j][e])); } }
#pragma unroll
                    for (int o = 1; o < 64; o <<= 1) am = fmaxf(am, SHX(am, o));
                    const float sx = 127.f * __builtin_amdgcn_rcpf(am);
#pragma unroll
                    for (int j = 0; j < 4; ++j) *(unsigned*)((unsigned char*)XN + (size_t)row * 1024 + 4 * lane + 256 * j) = pk4_i8(v[j][0] * sx, v[j][1] * sx, v[j][2] * sx, v[j][3] * sx);
                    LDS_WAIT();
                    if (lane == 0) XNS[row] = am * (1.f / 127.f);
                    continue;
                }
#pragma unroll
                for (int j = 0; j < 4; ++j) { const int c = 4 * lane + 256 * j; const f32x4 w = *(const f32x4*)(nw + c), s1 = *(const f32x4*)(sc + c), s0 = *(const f32x4*)(sh + c);
                    f32x4 y;
#pragma unroll
                    for (int e = 0; e < 4; ++e) { y[e] = v[j][e] * rstd * w[e] * (1.f + s1[e]) + s0[e]; am1 = fmaxf(am1, fabsf(y[e])); }
                    v[j] = y;
                    {
#pragma unroll
                        for (int e = 0; e < 4; ++e) { const f32x4 r0 = *(const LAS f32x4*)(rw + (c + e) * 8), r1 = *(const LAS f32x4*)(rw + (c + e) * 8 + 4);
                            lg[0] += y[e] * r0[0]; lg[1] += y[e] * r0[1]; lg[2] += y[e] * r0[2]; lg[3] += y[e] * r0[3]; lg[4] += y[e] * r1[0]; lg[5] += y[e] * r1[1]; lg[6] += y[e] * r1[2]; lg[7] += y[e] * r1[3]; } } }
                if (l == 1) {
#pragma unroll
                    for (int o = 1; o < 64; o <<= 1) am1 = fmaxf(am1, SHX(am1, o));
                    { const float sx = 127.f * __builtin_amdgcn_rcpf(am1);
#pragma unroll
                      for (int j = 0; j < 4; ++j) *(unsigned*)(XN2 + (size_t)row * 1024 + 4 * lane + 256 * j) = pk4_i8(v[j][0] * sx, v[j][1] * sx, v[j][2] * sx, v[j][3] * sx); }
#pragma unroll
                    for (int e = 0; e < 8; ++e) lg[e] = wave_sum(lg[e], lane);
                    int e1 = 0; float v1 = lg[0];
#pragma unroll
                    for (int e = 1; e < 8; ++e) if (lg[e] > v1) { v1 = lg[e]; e1 = e; }
                    int e2 = -1; float v2 = -3.0e38f;
#pragma unroll
                    for (int e = 0; e < 8; ++e) if (e != e1 && lg[e] > v2) { v2 = lg[e]; e2 = e; }
                    if (lane == 0) {
                        const float w1 = 1.f / (1.f + __expf(v2 - v1));
                        const int p1 = (int)__hip_atomic_fetch_add(ctl + CW_CNT + 64 * e1, 1u, RLX_AGENT), p2 = (int)__hip_atomic_fetch_add(ctl + CW_CNT + 64 * e2, 1u, RLX_AGENT);
                        TOKE[row] = make_int4(e1, p1, e2, p2); TOKW[row] = (f32x2){w1, 1.f - w1}; XNS[row] = am1 * (1.f / 127.f);
                    }
                }
            }
        }
        SEAM(pb + 8);
        if (l == 0) {
            if (IN(10)) { PHASE_BEGIN();
                pg8::Order S; S.init1(G, bxp, XN, wb + W_FGU, NPAN, 22, 512);
                EpiSwigluS<true, false> E{(unsigned char*)HMID, FFD, 0, XNS, 1.f / SC_WGU, 1.f, (LAS float*)(lds + EPI_SB_OFF)};
                pg8::gemm_phase<EpiSwigluS<true, false>, pg8::Order, false, true, true, 2>(lds + RING_OFF, tid, 512, S, E);
            }
            SEAM(10);
            if (IN(11)) { PHASE_BEGIN();
                pg8::Order S; S.init1(G, bxp, HMID, (bf16*)(wb + W_FD), NLAT / 256, 4, FFD);
                S.A1 = S.A0; S.B1 = S.B0; S.nM1 = NPAN - NLAT / 256; S.nN1 = 4; S.kind1 = 1; S.nt1 = 4; S.ksl1 = 11; S.kbytes1 = (size_t)256 * 2; S.pm1off = NLAT / 256;
                EpiResid E{LATX, LATX + (size_t)NLAT * 1024, LATX, MODVL, 5, FPART, 1.f};
                pg8::gemm_phase<EpiResid, pg8::Order, true>(lds + RING_OFF, tid, FFD, S, E);
            }
            SEAM(11);
        }
    }

    int pbase[9];
    {
        int a = 0;
#pragma unroll
        for (int e = 0; e < 8; ++e) { pbase[e] = a; const unsigned c = hi > 21 ? __hip_atomic_load((gu32*)(args.ws + WS_CTL) + CW_CNT + 64 * e, RLX_AGENT) : 0u; a += (int)((c + 255u) >> 8); }
        pbase[8] = a;
    }
    if (IN(21)) { PHASE_BEGIN();
        {
            LAS unsigned char* scr = lds + wave * 9216;
            constexpr int IT_G = 16 * 56, IT_D = 56 * 16;
            const int ite = G >= 8 * MOE_NCONV ? 2 * IT_G : 2 * IT_G + IT_D;
            const int e0 = G == 256 ? MOE_NPRE : 0;
            for (int it = gw; it < (8 - e0) * ite; it += NGW) {
                const int e = e0 + it / ite; int r = it - (e - e0) * ite;
                if (conv_matrix_q<2>(r, in[I_MG] + (size_t)e * 1024 * FFE, 1024, FFE, WMGU + (size_t)e * 7168 * 1024, 2, 0, SC_WGU, scr, lane)) continue;
                if (conv_matrix_q<2>(r, in[I_MU] + (size_t)e * 1024 * FFE, 1024, FFE, WMGU + (size_t)e * 7168 * 1024, 2, 128, SC_WGU, scr, lane)) continue;
                conv_matrix_q<1>(r, in[I_MD] + (size_t)e * FFE * 1024, FFE, 1024, WMD + (size_t)e * 1024 * FFE, 0, 0, SC_WD, scr, lane);
            }
        }
        v4u qn; int4 ten; float isn;
        { const int r0 = gw < NLAT ? gw : 0; ten = TOKE[r0]; isn = XNS[r0]; qn = *(const v4u*)(XN2 + (size_t)r0 * 1024 + 16 * lane); }
        for (int row = gw; row < NLAT; row += NGW) {
            const int4 te = ten; const float isx = isn; const v4u q = qn;
            { const int rn = row + NGW < NLAT ? row + NGW : row; ten = TOKE[rn]; isn = XNS[rn]; qn = *(const v4u*)(XN2 + (size_t)rn * 1024 + 16 * lane); }
            int s1 = 0, s2 = 0;
#pragma unroll
            for (int e = 0; e < 8; ++e) { if (te.x == e) s1 = pbase[e] * 256 + te.y; if (te.z == e) s2 = pbase[e] * 256 + te.w; }
            if (lane == 0) { TOKS[row] = make_int2(s1, s2); XSI[s1] = isx; XSI[s2] = isx; }
            *(v4u*)(XG + (size_t)s1 * 1024 + 16 * lane) = q; *(v4u*)(XG + (size_t)s2 * 1024 + 16 * lane) = q;
        }
    }
    SEAM(21);
    {
        const int P = pbase[8];
        if (IN(22)) { PHASE_BEGIN();
            const int nconv = G >= 8 * MOE_NCONV ? MOE_NCONV : 0, Gg = G - nconv;
            if (bxp >= Gg) {
                LAS unsigned char* scr = lds + wave * 9216;
                constexpr int IT_D = 56 * 16;
                for (int it = (bxp - Gg) * NWAVES + wave; it < 8 * IT_D; it += nconv * NWAVES) {
                    const int e = it / IT_D; int r = it - e * IT_D;
                    conv_matrix_q<1>(r, in[I_MD] + (size_t)e * FFE * 1024, FFE, 1024, WMD + (size_t)e * 1024 * FFE, 0, 0, SC_WD, scr, lane);
                }
            } else {
                pg8::Order S; S.init1(Gg, bxp, XG, WMGU, P, 28, 512);
                S.moe = 1; S.pb1 = pbase[1]; S.pb2 = pbase[2]; S.pb3 = pbase[3]; S.pb4 = pbase[4]; S.pb5 = pbase[5]; S.pb6 = pbase[6]; S.pb7 = pbase[7]; S.estride = (size_t)7168 * 1024;
                if (G == 256) { S.nelo = MOE_NPRE; S.elo = (size_t)(WS_XN + 17 * MiB) - (size_t)(WS_WM + WM_GU); }
                EpiSwigluS<true, true> E{HM, FFE, 0, XSI, 1.f / SC_WGU, SC_H, (LAS float*)(lds + EPI_SB_OFF)};
                pg8::gemm_phase<EpiSwigluS<true, true>, pg8::Order, false, true, true, 2>(lds + RING_OFF, tid, 512, S, E);
            }
        }
        SEAM(22);
        if (IN(23)) { PHASE_BEGIN();
            const int nmain = P < 128 ? P : 128, ntail = P - nmain;
            pg8::Order S; S.init1(G, bxp, HM, WMD, nmain, 4, FFE / 2);
            S.moe = 1; S.pb1 = pbase[1]; S.pb2 = pbase[2]; S.pb3 = pbase[3]; S.pb4 = pbase[4]; S.pb5 = pbase[5]; S.pb6 = pbase[6]; S.pb7 = pbase[7]; S.estride = (size_t)1024 * FFE;
            S.A1 = S.A0; S.B1 = S.B0; S.nM1 = ntail; S.nN1 = 4; S.kind1 = 1; S.nt1 = 4; S.ksl1 = 7; S.kbytes1 = (size_t)512;
            S.pm1off = nmain;
            EpiPlain E{YS, YTP, 1.f / (SC_H * SC_WD)};
            pg8::gemm_phase<EpiPlain, pg8::Order, true, true, true, 1>(lds + RING_OFF, tid, FFE / 2, S, E);
        }
        SEAM(23);
    }
    if (IN(24)) { PHASE_BEGIN();
        const float* modv = MODV + (size_t)5 * 6144; const float* fw = in[I_FNW];
#ifdef PROBE_LO
        const unsigned long long* stp = (const unsigned long long*)(ws + WS_CTL + 131072);
        const float probe_scale = 1.0f + (float)(__hip_atomic_load(stp + PROBE_HI, RLX_AGENT) - __hip_atomic_load(stp + PROBE_LO, RLX_AGENT)) * 0.01f * 5e-4f;
#else
        const float probe_scale = 1.0f;
#endif
        f32x4 fwv[4];
#pragma unroll
        for (int j = 0; j < 4; ++j) fwv[j] = *(const f32x4*)(fw + 4 * lane + 256 * j);
        int2 sl_c = make_int2(0, 0), sl_n = make_int2(0, 0); f32x2 tw_c = (f32x2){0.f, 0.f}, tw_n = (f32x2){0.f, 0.f};
        f32x4 xn[4], gn_[4]; v2u y1n[4], y2n[4];
#define FIN_LOAD(row_, sl_) do { const float* xr_ = LATX + (size_t)(row_) * 1024; const float* g2_ = modv + ((row_) >> 12) * 6144 + 5 * 1024; \
            const bf16* y1p_ = YS + (size_t)((sl_).x >= 32768 ? 0 : (sl_).x) * 1024; const bf16* y2p_ = YS + (size_t)((sl_).y >= 32768 ? 0 : (sl_).y) * 1024; \
            _Pragma("unroll") for (int j = 0; j < 4; ++j) { const int c = 4 * lane + 256 * j; xn[j] = *(const f32x4*)(xr_ + c); gn_[j] = *(const f32x4*)(g2_ + c); y1n[j] = *(const v2u*)(y1p_ + c); y2n[j] = *(const v2u*)(y2p_ + c); } } while (0)
        if (gw < NLAT) { sl_c = TOKS[gw]; tw_c = TOKW[gw]; }
        if (gw + NGW < NLAT) { sl_n = TOKS[gw + NGW]; tw_n = TOKW[gw + NGW]; }
        if (gw < NLAT) FIN_LOAD(gw, sl_c);
        for (int row = gw; row < NLAT; row += NGW) {
            const int2 sl = sl_c; const f32x2 tw = tw_c;
            f32x4 x[4], gg[4]; v2u y1[4], y2[4];
#pragma unroll
            for (int j = 0; j < 4; ++j) { x[j] = xn[j]; gg[j] = gn_[j]; y1[j] = y1n[j]; y2[j] = y2n[j]; }
            sl_c = sl_n; tw_c = tw_n;
            if (row + NGW < NLAT) FIN_LOAD(row + NGW, sl_c);
            if (row + 2 * NGW < NLAT) { sl_n = TOKS[row + 2 * NGW]; tw_n = TOKW[row + 2 * NGW]; }
            const bool tx = sl.x >= 32768, ty = sl.y >= 32768;
            f32x4 a[4], bq[4];
#pragma unroll
            for (int j = 0; j < 4; ++j) { a[j] = (f32x4){bflo(y1[j].x), bfhi(y1[j].x), bflo(y1[j].y), bfhi(y1[j].y)}; bq[j] = (f32x4){bflo(y2[j].x), bfhi(y2[j].x), bflo(y2[j].y), bfhi(y2[j].y)}; }
            if (tx) {
#pragma unroll
                for (int j = 0; j < 4; ++j) { a[j] = (f32x4){0.f, 0.f, 0.f, 0.f};
#pragma unroll
                    for (int k7 = 0; k7 < 7; ++k7) { const v2u y = *(const v2u*)(YTP + ((size_t)k7 * 2048 + (sl.x - 32768)) * 1024 + 4 * lane + 256 * j); a[j] = a[j] + (f32x4){bflo(y.x), bfhi(y.x), bflo(y.y), bfhi(y.y)}; } } }
            if (ty) {
#pragma unroll
                for (int j = 0; j < 4; ++j) { bq[j] = (f32x4){0.f, 0.f, 0.f, 0.f};
#pragma unroll
                    for (int k7 = 0; k7 < 7; ++k7) { const v2u y = *(const v2u*)(YTP + ((size_t)k7 * 2048 + (sl.y - 32768)) * 1024 + 4 * lane + 256 * j); bq[j] = bq[j] + (f32x4){bflo(y.x), bfhi(y.x), bflo(y.y), bfhi(y.y)}; } } }
            f32x4 v[4]; float ss = 0.f;
#pragma unroll
            for (int j = 0; j < 4; ++j) { v[j] = x[j] + gg[j] * (a[j] * tw[0] + bq[j] * tw[1]); ss += v[j][0] * v[j][0] + v[j][1] * v[j][1] + v[j][2] * v[j][2] + v[j][3] * v[j][3]; }
            const float rstd = rsqrtf(wave_sum(ss, lane) * (1.f / 1024.f) + EPS);
#pragma unroll
            for (int j = 0; j < 4; ++j) { const int c = 4 * lane + 256 * j; *(f32x4*)(args.out + (size_t)row * 1024 + c) = v[j] * rstd * fwv[j] * probe_scale; }
        }
#undef FIN_LOAD
    }
#undef IN
#undef SEAM
}

extern "C" void kernel_launch(void* const* d_in, const int* in_sizes, int n_in, void* d_out, int out_size, void* d_ws, size_t ws_size, hipStream_t stream) {
    static int grid = 0;
    if (grid == 0) {
        if (n_in != N_IN || out_size != NLAT * D || ws_size < WS_END) { fprintf(stderr, "kernel_launch: unexpected shapes (n_in %d, out %d, ws %zu)\n", n_in, out_size, ws_size); grid = -1; return; }
        int dev = 0, cus = 0, per_cu = 0;
        if (hipGetDevice(&dev) != hipSuccess || hipDeviceGetAttribute(&cus, hipDeviceAttributeMultiprocessorCount, dev) != hipSuccess) { grid = -1; return; }
        if (hipFuncSetAttribute((const void*)fwd_kernel, hipFuncAttributeMaxDynamicSharedMemorySize, LDS_BYTES) != hipSuccess) { fprintf(stderr, "kernel_launch: hipFuncSetAttribute failed\n"); grid = -1; return; }
        if (hipOccupancyMaxActiveBlocksPerMultiprocessor(&per_cu, (const void*)fwd_kernel, NWAVES * 64, LDS_BYTES) != hipSuccess || per_cu < 1) fprintf(stderr, "kernel_launch: occupancy query reports %d\n", per_cu);
        (void)hipGetLastError();
        grid = cus;
    }
    if (grid < 0) return;
    if (hipMemsetAsync((char*)d_ws + WS_CTL, 0, CTL_ZERO_BYTES, stream) != hipSuccess) return;
    Args a{};
    for (int i = 0; i < N_IN; ++i) a.in[i] = (const float*)d_in[i];
    a.out = (float*)d_out; a.ws = (unsigned char*)d_ws;
#if MK_ONE_LAUNCH
    a.ph_lo = 0; a.ph_hi = NPH;
    hipLaunchKernelGGL(fwd_kernel, dim3(grid), dim3(NWAVES * 64), LDS_BYTES, stream, a);
#else
    for (int p = 0; p < NPH; ++p) { a.ph_lo = p; a.ph_hi = p + 1; hipLaunchKernelGGL(fwd_kernel, dim3(grid), dim3(NWAVES * 64), LDS_BYTES, stream, a); }
#endif
}
```

```cpp
#include <hip/hip_runtime.h>
#include <cstdio>
#include <cstdint>

#ifndef MK_ONE_LAUNCH
#define MK_ONE_LAUNCH 1
#endif

namespace pg8 {
#define PG8_LAS __attribute__((address_space(3)))
typedef unsigned short bf16_t;
typedef short bf16x8 __attribute__((ext_vector_type(8)));
typedef float f32x4 __attribute__((ext_vector_type(4)));
typedef unsigned u32x4 __attribute__((ext_vector_type(4)));
constexpr int BM = 256, BK = 64, HALF = 128, HTB = HALF * BK * 2, STAGE_BYTES = 8 * HTB, NXCD = 8, WGM = 8;

__host__ __device__ __forceinline__ int lds_byte(int r, int c) { const int st = (r >> 4) * 2 + (c >> 5), rr = r & 15, cc = c & 31, ob = rr * 64 + cc * 2; return st * 1024 + (ob ^ (((ob >> 9) & 1) << 5)); }
__host__ __device__ __forceinline__ void stage_rc(int b, int& R, int& C) { const int st = b / 1024, sb = b % 1024, swz = sb ^ (((sb >> 9) & 1) << 5); R = (st >> 1) * 16 + swz / 64; C = (st & 1) * 32 + (swz % 64) / 2; }
__host__ __device__ __forceinline__ int perm32(int rho) { const int n = rho >> 4, i = rho & 15; return 8 * (i >> 2) + 4 * n + (i & 3); }

struct Unit { int pm, pn, kind, nt, slice, par; const char* A; const char* B; };

struct Order {
    int G, c;
    int n0;
    const char* A0; const char* B0; int nM0, nN0, kind0;
    const char* A1; const char* B1; int nM1, nN1, kind1;
    size_t tstep;
    int pm0;
    int pm1off;
    int apm0;
    int moe; int pb1, pb2, pb3, pb4, pb5, pb6, pb7; size_t estride;
    int nelo; size_t elo;
    int nt0, nt1;
    int ksl1; size_t kbytes1;
    __device__ __forceinline__ void init1(int G_, int c_, const void* A, const void* B, int nM, int nN, int K) {
        G = G_; c = c_; A0 = (const char*)A; B0 = (const char*)B; nM0 = nM; nN0 = nN; kind0 = 0; n0 = nM * nN; A1 = A0; B1 = B0; nM1 = 0; nN1 = 1; kind1 = 1;
        tstep = (size_t)256 * K * 2; pm0 = 0; pm1off = 0; apm0 = 0; moe = 0; pb1 = pb2 = pb3 = pb4 = pb5 = pb6 = pb7 = 0; estride = 0; nelo = 0; elo = 0; nt0 = nt1 = K / BK; ksl1 = 1; kbytes1 = 0; }
    __device__ __forceinline__ bool next(int i, Unit& u) const {
        long L = (long)i * G + c; const bool s = L >= n0; if (s) L -= n0;
        const int nM = s ? nM1 : nM0, nN = s ? nN1 : nN0, nwg = nM * nN; const int ksl = s ? ksl1 : 1; if (L >= (long)nwg * ksl) return false;
        const int slice = (int)(L % ksl); L /= ksl;
        int wgid = (int)L; { const int q = nwg / NXCD, r = nwg % NXCD, xcd = wgid % NXCD, off = wgid / NXCD; wgid = (xcd < r ? xcd * (q + 1) : r * (q + 1) + (xcd - r) * q) + off; }
        const int nig = WGM * nN, gid = wgid / nig, fm = gid * WGM, gsz = (nM - fm) < WGM ? (nM - fm) : WGM;
        const int pm = pm0 + (s ? pm1off : 0) + fm + ((wgid % nig) % gsz), pn = (wgid % nig) / gsz;
        u.pm = pm; u.pn = pn; u.kind = s ? kind1 : kind0; u.nt = s ? nt1 : nt0; u.slice = slice;
        u.A = (s ? A1 : A0) + (size_t)(pm - apm0) * tstep + (size_t)slice * kbytes1;
        const char* b = (s ? B1 : B0) + (size_t)pn * tstep + (size_t)slice * kbytes1;
        if (moe) { const int e = (pm >= pb1) + (pm >= pb2) + (pm >= pb3) + (pm >= pb4) + (pm >= pb5) + (pm >= pb6) + (pm >= pb7); b += (size_t)e * estride + (e < nelo ? elo : (size_t)0); }
        u.B = b; return true;
    }
    __device__ __forceinline__ void a_ready(const Unit&) const {}
    __device__ __forceinline__ void done(const Unit&) const {}
};

__device__ __forceinline__ unsigned cvt_pk_bf16(float lo, float hi) { unsigned r; asm volatile("v_cvt_pk_bf16_f32 %0, %1, %2" : "=v"(r) : "v"(lo), "v"(hi)); return r; }

typedef int i32x4 __attribute__((ext_vector_type(4)));
typedef int i32x8 __attribute__((ext_vector_type(8)));
__device__ __forceinline__ i32x8 cat32(bf16x8 a, bf16x8 b) { return __builtin_shufflevector(__builtin_bit_cast(i32x4, a), __builtin_bit_cast(i32x4, b), 0, 1, 2, 3, 4, 5, 6, 7); }
template <class E> struct epi_has_pre { template <class T> static auto t(int) -> decltype(&T::pre, char()); template <class T> static long t(...); static constexpr bool value = sizeof(t<E>(0)) == 1; };
template <class Epi, class Sched, bool MIXED = false, bool ALIGN_EPI = true, bool SP2 = true, int QM = 0>
__device__ __forceinline__ void gemm_phase(PG8_LAS unsigned char* lds, const int tid, const int K, const Sched& S, const Epi& E) {
    const int wid = __builtin_amdgcn_readfirstlane(tid >> 6), lane = tid & 63, wr = wid >> 2, wc = wid & 3, fr = lane & 15, fq = lane >> 4;
    unsigned voffA[2], voffB[2];
#pragma unroll
    for (int i = 0; i < 2; ++i) { int R, C; stage_rc(tid * 16 + i * 8192, R, C); const int Rb = ((R & ~31) + perm32(R & 31));
        voffA[i] = (unsigned)(R * K + C) * 2u; voffB[i] = (unsigned)(Rb * K + C) * 2u; }
    const size_t kstep = (size_t)(BK * 2);
    const size_t hstep = (size_t)HALF * K * 2;
    const unsigned ldsw = (unsigned)wid * 1024u;
    const int aoff = lds_byte(wr * 64 + fr, fq * 8), boff = lds_byte(wc * 32 + fr, fq * 8);
#define PG8_SA(b, h) (((b) * 2 + (h)) * HTB)
#define PG8_SB(b, h) ((4 + (b) * 2 + (h)) * HTB)
#define PG8_STAGE(bufoff, gbase, voff) do { _Pragma("unroll") for (int _i = 0; _i < 2; ++_i) \
        __builtin_amdgcn_global_load_lds((const unsigned*)((const char*)(gbase) + (voff)[_i]), (PG8_LAS unsigned*)(lds + (bufoff) + ldsw + _i * 8192), 16, 0, 0); } while (0)
#define PG8_LDA(dst, b, h) do { _Pragma("unroll") for (int m = 0; m < 4; ++m) _Pragma("unroll") for (int k = 0; k < 2; ++k) dst[m][k] = *(const PG8_LAS bf16x8*)(lds + PG8_SA(b, h) + aoff + m * 2048 + k * 1024); } while (0)
#define PG8_LDB(dst, b, h) do { _Pragma("unroll") for (int n = 0; n < 2; ++n) _Pragma("unroll") for (int k = 0; k < 2; ++k) dst[n][k] = *(const PG8_LAS bf16x8*)(lds + PG8_SB(b, h) + boff + n * 2048 + k * 1024); } while (0)
#define PG8_MMA(ai, bj, At, Bt) do { __builtin_amdgcn_s_setprio(1); \
        if constexpr (QM == 2) { _Pragma("unroll") for (int k = 0; k < 2; ++k) _Pragma("unroll") for (int m = 0; m < 4; ++m) _Pragma("unroll") for (int n = 0; n < 2; ++n) \
            asm volatile("v_mfma_i32_16x16x64_i8 %0, %1, %2, %0" : "+v"(acc[ai][bj][m][n]) : "v"(Bt[n][k]), "v"(At[m][k])); } \
        _Pragma("unroll") for (int m = 0; m < 4; ++m) _Pragma("unroll") for (int n = 0; n < 2; ++n) { \
        if constexpr (QM == 1) asm volatile("v_mfma_f32_16x16x128_f8f6f4 %0, %1, %2, %0" : "+v"(acc[ai][bj][m][n]) : "v"(cat32(Bt[n][0], Bt[n][1])), "v"(cat32(At[m][0], At[m][1]))); \
        else if constexpr (QM == 2) { } \
        else { _Pragma("unroll") for (int k = 0; k < 2; ++k) acc[ai][bj][m][n] = __builtin_amdgcn_mfma_f32_16x16x32_bf16(Bt[n][k], At[m][k], acc[ai][bj][m][n], 0, 0, 0); } } __builtin_amdgcn_s_setprio(0); } while (0)
#define PG8_WAIT_V(n) asm volatile("s_waitcnt vmcnt(" #n ")" ::: "memory")
#define PG8_WAIT_L(n) asm volatile("s_waitcnt lgkmcnt(" #n ")" ::: "memory")
#define PG8_BAR __builtin_amdgcn_s_barrier()
#define PG8_SCHED __builtin_amdgcn_sched_barrier(0)
    Unit cur, nxt; int ui = 0;
    if (!S.next(0, cur)) return;
    f32x4 acc[2][2][4][2];
#pragma unroll
    for (int a = 0; a < 2; ++a)
#pragma unroll
        for (int b = 0; b < 2; ++b)
#pragma unroll
            for (int m = 0; m < 4; ++m)
#pragma unroll
                for (int n = 0; n < 2; ++n) acc[a][b][m][n] = (f32x4){0.f, 0.f, 0.f, 0.f};
    bf16x8 At[4][2], B0[2][2], B1[2][2];
    const char* cA = cur.A; const char* cB = cur.B;
    cur.par = 0;
    if constexpr (epi_has_pre<Epi>::value) E.pre(cur, wid, lane);
    S.a_ready(cur);
    if constexpr (SP2) {
        PG8_STAGE(PG8_SB(0, 0), cB, voffB); PG8_STAGE(PG8_SB(0, 1), cB + hstep, voffB); PG8_STAGE(PG8_SA(0, 0), cA, voffA); PG8_STAGE(PG8_SA(0, 1), cA + hstep, voffA);
        if (wr == 1) PG8_BAR;
        PG8_WAIT_V(2); PG8_BAR;
        PG8_STAGE(PG8_SB(1, 0), cB + kstep, voffB); PG8_STAGE(PG8_SA(1, 0), cA + kstep, voffA); PG8_STAGE(PG8_SB(1, 1), cB + hstep + kstep, voffB);
        PG8_WAIT_V(6); PG8_BAR;
    } else {
        PG8_STAGE(PG8_SB(0, 0), cB, voffB); PG8_STAGE(PG8_SA(0, 0), cA, voffA); PG8_STAGE(PG8_SB(0, 1), cB + hstep, voffB); PG8_STAGE(PG8_SA(0, 1), cA + hstep, voffA);
        if (wr == 1) PG8_BAR;
        PG8_WAIT_V(4); PG8_BAR;
        PG8_STAGE(PG8_SB(1, 0), cB + kstep, voffB); PG8_STAGE(PG8_SA(1, 0), cA + kstep, voffA); PG8_STAGE(PG8_SB(1, 1), cB + hstep + kstep, voffB);
        PG8_WAIT_V(6); PG8_BAR;
    }
    for (;;) {
        const bool has_next = S.next(ui + 1, nxt);
        const char* nA = has_next ? nxt.A : cA; const char* nB = has_next ? nxt.B : cB;
        int nt = MIXED ? cur.nt : K / BK;
        if constexpr (QM != 0) asm volatile("" : "+s"(nt));
        for (int t = 0; t < nt; t += 2) {
            const bool last = (t == nt - 2);
            const char* a1 = cA + (size_t)(t + 1) * kstep;
            const char* a2 = last ? nA : cA + (size_t)(t + 2) * kstep; const char* b2 = last ? nB : cB + (size_t)(t + 2) * kstep;
            const char* a3 = a2 + kstep; const char* b3 = b2 + kstep;
            if (last && has_next) S.a_ready(nxt);
            if constexpr (SP2) {
            PG8_LDB(B0, 0, 0); PG8_LDB(B1, 0, 1); PG8_SCHED; PG8_LDA(At, 0, 0); PG8_STAGE(PG8_SA(1, 1), a1 + hstep, voffA);
            PG8_WAIT_V(8); PG8_WAIT_L(0); PG8_BAR; PG8_MMA(0, 0, At, B0); PG8_MMA(0, 1, At, B1); PG8_BAR; PG8_SCHED;
            PG8_LDA(At, 0, 1); PG8_STAGE(PG8_SB(0, 0), b2, voffB); PG8_STAGE(PG8_SB(0, 1), b2 + hstep, voffB); PG8_STAGE(PG8_SA(0, 0), a2, voffA);
            PG8_WAIT_V(8); PG8_WAIT_L(0); PG8_BAR; PG8_MMA(1, 0, At, B0); PG8_MMA(1, 1, At, B1); PG8_BAR; PG8_SCHED;
            PG8_LDB(B0, 1, 0); PG8_LDB(B1, 1, 1); PG8_SCHED; PG8_LDA(At, 1, 0); PG8_STAGE(PG8_SA(0, 1), a2 + hstep, voffA);
            PG8_WAIT_V(8); PG8_WAIT_L(0); PG8_BAR; PG8_MMA(0, 0, At, B0); PG8_MMA(0, 1, At, B1); PG8_BAR; PG8_SCHED;
            PG8_LDA(At, 1, 1); PG8_STAGE(PG8_SB(1, 0), b3, voffB); PG8_STAGE(PG8_SB(1, 1), b3 + hstep, voffB); PG8_STAGE(PG8_SA(1, 0), a3, voffA);
            PG8_WAIT_V(8); PG8_WAIT_L(0); PG8_BAR; PG8_MMA(1, 0, At, B0); PG8_MMA(1, 1, At, B1); PG8_BAR; PG8_SCHED;
            } else {
            PG8_LDB(B0, 0, 0); PG8_SCHED; PG8_LDA(At, 0, 0); PG8_STAGE(PG8_SA(1, 1), a1 + hstep, voffA);
            PG8_WAIT_L(8); PG8_BAR; PG8_WAIT_L(0); PG8_MMA(0, 0, At, B0); PG8_BAR; PG8_SCHED;
            PG8_LDB(B1, 0, 1); PG8_STAGE(PG8_SB(0, 0), b2, voffB);
            PG8_BAR; PG8_WAIT_L(0); PG8_MMA(0, 1, At, B1); PG8_BAR;
            PG8_LDA(At, 0, 1); PG8_STAGE(PG8_SA(0, 0), a2, voffA);
            PG8_BAR; PG8_WAIT_L(0); PG8_MMA(1, 0, At, B0); PG8_BAR; PG8_SCHED;
            PG8_STAGE(PG8_SB(0, 1), b2 + hstep, voffB);
            PG8_WAIT_V(6); PG8_BAR; PG8_MMA(1, 1, At, B1); PG8_BAR;
            PG8_LDB(B0, 1, 0); PG8_SCHED; PG8_LDA(At, 1, 0); PG8_STAGE(PG8_SA(0, 1), a2 + hstep, voffA);
            PG8_WAIT_L(8); PG8_BAR; PG8_WAIT_L(0); PG8_MMA(0, 0, At, B0); PG8_BAR; PG8_SCHED;
            PG8_LDB(B1, 1, 1); PG8_STAGE(PG8_SB(1, 0), b3, voffB);
            PG8_BAR; PG8_WAIT_L(0); PG8_MMA(0, 1, At, B1); PG8_BAR;
            PG8_LDA(At, 1, 1); PG8_STAGE(PG8_SA(1, 0), a3, voffA);
            PG8_BAR; PG8_WAIT_L(0); PG8_MMA(1, 0, At, B0); PG8_BAR; PG8_SCHED;
            PG8_STAGE(PG8_SB(1, 1), b3 + hstep, voffB);
            PG8_WAIT_V(6); PG8_BAR; PG8_MMA(1, 1, At, B1); PG8_BAR;
            }
        }
        if constexpr (QM != 0) asm volatile("s_nop 15\n\ts_nop 15" ::: "memory");
        if constexpr (ALIGN_EPI) { if (wr == 0) PG8_BAR; }
        E(acc, cur, wr, wc, fr, fq); S.done(cur);
        nxt.par = cur.par ^ 1;
        if constexpr (epi_has_pre<Epi>::value) { if (has_next) E.pre(nxt, wid, lane); }
        if (!has_next) break;
#pragma unroll
        for (int a = 0; a < 2; ++a)
#pragma unroll
            for (int b = 0; b < 2; ++b)
#pragma unroll
                for (int m = 0; m < 4; ++m)
#pragma unroll
                    for (int n = 0; n < 2; ++n) acc[a][b][m][n] = (f32x4){0.f, 0.f, 0.f, 0.f};
        cur = nxt; cA = nA; cB = nB; ++ui;
        if constexpr (ALIGN_EPI) { if (wr == 1) PG8_BAR; }
    }
    PG8_WAIT_V(0);
    if constexpr (!ALIGN_EPI) { if (wr == 0) PG8_BAR; }
    PG8_BAR;
#undef PG8_SA
#undef PG8_SB
#undef PG8_STAGE
#undef PG8_LDA
#undef PG8_LDB
#undef PG8_MMA
#undef PG8_WAIT_V
#undef PG8_WAIT_L
#undef PG8_BAR
#undef PG8_SCHED
}
}

constexpr int NWAVES = 8;
constexpr int D = 1024, NBATCH = 4, SEQ = 4096, CTXL = 256;
constexpr int NLAT = NBATCH * SEQ, NCTX = NBATCH * CTXL, NROW = NLAT + NCTX, NPAN = NROW / 256;
constexpr int INW_SRC = 4128, INW = 4608;
constexpr int FFD = 2816, FFE = 3584, NEXP = 8;
constexpr float EPS = 1e-6f;

constexpr size_t MiB = 1u << 20;
constexpr size_t WS_CTL = 0, CTL_ZERO_BYTES = 256 * 1024;
constexpr size_t WS_TAB = 1 * MiB;
constexpr size_t WS_LATX = 8 * MiB;
constexpr size_t WS_W = 76 * MiB;
constexpr size_t WS_XN = 120 * MiB;
constexpr size_t WS_IP = 154 * MiB;
constexpr size_t WS_DS = 324 * MiB;
constexpr size_t WS_S5F = 392 * MiB;
constexpr size_t WS_OG = 401 * MiB;
constexpr size_t WS_SG = 418 * MiB;
constexpr size_t WS_O32 = 435 * MiB;
constexpr size_t WS_Y32 = 469 * MiB;
constexpr size_t WS_SST = 435 * MiB;
constexpr size_t WS_BC = 478 * MiB;
constexpr size_t WS_S5H = 469 * MiB;
constexpr size_t WS_WM = 76 * MiB;
constexpr size_t WS_XG = 244 * MiB;
constexpr size_t WS_HM = 312 * MiB;
constexpr size_t WS_YS = 438 * MiB;
constexpr size_t WS_YT = 506 * MiB;
constexpr size_t WS_END = 534 * MiB;
constexpr size_t IP_K = 0, IP_V = IP_K + (size_t)NROW * 256 * 2, IP_GF = IP_V + (size_t)NROW * 512 * 2, IP_GB = IP_GF + (size_t)NROW * 256 * 4,
                 IP_U = IP_GB + (size_t)NROW * 256 * 4, IP_Q = IP_U + (size_t)NROW * 512 * 2, IP_R = IP_Q + (size_t)NROW * 256 * 2,
                 IP_GA = IP_R + (size_t)NROW * 512 * 2, IP_GM = IP_GA + (size_t)NROW * 1024 * 2, IP_END = IP_GM + (size_t)NROW * 1024 * 2;
static_assert(IP_END <= 170 * MiB, "in-proj region");
constexpr size_t IP_T = IP_K;
constexpr size_t IP_S2 = IP_U;
constexpr size_t IP_HMID = 0;
static_assert((size_t)NROW * 1024 * 2 <= IP_GB, "T overlay");
static_assert((size_t)NROW * FFD * 2 <= 170 * MiB, "HMID overlay");
constexpr size_t W_IN = 0;
constexpr size_t W_GLU = 18 * MiB;
constexpr size_t W_GP = 19 * MiB;
constexpr size_t W_SP = 21 * MiB;
constexpr size_t W_OUT = 23 * MiB;
constexpr size_t W_FGU = 27 * MiB;
constexpr size_t W_FD = 38 * MiB;
constexpr size_t WM_GU = 0;
constexpr size_t WM_D = 112 * MiB;
constexpr size_t T_MODV = 0;
constexpr size_t T_LAMB = 256 * 1024;
constexpr size_t T_BBAR = 512 * 1024;
constexpr size_t T_TOKE = 2 * MiB;
constexpr size_t T_TOKW = 2 * MiB + 256 * 1024;
constexpr size_t T_TOKS = 2 * MiB + 512 * 1024;
constexpr size_t T_BMT = 3 * MiB;
constexpr size_t T_CMT = 3 * MiB + 512 * 1024;
constexpr size_t T_DEC = 4 * MiB;
constexpr size_t T_PT = 5 * MiB;
constexpr size_t T_XSI = 6 * MiB;
constexpr size_t T_XNS = 6 * MiB + 256 * 1024;
constexpr int CW_TMO = 0, CW_CODE = 1;
constexpr int CW_BAR = 4096;
constexpr int CW_CNT = 16384;

constexpr int RING_OFF = 0, RING_BYTES = 135168;
constexpr int LDSCTL_OFF = RING_BYTES, MISC_OFF = LDSCTL_OFF + 320;
constexpr int LDS_BYTES = 147456;
constexpr int MOE_NPRE = 2;
constexpr int MOE_NCONV = 24;
constexpr int EPI_SB_OFF = 139264;

#define GAS __attribute__((address_space(1)))
#define LAS __attribute__((address_space(3)))
typedef unsigned short bf16;
typedef unsigned v4u __attribute__((ext_vector_type(4)));
typedef unsigned v2u __attribute__((ext_vector_type(2)));
typedef float f32x4 __attribute__((ext_vector_type(4)));
typedef float f32x2 __attribute__((ext_vector_type(2)));
typedef short bf16x8 __attribute__((ext_vector_type(8)));
typedef GAS unsigned gu32;
#define RLX_AGENT __ATOMIC_RELAXED, __HIP_MEMORY_SCOPE_AGENT
#define LDS_WAIT() asm volatile("s_waitcnt lgkmcnt(0)" ::: "memory")
#define VM_WAIT() asm volatile("s_waitcnt vmcnt(0)" ::: "memory")
__device__ __forceinline__ unsigned f2bf(float f) { unsigned u = __builtin_bit_cast(unsigned, f); return (u + 0x7fffu + ((u >> 16) & 1u)) >> 16; }
__device__ __forceinline__ unsigned pk2(float lo, float hi) { return f2bf(lo) | (f2bf(hi) << 16); }
__device__ __forceinline__ float bf2f(unsigned b) { return __builtin_bit_cast(float, b << 16); }
__device__ __forceinline__ float bflo(unsigned w) { return __builtin_bit_cast(float, w << 16); }
__device__ __forceinline__ float bfhi(unsigned w) { return __builtin_bit_cast(float, w & 0xffff0000u); }
__device__ __forceinline__ float sigmoidf_(float x) { return __builtin_amdgcn_rcpf(1.0f + __expf(-x)); }
__device__ __forceinline__ float siluf_(float x) { return x * __builtin_amdgcn_rcpf(1.0f + __expf(-x)); }
__device__ __forceinline__ float geluf_(float x) { const float t = 1.5957691216057308f * (x + 0.044715f * x * x * x); return x * __builtin_amdgcn_rcpf(1.0f + __expf(-t)); }
__device__ __forceinline__ float logsigmoidf_(float z) { return fminf(z, 0.f) - __logf(1.0f + __expf(-fabsf(z))); }

#define XB_TMO      128
#define XB_XCNT(j)  (256  + 64 * (j))
#define XB_XSUB(j)  (1280 + 64 * (j))
#define XB_XGEN(j)  (2304 + 64 * (j))
#define XB_TOP      3328
#define XB_TOPGEN   3392
#define XCD_BAR_WORDS 3456
#define XB_SPIN_CAP (1u << 18)
__device__ __forceinline__ unsigned xb_ld(unsigned* p)              { return __hip_atomic_load(p, __ATOMIC_RELAXED, __HIP_MEMORY_SCOPE_AGENT); }
__device__ __forceinline__ unsigned xb_add(unsigned* p, unsigned v) { return __hip_atomic_fetch_add(p, v, __ATOMIC_RELAXED, __HIP_MEMORY_SCOPE_AGENT); }
__device__ __forceinline__ unsigned xb_xcc_id() { return (unsigned)__builtin_amdgcn_s_getreg((3 << 11) | 20) & 0xFu; }
#define XB_SPIN(cond, bar) do { unsigned _sp = 0; while (cond) { __builtin_amdgcn_s_sleep(1); \
    if ((++_sp & 255u) == 0u) { if (xb_ld(&(bar)[XB_TMO])) break; if (_sp > XB_SPIN_CAP) { atomicAdd(&(bar)[XB_TMO], 1u); break; } } } } while (0)
struct XcdBarrier { unsigned* bar; unsigned x; volatile LAS unsigned* st; };
__device__ __forceinline__ XcdBarrier xcd_barrier_post(unsigned* bar, volatile LAS unsigned* st) {
    XcdBarrier b; b.bar = bar; b.x = xb_xcc_id(); b.st = st;
    if (threadIdx.x == 0) (void)xb_add(&bar[XB_XCNT(b.x)], 1u);
    return b;
}
__device__ __forceinline__ void xcd_barrier_complete(unsigned* bar, unsigned x, unsigned& nloc, unsigned& nx) {
    const unsigned G = gridDim.x * gridDim.y * gridDim.z;
    unsigned sum, cnt, mine, sp = 0u;
    for (;;) {
        sum = 0u; cnt = 0u; mine = 0u;
#pragma unroll
        for (unsigned j = 0; j < 16; ++j) { const unsigned c = xb_ld(&bar[XB_XCNT(j)]); sum += c; cnt += (c > 0u) ? 1u : 0u; mine = (j == x) ? c : mine; }
        if (sum == G) break;
        __builtin_amdgcn_s_sleep(1);
        if ((++sp & 255u) == 0u) { if (xb_ld(&bar[XB_TMO])) break; if (sp > XB_SPIN_CAP) { atomicAdd(&bar[XB_TMO], 1u); break; } }
    }
    nloc = mine > 0u ? mine : 1u; nx = cnt > 0u ? cnt : 1u;
}
__device__ __forceinline__ void xcd_barrier(const XcdBarrier& b) {
    asm volatile("s_waitcnt vmcnt(0)" ::: "memory");
    __syncthreads();
    if (threadIdx.x == 0) {
        unsigned* bar = b.bar;
        __builtin_amdgcn_s_waitcnt(0);
        unsigned nloc = b.st[0], nx = b.st[1];
        if (nloc == 0u) { xcd_barrier_complete(bar, b.x, nloc, nx); b.st[0] = nloc; b.st[1] = nx; }
        const unsigned old = xb_add(&bar[XB_XSUB(b.x)], 1u);
        const unsigned gen = old / nloc;
        if (old + 1u == (gen + 1u) * nloc) {
            __builtin_amdgcn_fence(__ATOMIC_RELEASE, "agent");
            asm volatile("s_waitcnt vmcnt(0)" ::: "memory");
            const unsigned og = xb_add(&bar[XB_TOP], 1u);
            const unsigned tg = og / nx;
            if (og + 1u != (tg + 1u) * nx) XB_SPIN(xb_ld(&bar[XB_TOP]) < (tg + 1u) * nx, bar);
            __builtin_amdgcn_fence(__ATOMIC_ACQUIRE, "");
            asm volatile("s_waitcnt vmcnt(0)" ::: "memory");
            xb_add(&bar[XB_XGEN(b.x)], 1u);
        } else {
            XB_SPIN(xb_ld(&bar[XB_XGEN(b.x)]) == gen, bar);
            __builtin_amdgcn_fence(__ATOMIC_ACQUIRE, "agent");
            asm volatile("s_waitcnt vmcnt(0)" ::: "memory");
        }
    }
    __syncthreads();
}

enum InIdx { I_X = 0, I_C, I_CTX, I_CCTX, I_WMOD, I_BMOD, I_N1W, I_N2W, I_FNW, I_WIN, I_LRF, I_LRB, I_BIASF, I_BIASB, I_GNW,
             I_AREF, I_AIMF, I_LDTF, I_AREB, I_AIMB, I_LDTB, I_BRE, I_BIM, I_CRE, I_CIM, I_S5D, I_WGLU, I_BGLU, I_WGP, I_WSP, I_WOUT,
             I_FG, I_FU, I_FD, I_ROUTER, I_MG, I_MU, I_MD, N_IN };
struct Args { const float* in[N_IN]; float* out; unsigned char* ws; int ph_lo, ph_hi; };

#define SHX(v, m) __builtin_bit_cast(float, __builtin_amdgcn_ds_bpermute((lane ^ (m)) << 2, __builtin_bit_cast(int, (float)(v))))
__device__ __forceinline__ float wave_sum(float v, const int lane) {
#pragma unroll
    for (int o = 1; o < 64; o <<= 1) v += SHX(v, o);
    return v;
}

typedef short tr_v4i16 __attribute__((ext_vector_type(4)));
__device__ __forceinline__ void transpose_item(const float* W, int ldw, int k0, int n0, bf16* WT, int ldt, int drow0, LAS unsigned char* scr, int lane) {
    const int kk = lane >> 4, n4 = (lane & 15) * 4;
    f32x4 v[16];
#pragma unroll
    for (int i = 0; i < 16; ++i) v[i] = *(const f32x4*)(W + (size_t)(k0 + 4 * i + kk) * ldw + n0 + n4);
#pragma unroll
    for (int i = 0; i < 16; ++i) { v2u o; o.x = pk2(v[i][0], v[i][1]); o.y = pk2(v[i][2], v[i][3]); *(LAS v2u*)(scr + (4 * i + kk) * 144 + n4 * 2) = o; }
    LDS_WAIT(); asm volatile("" ::: "memory");
    const int hh = lane >> 5, blk = (lane >> 4) & 1, q = (lane & 15) >> 2, p = lane & 3, li = lane & 15;
#pragma unroll
    for (int it = 0; it < 4; ++it)
#pragma unroll
        for (int ct = 0; ct < 2; ++ct) { const int kc = 2 * it + hh, col0 = 32 * ct;
            const LAS unsigned char* a0 = scr + (8 * kc + q) * 144 + (col0 + 16 * blk + 4 * p) * 2;
            const tr_v4i16 lo = __builtin_amdgcn_ds_read_tr16_b64_v4i16((LAS tr_v4i16*)a0), hi = __builtin_amdgcn_ds_read_tr16_b64_v4i16((LAS tr_v4i16*)(a0 + 4 * 144));
            const bf16x8 o = __builtin_shufflevector(lo, hi, 0, 1, 2, 3, 4, 5, 6, 7);
            *(bf16x8*)(WT + (size_t)(drow0 + col0 + 16 * blk + li) * ldt + k0 + 8 * kc) = o; }
    LDS_WAIT(); asm volatile("" ::: "memory");
}
constexpr float SC_MB = 32.f;
constexpr float SC_XIN = 20.f;
constexpr float SC_WGU = 1024.f, SC_WD = 2048.f, SC_H = 8.f;
__device__ __forceinline__ unsigned pk4_fp8(float a, float b, float c, float d) {
    a = __builtin_amdgcn_fmed3f(a, -448.f, 448.f); b = __builtin_amdgcn_fmed3f(b, -448.f, 448.f); c = __builtin_amdgcn_fmed3f(c, -448.f, 448.f); d = __builtin_amdgcn_fmed3f(d, -448.f, 448.f);
    int r = __builtin_amdgcn_cvt_pk_fp8_f32(a, b, 0, false); r = __builtin_amdgcn_cvt_pk_fp8_f32(c, d, r, true); return (unsigned)r; }
__device__ __forceinline__ unsigned pk4_i8(float a, float b, float c, float d) {
    a = __builtin_amdgcn_fmed3f(__builtin_rintf(a), -127.f, 127.f) + 128.f; b = __builtin_amdgcn_fmed3f(__builtin_rintf(b), -127.f, 127.f) + 128.f;
    c = __builtin_amdgcn_fmed3f(__builtin_rintf(c), -127.f, 127.f) + 128.f; d = __builtin_amdgcn_fmed3f(__builtin_rintf(d), -127.f, 127.f) + 128.f;
    unsigned r = __builtin_amdgcn_cvt_pk_u8_f32(a, 0, 0); r = __builtin_amdgcn_cvt_pk_u8_f32(b, 1, r); r = __builtin_amdgcn_cvt_pk_u8_f32(c, 2, r); r = __builtin_amdgcn_cvt_pk_u8_f32(d, 3, r);
    return r ^ 0x80808080u; }
template <int FMT> __device__ __forceinline__ unsigned pk4_q(float a, float b, float c, float d) { if constexpr (FMT == 2) return pk4_i8(a, b, c, d); else return pk4_fp8(a, b, c, d); }
template <int FMT> __device__ __forceinline__ unsigned pk4_q_bf(tr_v4i16 v, float sc) {
    return pk4_q<FMT>(__builtin_bit_cast(float, (unsigned)(unsigned short)v[0] << 16) * sc, __builtin_bit_cast(float, (unsigned)(unsigned short)v[1] << 16) * sc,
                      __builtin_bit_cast(float, (unsigned)(unsigned short)v[2] << 16) * sc, __builtin_bit_cast(float, (unsigned)(unsigned short)v[3] << 16) * sc); }
__device__ __forceinline__ unsigned pk4_fp8_bf(tr_v4i16 v, float sc) {
    return pk4_fp8(__builtin_bit_cast(float, (unsigned)(unsigned short)v[0] << 16) * sc, __builtin_bit_cast(float, (unsigned)(unsigned short)v[1] << 16) * sc,
                   __builtin_bit_cast(float, (unsigned)(unsigned short)v[2] << 16) * sc, __builtin_bit_cast(float, (unsigned)(unsigned short)v[3] << 16) * sc); }
template <int FMT> __device__ __forceinline__ void transpose_item_q(const float* W, int ldw, int k0, int n0, unsigned char* WT, int ldt, int drow0, float sc, LAS unsigned char* scr, int lane) {
    const int kk = lane >> 4, n4 = (lane & 15) * 4;
    f32x4 v[16];
#pragma unroll
    for (int i = 0; i < 16; ++i) v[i] = *(const f32x4*)(W + (size_t)(k0 + 4 * i + kk) * ldw + n0 + n4);
#pragma unroll
    for (int i = 0; i < 16; ++i) { v2u o; o.x = pk2(v[i][0], v[i][1]); o.y = pk2(v[i][2], v[i][3]); *(LAS v2u*)(scr + (4 * i + kk) * 144 + n4 * 2) = o; }
    LDS_WAIT(); asm volatile("" ::: "memory");
    const int hh = lane >> 5, blk = (lane >> 4) & 1, q = (lane & 15) >> 2, p = lane & 3, li = lane & 15;
#pragma unroll
    for (int it = 0; it < 2; ++it)
#pragma unroll
        for (int ct = 0; ct < 2; ++ct) { const int kc = 4 * it + 2 * hh, col0 = 32 * ct;
            const LAS unsigned char* a0 = scr + (8 * kc + q) * 144 + (col0 + 16 * blk + 4 * p) * 2;
            const tr_v4i16 t0 = __builtin_amdgcn_ds_read_tr16_b64_v4i16((LAS tr_v4i16*)a0), t1 = __builtin_amdgcn_ds_read_tr16_b64_v4i16((LAS tr_v4i16*)(a0 + 4 * 144)),
                           t2 = __builtin_amdgcn_ds_read_tr16_b64_v4i16((LAS tr_v4i16*)(a0 + 8 * 144)), t3 = __builtin_amdgcn_ds_read_tr16_b64_v4i16((LAS tr_v4i16*)(a0 + 12 * 144));
            v4u o; o.x = pk4_q_bf<FMT>(t0, sc); o.y = pk4_q_bf<FMT>(t1, sc); o.z = pk4_q_bf<FMT>(t2, sc); o.w = pk4_q_bf<FMT>(t3, sc);
            *(v4u*)(WT + (size_t)(drow0 + col0 + 16 * blk + li) * ldt + k0 + 8 * kc) = o; }
    LDS_WAIT(); asm volatile("" ::: "memory");
}
__device__ __forceinline__ bool conv_matrix(int& r, const float* W, int K, int N, bf16* WT, int mode, int roff, LAS unsigned char* scr, int lane) {
    const int nblk = mode == 1 ? 64 : N / 64, items = (K / 64) * nblk;
    if (r >= items) { r -= items; return false; }
    const int kb = r / nblk, nb = r % nblk, k0 = 64 * kb;
    int n0, drow0;
    if (mode == 0) { n0 = 64 * nb; drow0 = n0 + roff; }
    else if (mode == 1) { n0 = nb < 12 ? 64 * nb : 800 + 64 * (nb - 12); drow0 = nb < 12 ? n0 : n0 + 480; }
    else { n0 = 64 * nb; drow0 = (n0 >> 7) * 256 + (n0 & 127) + roff; }
    transpose_item(W, N, k0, n0, WT, K, drow0, scr, lane);
    return true;
}
template <int FMT> __device__ __forceinline__ bool conv_matrix_q(int& r, const float* W, int K, int N, unsigned char* WT, int mode, int roff, float sc, LAS unsigned char* scr, int lane) {
    const int nblk = mode == 1 ? 64 : N / 64, items = (K / 64) * nblk;
    if (r >= items) { r -= items; return false; }
    const int kb = r / nblk, nb = r % nblk, k0 = 64 * kb;
    int n0 = 64 * nb, drow0;
    if (mode == 0) drow0 = n0 + roff;
    else if (mode == 1) { n0 = nb < 12 ? 64 * nb : 800 + 64 * (nb - 12); drow0 = nb < 12 ? n0 : n0 + 480; }
    else drow0 = (n0 >> 7) * 256 + (n0 & 127) + roff;
    transpose_item_q<FMT>(W, N, k0, n0, WT, K, drow0, sc, scr, lane);
    return true;
}

using pg8::Unit; using pg8::cvt_pk_bf16;
typedef pg8::f32x4 accv;
#define EPI_ARGS const accv (&acc)[2][2][4][2], const Unit& u, int wr, int wc, int fr, int fq
__device__ __forceinline__ v4u pack8(f32x4 a, f32x4 b) { v4u w; w.x = cvt_pk_bf16(a[0], a[1]); w.y = cvt_pk_bf16(a[2], a[3]); w.z = cvt_pk_bf16(b[0], b[1]); w.w = cvt_pk_bf16(b[2], b[3]); return w; }
__device__ __forceinline__ void unpack8(v4u w, f32x4& a, f32x4& b) { a = (f32x4){bflo(w.x), bfhi(w.x), bflo(w.y), bfhi(w.y)}; b = (f32x4){bflo(w.z), bfhi(w.z), bflo(w.w), bfhi(w.w)}; }

struct EpiInProj {
    bf16 *Kb, *Vb, *Ub, *Qb, *Rb, *GAb, *GMb; float *GF, *GB; const float *bias_f, *bias_b; const float* xsi; LAS float* sb;
    __device__ __forceinline__ void pre(const Unit& u, int wid, int lane) const {
        if (wid < 4) __builtin_amdgcn_global_load_lds((const unsigned*)(xsi + (size_t)u.pm * 256 + wid * 64 + lane), (LAS unsigned*)(sb + u.par * 256 + wid * 64), 4, 0, 0);
    }
    static __device__ __forceinline__ f32x4 cv(const accv& a, float is) { const float a0 = a[0], a1 = a[1], a2 = a[2], a3 = a[3];
        return (f32x4){(float)__builtin_bit_cast(int, a0) * is, (float)__builtin_bit_cast(int, a1) * is, (float)__builtin_bit_cast(int, a2) * is, (float)__builtin_bit_cast(int, a3) * is}; }
    __device__ __forceinline__ void operator()(EPI_ARGS) const {
        const int pn = u.pn, row0 = u.pm * 256 + wr * 64 + fr, cw = wc * 32 + 8 * fq;
        float is[2][4];
#pragma unroll
        for (int ai = 0; ai < 2; ++ai)
#pragma unroll
            for (int m = 0; m < 4; ++m) is[ai][m] = sb[u.par * 256 + wr * 64 + fr + ai * 128 + m * 16] * (1.f / SC_WGU);
        if (pn == 3 || pn == 4) {
            float* dst = pn == 3 ? GF : GB; const float* bias = pn == 3 ? bias_f : bias_b;
#pragma unroll
            for (int bj = 0; bj < 2; ++bj) { const int c = cw + bj * 128; const f32x4 b0 = *(const f32x4*)(bias + c), b1 = *(const f32x4*)(bias + c + 4);
#pragma unroll
                for (int ai = 0; ai < 2; ++ai)
#pragma unroll
                    for (int m = 0; m < 4; ++m) { float* p = dst + (size_t)(row0 + ai * 128 + m * 16) * 256 + c; f32x4 v0 = cv(acc[ai][bj][m][0], is[ai][m]) + b0, v1 = cv(acc[ai][bj][m][1], is[ai][m]) + b1;
#pragma unroll
                        for (int j = 0; j < 4; ++j) { v0[j] = logsigmoidf_(v0[j]) * 0.0625f; v1[j] = logsigmoidf_(v1[j]) * 0.0625f; }
                        *(f32x4*)p = v0; *(f32x4*)(p + 4) = v1; } }
            return;
        }
        bf16* dst; int ld, cb, act;
        if (pn == 0) { dst = Kb; ld = 256; cb = 0; act = 0; }
        else if (pn <= 2) { dst = Vb; ld = 512; cb = (pn - 1) * 256; act = 0; }
        else if (pn <= 6) { dst = Ub; ld = 512; cb = (pn - 5) * 256; act = 0; }
        else if (pn == 7) { dst = Qb; ld = 256; cb = 0; act = 1; }
        else if (pn <= 9) { dst = Rb; ld = 512; cb = (pn - 8) * 256; act = 2; }
        else if (pn <= 13) { dst = GAb; ld = 1024; cb = (pn - 10) * 256; act = 3; }
        else { dst = GMb; ld = 1024; cb = (pn - 14) * 256; act = 3; }
#pragma unroll
        for (int ai = 0; ai < 2; ++ai)
#pragma unroll
            for (int m = 0; m < 4; ++m) { bf16* rowp = dst + (size_t)(row0 + ai * 128 + m * 16) * ld + cb + cw;
#pragma unroll
                for (int bj = 0; bj < 2; ++bj) { f32x4 v0 = cv(acc[ai][bj][m][0], is[ai][m]), v1 = cv(acc[ai][bj][m][1], is[ai][m]);
                    if (act == 1) { v0 = v0 * 0.125f; v1 = v1 * 0.125f; }
                    else if (act == 2) {
#pragma unroll
                        for (int j = 0; j < 4; ++j) { v0[j] = siluf_(v0[j]); v1[j] = siluf_(v1[j]); } }
                    else if (act == 3) {
#pragma unroll
                        for (int j = 0; j < 4; ++j) { v0[j] = sigmoidf_(v0[j]); v1[j] = sigmoidf_(v1[j]); } }
                    *(v4u*)(rowp + bj * 128) = pack8(v0, v1); } }
    }
};
struct EpiD12 {
    const bf16* SG; bf16* S2; const float* bglu; const bf16* GA; bf16* T;
    __device__ __forceinline__ void operator()(EPI_ARGS) const {
        const int row0 = u.pm * 256 + wr * 64 + fr, c0 = u.pn * 256 + wc * 32 + 8 * fq;
        if (u.kind == 0) {
            f32x4 b0[2], b1[2];
#pragma unroll
            for (int bj = 0; bj < 2; ++bj) { b0[bj] = *(const f32x4*)(bglu + c0 + bj * 128); b1[bj] = *(const f32x4*)(bglu + c0 + bj * 128 + 4); }
#pragma unroll
            for (int ai = 0; ai < 2; ++ai)
#pragma unroll
                for (int m = 0; m < 4; ++m) { const size_t row = (size_t)(row0 + ai * 128 + m * 16);
#pragma unroll
                    for (int bj = 0; bj < 2; ++bj) { const int c = c0 + bj * 128; f32x4 v0 = acc[ai][bj][m][0], v1 = acc[ai][bj][m][1], s0, s1;
                        unpack8(*(const v4u*)(SG + row * 512 + c), s0, s1);
#pragma unroll
                        for (int j = 0; j < 4; ++j) { v0[j] = s0[j] * sigmoidf_(v0[j] + b0[bj][j]); v1[j] = s1[j] * sigmoidf_(v1[j] + b1[bj][j]); }
                        *(v4u*)(S2 + row * 512 + c) = pack8(v0, v1); } }
        } else {
#pragma unroll
            for (int ai = 0; ai < 2; ++ai)
#pragma unroll
                for (int m = 0; m < 4; ++m) { const size_t row = (size_t)(row0 + ai * 128 + m * 16);
#pragma unroll
                    for (int bj = 0; bj < 2; ++bj) { const int c = c0 + bj * 128; f32x4 s0, s1;
                        unpack8(*(const v4u*)(GA + row * 1024 + c), s0, s1); *(v4u*)(T + row * 1024 + c) = pack8(acc[ai][bj][m][0] * s0, acc[ai][bj][m][1] * s1); } }
        }
    }
};
struct EpiD3 {
    const bf16* T; const bf16* GM; bf16* MB;
    __device__ __forceinline__ void operator()(EPI_ARGS) const {
        const int row0 = u.pm * 256 + wr * 64 + fr, c0 = u.pn * 256 + wc * 32 + 8 * fq;
#pragma unroll
        for (int ai = 0; ai < 2; ++ai)
#pragma unroll
            for (int m = 0; m < 4; ++m) { const size_t row = (size_t)(row0 + ai * 128 + m * 16);
#pragma unroll
                for (int bj = 0; bj < 2; ++bj) { const int c = c0 + bj * 128; f32x4 t0, t1, g0, g1; unpack8(*(const v4u*)(T + row * 1024 + c), t0, t1); unpack8(*(const v4u*)(GM + row * 1024 + c), g0, g1);
                    const f32x4 m0 = (t0 + g0 * acc[ai][bj][m][0]) * SC_MB, m1 = (t1 + g1 * acc[ai][bj][m][1]) * SC_MB;
                    v2u o; o.x = pk4_i8(m0[0], m0[1], m0[2], m0[3]); o.y = pk4_i8(m1[0], m1[1], m1[2], m1[3]);
                    *(v2u*)((unsigned char*)MB + row * 1024 + c) = o; } }
    }
};
template <bool I32>
struct EpiResidT {
    const float* rl; const float* rc; float* out; const float* modv; int gidx; float* part; float osc;
    static __device__ __forceinline__ f32x4 cv(const accv& a, float sc) { if constexpr (I32) { const float a0 = a[0], a1 = a[1], a2 = a[2], a3 = a[3];
            return (f32x4){(float)__builtin_bit_cast(int, a0) * sc, (float)__builtin_bit_cast(int, a1) * sc, (float)__builtin_bit_cast(int, a2) * sc, (float)__builtin_bit_cast(int, a3) * sc}; } else return a; }
    __device__ __forceinline__ void operator()(EPI_ARGS) const {
        const int row0 = u.pm * 256 + wr * 64 + fr, c0 = u.pn * 256 + wc * 32 + 8 * fq;
        if (u.kind == 1) {
            float* pp = part + (size_t)u.slice * NCTX * 1024;
#pragma unroll
            for (int ai = 0; ai < 2; ++ai)
#pragma unroll
                for (int m = 0; m < 4; ++m)
#pragma unroll
                    for (int bj = 0; bj < 2; ++bj) { float* op = pp + (size_t)(row0 - NLAT + ai * 128 + m * 16) * 1024 + c0 + bj * 128; *(f32x4*)op = cv(acc[ai][bj][m][0], osc); *(f32x4*)(op + 4) = cv(acc[ai][bj][m][1], osc); }
            return;
        }
        const int bi = u.pm < NLAT / 256 ? (u.pm >> 4) : 4;
        const float* gp = modv + bi * 6144 + gidx * 1024;
#pragma unroll
        for (int bj = 0; bj < 2; ++bj) { const int c = c0 + bj * 128; const f32x4 g0 = *(const f32x4*)(gp + c), g1 = *(const f32x4*)(gp + c + 4);
#pragma unroll
            for (int ai = 0; ai < 2; ++ai)
#pragma unroll
                for (int m = 0; m < 4; ++m) { const int row = row0 + ai * 128 + m * 16;
                    const float* rp = (row < NLAT ? rl + (size_t)row * 1024 : rc + (size_t)(row - NLAT) * 1024) + c; float* op = out + (size_t)row * 1024 + c;
                    const f32x4 r0 = *(const f32x4*)rp, r1 = *(const f32x4*)(rp + 4);
                    *(f32x4*)op = r0 + g0 * cv(acc[ai][bj][m][0], osc); *(f32x4*)(op + 4) = r1 + g1 * cv(acc[ai][bj][m][1], osc); } }
    }
};
typedef EpiResidT<false> EpiResid;
struct EpiSwiglu {
    bf16* H; int ld; int pmoff;
    __device__ __forceinline__ void operator()(EPI_ARGS) const {
        const int row0 = (u.pm - pmoff) * 256 + wr * 64 + fr, c = u.pn * 128 + wc * 32 + 8 * fq;
#pragma unroll
        for (int ai = 0; ai < 2; ++ai)
#pragma unroll
            for (int m = 0; m < 4; ++m) { f32x4 g0 = acc[ai][0][m][0], g1 = acc[ai][0][m][1]; const f32x4 u0 = acc[ai][1][m][0], u1 = acc[ai][1][m][1];
#pragma unroll
                for (int j = 0; j < 4; ++j) { g0[j] = siluf_(g0[j]) * u0[j]; g1[j] = siluf_(g1[j]) * u1[j]; }
                *(v4u*)(H + (size_t)(row0 + ai * 128 + m * 16) * ld + c) = pack8(g0, g1); }
    }
};
template <bool I32, bool OUT8>
struct EpiSwigluS {
    unsigned char* H; int ld; int pmoff; const float* xsi; float wsi, hs; LAS float* sb;
    static __device__ __forceinline__ float cv(float x) { if constexpr (I32) return (float)__builtin_bit_cast(int, x); else return x; }
    __device__ __forceinline__ void pre(const Unit& u, int wid, int lane) const {
        if (wid < 4) __builtin_amdgcn_global_load_lds((const unsigned*)(xsi + (size_t)u.pm * 256 + wid * 64 + lane), (LAS unsigned*)(sb + u.par * 256 + wid * 64), 4, 0, 0);
    }
    __device__ __forceinline__ void operator()(EPI_ARGS) const {
        const int row0 = (u.pm - pmoff) * 256 + wr * 64 + fr, c = u.pn * 128 + wc * 32 + 8 * fq;
        const LAS float* xp = sb + u.par * 256 + wr * 64 + fr;
#pragma unroll
        for (int ai = 0; ai < 2; ++ai)
#pragma unroll
            for (int m = 0; m < 4; ++m) { const float is = xp[ai * 128 + m * 16] * wsi, is2 = is * hs;
                f32x4 g0 = acc[ai][0][m][0], g1 = acc[ai][0][m][1]; const f32x4 u0 = acc[ai][1][m][0], u1 = acc[ai][1][m][1];
#pragma unroll
                for (int j = 0; j < 4; ++j) { g0[j] = siluf_(cv(g0[j]) * is) * (cv(u0[j]) * is2); g1[j] = siluf_(cv(g1[j]) * is) * (cv(u1[j]) * is2); }
                if constexpr (OUT8) { v2u o; o.x = pk4_fp8(g0[0], g0[1], g0[2], g0[3]); o.y = pk4_fp8(g1[0], g1[1], g1[2], g1[3]); *(v2u*)(H + (size_t)(row0 + ai * 128 + m * 16) * ld + c) = o; }
                else *(v4u*)((bf16*)H + (size_t)(row0 + ai * 128 + m * 16) * ld + c) = pack8(g0, g1); }
    }
};
struct EpiPlain {
    bf16* Y; bf16* YT; float osc;
    __device__ __forceinline__ void operator()(EPI_ARGS) const {
        const int row0 = u.pm * 256 + wr * 64 + fr, c0 = u.pn * 256 + wc * 32 + 8 * fq;
        if (u.kind == 1) {
            bf16* yp = YT + (size_t)u.slice * 2048 * 1024;
#pragma unroll
            for (int ai = 0; ai < 2; ++ai)
#pragma unroll
                for (int m = 0; m < 4; ++m)
#pragma unroll
                    for (int bj = 0; bj < 2; ++bj) *(v4u*)(yp + (size_t)(row0 - 32768 + ai * 128 + m * 16) * 1024 + c0 + bj * 128) = pack8(acc[ai][bj][m][0] * osc, acc[ai][bj][m][1] * osc);
            return;
        }
#pragma unroll
        for (int ai = 0; ai < 2; ++ai)
#pragma unroll
            for (int m = 0; m < 4; ++m)
#pragma unroll
                for (int bj = 0; bj < 2; ++bj) *(v4u*)(Y + (size_t)(row0 + ai * 128 + m * 16) * 1024 + c0 + bj * 128) = pack8(acc[ai][bj][m][0] * osc, acc[ai][bj][m][1] * osc);
    }
};

#define PHASE_BEGIN() int tid_; asm volatile("v_mbcnt_lo_u32_b32 %0, -1, 0\n\tv_mbcnt_hi_u32_b32 %0, -1, %0" : "=v"(tid_)); tid_ += wave_s_ * 64; GAS unsigned char* wsg_ = (GAS unsigned char*)args.ws; asm volatile("" : "+s"(wsg_)); unsigned char* ws = (unsigned char*)wsg_; \
    const int tid = tid_, lane = tid & 63, wave = __builtin_amdgcn_readfirstlane(tid >> 6), gw = vcu * NWAVES + wave; (void)lane; (void)gw; \
    const float* const* in = args.in; (void)in; gu32* ctl = (gu32*)(ws + WS_CTL); (void)ctl; int bxp = bx; asm volatile("" : "+s"(bxp)); (void)bxp;
#define LATX ((float*)(ws + WS_LATX))
#define XN ((bf16*)(ws + WS_XN))
#define Kb ((bf16*)(ws + WS_IP + IP_K))
#define Vb ((bf16*)(ws + WS_IP + IP_V))
#define GF ((float*)(ws + WS_IP + IP_GF))
#define GB ((float*)(ws + WS_IP + IP_GB))
#define Ub ((bf16*)(ws + WS_IP + IP_U))
#define Qb ((bf16*)(ws + WS_IP + IP_Q))
#define Rb ((bf16*)(ws + WS_IP + IP_R))
#define GAb ((bf16*)(ws + WS_IP + IP_GA))
#define GMb ((bf16*)(ws + WS_IP + IP_GM))
#define Tb ((bf16*)(ws + WS_IP + IP_T))
#define S2 ((bf16*)(ws + WS_IP + IP_S2))
#define HMID ((bf16*)(ws + WS_IP + IP_HMID))
#define OG ((bf16*)(ws + WS_OG))
#define SG ((bf16*)(ws + WS_SG))
#define O32 ((float*)(ws + WS_O32))
#define Y32 ((float*)(ws + WS_Y32))
#define MODV ((float*)(ws + WS_TAB + T_MODV))
#define LAMB ((f32x2*)(ws + WS_TAB + T_LAMB))
#define BBAR ((f32x2*)(ws + WS_TAB + T_BBAR))
#define BMT ((bf16*)(ws + WS_TAB + T_BMT))
#define CMT ((bf16*)(ws + WS_TAB + T_CMT))
#define PT32 ((bf16*)(ws + WS_TAB + T_PT))
#define S5F ((f32x2*)(ws + WS_S5F))
#define S5H ((f32x2*)(ws + WS_S5H))
#define DSB ((bf16*)(ws + WS_DS))
#define SSTB ((bf16*)(ws + WS_SST))
#define QDB ((bf16*)(ws + WS_BC))
#define KDB ((bf16*)(ws + WS_BC + (size_t)2 * NROW * 256 * 2))
#define DECB ((float*)(ws + WS_TAB + T_DEC))
#define TOKE ((int4*)(ws + WS_TAB + T_TOKE))
#define TOKW ((f32x2*)(ws + WS_TAB + T_TOKW))
#define TOKS ((int2*)(ws + WS_TAB + T_TOKS))
#define wb (ws + WS_W)
#define WMGU ((unsigned char*)(ws + WS_WM + WM_GU))
#define WMD ((unsigned char*)(ws + WS_WM + WM_D))
#define XG ((unsigned char*)(ws + WS_XG))
#define HM ((unsigned char*)(ws + WS_HM))
#define XSI ((float*)(ws + WS_TAB + T_XSI))
#define XNS ((float*)(ws + WS_TAB + T_XNS))
#define XN2 ((unsigned char*)(ws + 216 * MiB))
#define XNS1 ((float*)(ws + WS_TAB + T_XNS + 128 * 1024 + (size_t)l * 128 * 1024))
#define YS ((bf16*)(ws + WS_YS))
#define YTP ((bf16*)(ws + WS_YT))
#define FPART ((float*)(ws + WS_DS))


typedef __bf16 bf16x2_t __attribute__((ext_vector_type(2)));
__device__ __forceinline__ unsigned cvtpk(float lo, float hi) { const f32x2 v = {lo, hi}; const bf16x2_t b = __builtin_convertvector(v, bf16x2_t); return __builtin_bit_cast(unsigned, b); }
typedef float f32x16 __attribute__((ext_vector_type(16)));
#define MFMA32(a, b, c) __builtin_amdgcn_mfma_f32_32x32x16_bf16((a), (b), (c), 0, 0, 0)
#define MFMA_FENCE() do { __builtin_amdgcn_sched_barrier(0); asm volatile("s_nop 15\n\ts_nop 15" ::: "memory"); __builtin_amdgcn_sched_barrier(0); } while (0)
#define MFMA16(a, b, c) __builtin_amdgcn_mfma_f32_16x16x32_bf16((a), (b), (c), 0, 0, 0)
__device__ __forceinline__ void cmul(float& ar, float& ai, float br, float bi) { const float r = ar * br - ai * bi, i = ar * bi + ai * br; ar = r; ai = i; }
template <int DIR> __device__ __forceinline__ void s5_scan(f32x16 (&tre)[2], f32x16 (&tim)[2], const float lr, const float li, float& sr, float& si) {
#pragma unroll
    for (int q = 0; q < 32; ++q) { const int idx = DIR ? 31 - q : q, mt = idx >> 4, i = idx & 15;
        const float nr = lr * sr - li * si + tre[mt][i], ni = lr * si + li * sr + tim[mt][i]; sr = nr; si = ni; tre[mt][i] = sr; tim[mt][i] = si; }
}
template <int DIR> __device__ __forceinline__ void s5_fix(f32x16 (&tre)[2], f32x16 (&tim)[2], const float lr, const float li, const float xr, const float xi) {
    float fr = lr, fi = li;
#pragma unroll
    for (int q = 0; q < 32; ++q) { const int idx = DIR ? 31 - q : q, mt = idx >> 4, i = idx & 15;
        tre[mt][i] += fr * xr - fi * xi; tim[mt][i] += fr * xi + fi * xr; cmul(fr, fi, lr, li); }
}
__device__ __forceinline__ void ts_rows(int b, int ts, int& rb, int& rs) { if (ts < 4) { rb = NLAT + b * CTXL + 64 * ts; rs = 1; } else { rb = b * SEQ + (ts - 4); rs = 64; } }
__device__ __forceinline__ int chain_pos(int dir, int ts) { return dir == 0 ? ts : (ts < 4 ? 3 - ts : 71 - ts); }

template <int MODE> __device__ __forceinline__ void s5_unit(unsigned char* ws, const float* const* in, LAS unsigned char* hbuf_raw, const int l, const int b, const int ts, const int g, const int lane) {
    const int r = lane & 31, hh = lane >> 5;
    int rb, rs; ts_rows(b, ts, rb, rs);
    bf16x8 ua[2];
#pragma unroll
    for (int mt = 0; mt < 2; ++mt) { const int tokA = 32 * ((r >> 2) & 1) + 16 * mt + (r & 3) + 4 * (r >> 3);
        ua[mt] = *(const bf16x8*)(Ub + (size_t)(rb + tokA * rs) * 512 + 16 * g + 8 * hh); }
    f32x4 yacc[4];
#pragma unroll
    for (int i = 0; i < 4; ++i) yacc[i] = (f32x4){0.f, 0.f, 0.f, 0.f};
    unsigned ue[4][2];
    LAS unsigned* hbuf = (LAS unsigned*)hbuf_raw;
    bf16x8 bre4[4], bim4[4]; f32x2 lam4[4], h04[4];
#pragma unroll
    for (int it = 0; it < 4; ++it) { const int dir = it >> 1, ph = it & 1, p = 32 * ph + r;
        const bf16* bm = BMT + ((size_t)((((l * 2 + dir) * 32 + g) * 2 + ph) * 2)) * 512 + r * 16 + 8 * hh;
        bre4[it] = *(const bf16x8*)bm; bim4[it] = *(const bf16x8*)(bm + 512); lam4[it] = LAMB[((l * 2 + dir) * 32 + g) * 64 + p];
        if (MODE == 1) h04[it] = S5H[((size_t)((dir * 4 + b) * 32 + g) * 68 + chain_pos(dir, ts)) * 64 + p];
        else h04[it] = (f32x2){0.f, 0.f}; }
#pragma unroll
    for (int dir = 0; dir < 2; ++dir) {
        const int cpos = chain_pos(dir, ts);
#pragma unroll
        for (int ph = 0; ph < 2; ++ph) {
            const bf16x8 bre = bre4[dir * 2 + ph], bim = bim4[dir * 2 + ph];
            f32x16 tre[2], tim[2];
            __builtin_amdgcn_sched_barrier(0);
#pragma unroll
            for (int mt = 0; mt < 2; ++mt) { f32x16 z;
#pragma unroll
                for (int i = 0; i < 16; ++i) z[i] = 0.f;
                tre[mt] = MFMA32(ua[mt], bre, z); tim[mt] = MFMA32(ua[mt], bim, z); }
            MFMA_FENCE(); MFMA_FENCE();
            const int p = 32 * ph + r;
            const f32x2 lam = lam4[dir * 2 + ph];
            const size_t fidx = ((size_t)((dir * 4 + b) * 32 + g) * 68 + cpos) * 64 + p;
            const bool first = (hh == dir);
            bf16x8 cb2[2], pa2[2][2];
            if (MODE == 1 && dir == 1 && ph == 1) {
#pragma unroll
                for (int m4 = 0; m4 < 4; ++m4)
#pragma unroll
                    for (int i = 0; i < 4; i += 2) ue[m4][i >> 1] = (unsigned)Ub[(size_t)(rb + (16 * m4 + 4 * (lane >> 4) + i) * rs) * 512 + 16 * g + (lane & 15)]
                                                                  | ((unsigned)Ub[(size_t)(rb + (16 * m4 + 4 * (lane >> 4) + i + 1) * rs) * 512 + 16 * g + (lane & 15)] << 16);
            }
            if (MODE == 1) {
                const bf16* ptb = PT32 + ((size_t)((((l * 2 + dir) * 32 + g) * 2 + ph) * 32) + (lane & 15)) * 64 + 8 * (lane >> 4);
#pragma unroll
                for (int ks = 0; ks < 2; ++ks) { cb2[ks] = *(const bf16x8*)(CMT + ((size_t)((l * 32 + g) * 16 + (lane & 15)) * 2 + ph) * 64 + 32 * ks + 8 * (lane >> 4));
                    pa2[ks][0] = *(const bf16x8*)(ptb + 32 * ks); pa2[ks][1] = *(const bf16x8*)(ptb + (size_t)16 * 64 + 32 * ks); }
            }
            float sr = 0.f, si = 0.f;
            if (MODE == 1) { const f32x2 h0 = h04[dir * 2 + ph]; if (first) { sr = h0[0]; si = h0[1]; } }
            if (dir == 0) s5_scan<0>(tre, tim, lam[0], lam[1], sr, si); else s5_scan<1>(tre, tim, lam[0], lam[1], sr, si);
            const float orr = SHX(sr, 32), oi = SHX(si, 32);
            if (MODE == 0) {
                float l32r = lam[0], l32i = lam[1];
#pragma unroll
                for (int q = 0; q < 5; ++q) cmul(l32r, l32i, l32r, l32i);
                const float fr_ = first ? sr : orr, fi_ = first ? si : oi, sr_ = first ? orr : sr, si_ = first ? oi : si;
                const f32x2 fv = (f32x2){l32r * fr_ - l32i * fi_ + sr_, l32r * fi_ + l32i * fr_ + si_};
                asm volatile("s_waitcnt lgkmcnt(0)" ::: "memory");
                if (hh == 0) S5F[fidx] = fv;
            } else {
#pragma unroll
                for (int mt = 0; mt < 2; ++mt)
#pragma unroll
                    for (int i = 0; i < 16; ++i) hbuf[(32 * hh + 16 * mt + i) * 36 + r] = cvt_pk_bf16(tre[mt][i], tim[mt][i]);
                (void)orr; (void)oi;
                float xq[2][4][2];
#pragma unroll
                for (int ks = 0; ks < 2; ++ks)
#pragma unroll
                    for (int q = 0; q < 4; ++q) { const int src = (16 * ks + 4 * (lane >> 4) + q + 32 * dir) << 2;
                        xq[ks][q][0] = __builtin_bit_cast(float, __builtin_amdgcn_ds_bpermute(src, __builtin_bit_cast(int, sr))); xq[ks][q][1] = __builtin_bit_cast(float, __builtin_amdgcn_ds_bpermute(src, __builtin_bit_cast(int, si))); }
                LDS_WAIT();
#pragma unroll
                for (int ks = 0; ks < 2; ++ks) {
                    const bf16x8 cb = cb2[ks];
#pragma unroll
                    for (int m4 = 0; m4 < 4; ++m4) { const bf16x8 ha = *(const LAS bf16x8*)(hbuf + (16 * m4 + (lane & 15)) * 36 + 16 * ks + 4 * (lane >> 4)); yacc[m4] = MFMA16(ha, cb, yacc[m4]); }
                    v4u zp;
                    { const v4u cw = __builtin_bit_cast(v4u, cb); const unsigned cwa[4] = {cw.x, cw.y, cw.z, cw.w}; unsigned zz[4];
#pragma unroll
                      for (int q = 0; q < 4; ++q) { const float c0 = bflo(cwa[q]), c1 = bfhi(cwa[q]); zz[q] = cvtpk(c0 * xq[ks][q][0] + c1 * xq[ks][q][1], c1 * xq[ks][q][0] - c0 * xq[ks][q][1]); }
                      zp.x = zz[0]; zp.y = zz[1]; zp.z = zz[2]; zp.w = zz[3]; }
                    const bf16x8 zb = __builtin_bit_cast(bf16x8, zp);
#pragma unroll
                    for (int m = 0; m < 2; ++m) { const bf16x8 pa = pa2[ks][m];
                        if (dir == 0) yacc[2 + m] = MFMA16(pa, zb, yacc[2 + m]); else yacc[m] = MFMA16(pa, zb, yacc[m]); }
                    MFMA_FENCE();
                }
                LDS_WAIT();
            }
        }
    }
    if (MODE == 1) {
        const int hc = lane & 15; const float dsk = in[I_S5D][l * 512 + 16 * g + hc];
#pragma unroll
        for (int m4 = 0; m4 < 4; ++m4)
#pragma unroll
            for (int i = 0; i < 4; ++i) { const int tok = 16 * m4 + 4 * (lane >> 4) + i; const size_t o = (size_t)(rb + tok * rs) * 512 + 16 * g + hc;
                SG[o] = (bf16)f2bf(geluf_(yacc[m4][i] + dsk * ((i & 1) ? bfhi(ue[m4][i >> 1]) : bflo(ue[m4][i >> 1])))); }
    }
}


__device__ __forceinline__ int gla_rowbase(int b, int ts) { return ts < 4 ? NLAT + b * CTXL + 64 * ts : b * SEQ + 64 * (ts - 4); }
constexpr int VROW = 1040, VIMG_BYTES = 64 * VROW;
typedef short v4i16_t __attribute__((ext_vector_type(4)));
__device__ __forceinline__ void gla_v_image(unsigned char* ws, LAS unsigned char* img, int rb, int tid) {
#pragma unroll
    for (int i = 0; i < 8; ++i) { const int ci = tid + 512 * i, row = ci >> 6, ch = ci & 63; *(LAS v4u*)(img + row * VROW + ch * 16) = *(const v4u*)(Vb + (size_t)(rb + row) * 512 + ch * 8); }
}
__device__ __forceinline__ v4i16_t gla_vtr(LAS unsigned char* img, int row0, int col0, int lane) {
    const int blk = (lane >> 4) & 1, q = (lane & 15) >> 2, p = lane & 3;
    return __builtin_amdgcn_ds_read_tr16_b64_v4i16((LAS v4i16_t*)(img + (row0 + q) * VROW + (col0 + 16 * blk + 4 * p) * 2));
}
__device__ __forceinline__ bf16x8 cat8(v4i16_t lo, v4i16_t hi) { return __builtin_shufflevector(lo, hi, 0, 1, 2, 3, 4, 5, 6, 7); }
__device__ __forceinline__ void gla_c1_unit(unsigned char* ws, LAS unsigned char* lds, const int b, const int ts, const int tid) {
    const int lane = tid & 63, w = __builtin_amdgcn_readfirstlane(tid >> 6), dir = w >> 2, h = w & 3;
    const int rb = gla_rowbase(b, ts), chain = (dir * 4 + b) * 4 + h, cpos = chain_pos(dir, ts);
    gla_v_image(ws, lds + 65536, rb, tid);
    {
        const int c4 = lane & 15, tq = lane >> 4, d0 = 4 * c4;
        const float* gp = (dir ? GB : GF) + (size_t)(rb + 16 * tq) * 256 + h * 64 + d0;
        const bf16* kp = Kb + (size_t)(rb + 16 * tq) * 256 + h * 64 + d0;
        const bf16* qp = Qb + (size_t)(rb + 16 * tq) * 256 + h * 64 + d0;
        f32x4 P[16]; v2u kv[16], qv[16];
#pragma unroll
        for (int j = 0; j < 16; ++j) { P[j] = *(const f32x4*)(gp + j * 256); kv[j] = *(const v2u*)(kp + j * 256); qv[j] = *(const v2u*)(qp + j * 256); }
        f32x4 gsave[16];
#pragma unroll
        for (int j = 0; j < 16; ++j) gsave[j] = P[j];
#pragma unroll
        for (int j = 1; j < 16; ++j) P[j] = P[j] + P[j - 1];
        const f32x4 S = P[15];
        f32x4 Qa, Qb_, Qc;
#pragma unroll
        for (int e = 0; e < 4; ++e) { Qa[e] = SHX(S[e], 16); Qb_[e] = SHX(S[e], 32); Qc[e] = SHX(S[e], 48); }
        const f32x4 total = (S + Qa) + (Qb_ + Qc);
        f32x4 off = (f32x4){0.f, 0.f, 0.f, 0.f};
        if ((tq ^ 1) < tq) off = off + Qa;
        if ((tq ^ 2) < tq) off = off + Qb_;
        if ((tq ^ 3) < tq) off = off + Qc;
        f32x4 dec;
#pragma unroll
        for (int e = 0; e < 4; ++e) dec[e] = __expf(total[e]);
        bf16* qdp = QDB + ((size_t)dir * NROW + rb + 16 * tq) * 256 + h * 64 + d0;
        bf16* kdp = KDB + ((size_t)dir * NROW + rb + 16 * tq) * 256 + h * 64 + d0;
        unsigned klp[4][8];
#pragma unroll
        for (int j = 0; j < 16; ++j) {
            const f32x4 pf = P[j] + off;
            f32x4 bc; if (dir == 0) bc = pf; else bc = total - pf + gsave[j];
            const f32x4 kk = (f32x4){bflo(kv[j].x), bfhi(kv[j].x), bflo(kv[j].y), bfhi(kv[j].y)}, qq = (f32x4){bflo(qv[j].x), bfhi(qv[j].x), bflo(qv[j].y), bfhi(qv[j].y)};
            f32x4 kd, qd, kl;
#pragma unroll
            for (int e = 0; e < 4; ++e) { const float ex = __expf(bc[e]); qd[e] = qq[e] * ex; kd[e] = kk[e] * __builtin_amdgcn_rcpf(ex); kl[e] = kd[e] * dec[e]; }
            v2u qo, ko; qo.x = cvtpk(qd[0], qd[1]); qo.y = cvtpk(qd[2], qd[3]); ko.x = cvtpk(kd[0], kd[1]); ko.y = cvtpk(kd[2], kd[3]);
            *(v2u*)(qdp + j * 256) = qo; *(v2u*)(kdp + j * 256) = ko;
            if (j & 1) {
#pragma unroll
                for (int e = 0; e < 4; ++e) klp[e][j >> 1] = cvtpk(__uint_as_float(klp[e][j >> 1]), kl[e]);
            } else {
#pragma unroll
                for (int e = 0; e < 4; ++e) klp[e][j >> 1] = __float_as_uint(kl[e]);
            }
        }
#pragma unroll
        for (int e = 0; e < 4; ++e) { const int d = d0 + e, sw = (d >> 1) & 7;
            v4u v0, v1; v0.x = klp[e][0]; v0.y = klp[e][1]; v0.z = klp[e][2]; v0.w = klp[e][3]; v1.x = klp[e][4]; v1.y = klp[e][5]; v1.z = klp[e][6]; v1.w = klp[e][7];
            *(LAS v4u*)(lds + w * 8192 + d * 128 + (((2 * tq) ^ sw) * 16)) = v0; *(LAS v4u*)(lds + w * 8192 + d * 128 + (((2 * tq + 1) ^ sw) * 16)) = v1; }
        if (tq == 0) *(f32x4*)(DECB + (size_t)(chain * 68 + cpos) * 64 + d0) = dec;
    }
    __syncthreads();
    {
        const int r = lane & 31, hh = lane >> 5;
        bf16x8 afr[2][4];
#pragma unroll
        for (int dt = 0; dt < 2; ++dt)
#pragma unroll
            for (int ks = 0; ks < 4; ++ks) { const int d = 32 * dt + r; afr[dt][ks] = *(const LAS bf16x8*)(lds + w * 8192 + d * 128 + (((2 * ks + hh) ^ ((d >> 1) & 7)) * 16)); }
        bf16* dsp = DSB + (size_t)(chain * 68 + cpos) * 8192 + (size_t)r * 64 + 4 * hh;
#pragma unroll 1
        for (int et = 0; et < 4; ++et) {
            f32x16 acc[2];
#pragma unroll
            for (int i = 0; i < 16; ++i) { acc[0][i] = 0.f; acc[1][i] = 0.f; }
#pragma unroll
            for (int ks = 0; ks < 4; ++ks) { const bf16x8 bfrag = cat8(gla_vtr(lds + 65536, 16 * ks + 8 * hh, h * 128 + 32 * et, lane), gla_vtr(lds + 65536, 16 * ks + 8 * hh + 4, h * 128 + 32 * et, lane));
                acc[0] = MFMA32(afr[0][ks], bfrag, acc[0]); acc[1] = MFMA32(afr[1][ks], bfrag, acc[1]); MFMA_FENCE(); }
#pragma unroll
            for (int dt = 0; dt < 2; ++dt)
#pragma unroll
                for (int a = 0; a < 4; ++a) { v2u o; o.x = cvtpk(acc[dt][4 * a], acc[dt][4 * a + 1]); o.y = cvtpk(acc[dt][4 * a + 2], acc[dt][4 * a + 3]); *(v2u*)(dsp + (size_t)(32 * et) * 64 + 32 * dt + 8 * a) = o; }
        }
    }
    __syncthreads();
}
__device__ __forceinline__ void gla_c3_unit(unsigned char* ws, const float* const* in, LAS unsigned char* lds, const int l, const int b, const int ts, const int tid) {
    const int lane = tid & 63, w = __builtin_amdgcn_readfirstlane(tid >> 6), h = w >> 1, eh = w & 1, r = lane & 31, hh = lane >> 5;
    const int rb = gla_rowbase(b, ts);
    gla_v_image(ws, lds, rb, tid);
    __syncthreads();
    f32x16 acc[2][2];
#pragma unroll
    for (int a = 0; a < 2; ++a)
#pragma unroll
        for (int c = 0; c < 2; ++c)
#pragma unroll
            for (int i = 0; i < 16; ++i) acc[a][c][i] = 0.f;
#pragma unroll 1
    for (int dir = 0; dir < 2; ++dir) {
        const int chain = (dir * 4 + b) * 4 + h, cpos = chain_pos(dir, ts);
        bf16x8 QD[2][4], KD[2][4];
        {
            const bf16* qb = QDB + ((size_t)dir * NROW + rb + r) * 256 + h * 64 + 8 * hh; const bf16* kb = KDB + ((size_t)dir * NROW + rb + r) * 256 + h * 64 + 8 * hh;
#pragma unroll
            for (int tile = 0; tile < 2; ++tile)
#pragma unroll
                for (int ks = 0; ks < 4; ++ks) { QD[tile][ks] = *(const bf16x8*)(qb + (size_t)(32 * tile) * 256 + 16 * ks); KD[tile][ks] = *(const bf16x8*)(kb + (size_t)(32 * tile) * 256 + 16 * ks); }
        }
#pragma unroll
        for (int st = 0; st < 2; ++st) {
#pragma unroll
            for (int tt = 0; tt < 2; ++tt) {
                const bool dead = dir == 0 ? (st == 1 && tt == 0) : (st == 0 && tt == 1);
                if (!dead) {
                    f32x16 at;
#pragma unroll
                    for (int i = 0; i < 16; ++i) at[i] = 0.f;
#pragma unroll
                    for (int ks = 0; ks < 4; ++ks) at = MFMA32(KD[st][ks], QD[tt][ks], at);
                    MFMA_FENCE();
                    const int tq = 32 * tt + r;
#pragma unroll
                    for (int i = 0; i < 16; ++i) { const int sq = 32 * st + (i & 3) + 8 * (i >> 2) + 4 * hh; const bool keep = dir == 0 ? (sq <= tq) : (sq >= tq); at[i] = keep ? at[i] : 0.f; }
#pragma unroll
                    for (int sp = 0; sp < 2; ++sp) {
                        v4u pp; pp.x = cvtpk(at[8 * sp], at[8 * sp + 1]); pp.y = cvtpk(at[8 * sp + 2], at[8 * sp + 3]); pp.z = cvtpk(at[8 * sp + 4], at[8 * sp + 5]); pp.w = cvtpk(at[8 * sp + 6], at[8 * sp + 7]);
                        const bf16x8 p = __builtin_bit_cast(bf16x8, pp);
#pragma unroll
                        for (int et = 0; et < 2; ++et) { const int col0 = h * 128 + 64 * eh + 32 * et, row0 = 32 * st + 16 * sp + 4 * hh;
                            acc[et][tt] = MFMA32(cat8(gla_vtr(lds, row0, col0, lane), gla_vtr(lds, row0 + 8, col0, lane)), p, acc[et][tt]); }
                        MFMA_FENCE();
                    }
                }
            }
        }
        {
            const bf16* sst = SSTB + ((size_t)(chain * 68 + cpos) * 128 + 64 * eh + r) * 64 + 8 * hh;
            bf16x8 SF[2][4];
#pragma unroll
            for (int et = 0; et < 2; ++et)
#pragma unroll
                for (int ks = 0; ks < 4; ++ks) SF[et][ks] = *(const bf16x8*)(sst + (size_t)(32 * et) * 64 + 16 * ks);
#pragma unroll
            for (int et = 0; et < 2; ++et)
#pragma unroll
                for (int ks = 0; ks < 4; ++ks) { acc[et][0] = MFMA32(SF[et][ks], QD[0][ks], acc[et][0]); acc[et][1] = MFMA32(SF[et][ks], QD[1][ks], acc[et][1]); }
            MFMA_FENCE();
        }
    }
    float ss[2];
#pragma unroll
    for (int tt = 0; tt < 2; ++tt) { float s = 0.f;
#pragma unroll
        for (int et = 0; et < 2; ++et)
#pragma unroll
            for (int i = 0; i < 16; ++i) s += acc[et][tt][i] * acc[et][tt][i];
        s += SHX(s, 32); ss[tt] = s; }
    LAS float* sqb = (LAS float*)(lds + 67584);
    asm volatile("s_waitcnt lgkmcnt(0)" ::: "memory");
    if (hh == 0) { sqb[w * 64 + r] = ss[0]; sqb[w * 64 + 32 + r] = ss[1]; }
    __syncthreads();
    const float* gnw = in[I_GNW] + l * 128;
    f32x4 gn[2][4]; v2u rr[2][2][4];
#pragma unroll
    for (int et = 0; et < 2; ++et)
#pragma unroll
        for (int a = 0; a < 4; ++a) { const int e0 = 64 * eh + 32 * et + 8 * a + 4 * hh; gn[et][a] = *(const f32x4*)(gnw + e0);
#pragma unroll
            for (int tt = 0; tt < 2; ++tt) rr[tt][et][a] = *(const v2u*)(Rb + (size_t)(rb + 32 * tt + r) * 512 + h * 128 + e0); }
#pragma unroll
    for (int tt = 0; tt < 2; ++tt) {
        const float rstd = rsqrtf((ss[tt] + sqb[(w ^ 1) * 64 + 32 * tt + r]) * (1.f / 128.f) + EPS);
        const size_t row = (size_t)(rb + 32 * tt + r);
#pragma unroll
        for (int et = 0; et < 2; ++et)
#pragma unroll
            for (int a = 0; a < 4; ++a) { const int e0 = 64 * eh + 32 * et + 8 * a + 4 * hh; const v2u rv = rr[tt][et][a]; const f32x4 g4 = gn[et][a];
                v2u o; o.x = cvtpk(acc[et][tt][4 * a] * rstd * g4[0] * bflo(rv.x), acc[et][tt][4 * a + 1] * rstd * g4[1] * bfhi(rv.x));
                o.y = cvtpk(acc[et][tt][4 * a + 2] * rstd * g4[2] * bflo(rv.y), acc[et][tt][4 * a + 3] * rstd * g4[3] * bfhi(rv.y));
                *(v2u*)(OG + row * 512 + h * 128 + e0) = o; }
    }
    __syncthreads();
}

constexpr int NPH = 25;

__global__ void __launch_bounds__(NWAVES * 64, 2) fwd_kernel(Args args) {
    extern __shared__ __attribute__((aligned(16))) unsigned char lds_raw[];
    LAS unsigned char* lds = (LAS unsigned char*)lds_raw;
    volatile LAS unsigned* MISC = (volatile LAS unsigned*)(lds + MISC_OFF);
    const int G = gridDim.x; const int bx = blockIdx.x; const int vcu = (G % 8 == 0) ? (bx % 8) * (G / 8) + bx / 8 : bx;
    const int NGW = G * NWAVES;
    const int wave_s_ = __builtin_amdgcn_readfirstlane((int)threadIdx.x >> 6);
    for (int i = threadIdx.x; i < (LDS_BYTES - LDSCTL_OFF) / 4; i += NWAVES * 64) ((LAS unsigned*)(lds + LDSCTL_OFF))[i] = 0u;
    __syncthreads();
    XcdBarrier bar; bar.bar = (unsigned*)(args.ws + WS_CTL) + CW_BAR; bar.x = 0; bar.st = nullptr;
    if (MK_ONE_LAUNCH) bar = xcd_barrier_post((unsigned*)(args.ws + WS_CTL) + CW_BAR, MISC + 8);
    const int lo = args.ph_lo, hi = args.ph_hi;
#define IN(k) (lo <= (k) && (k) < hi)
#ifdef PROBE_LO
#define STAMP(k) do { if (blockIdx.x == 0 && threadIdx.x == 0) ((unsigned long long*)(args.ws + WS_CTL + 131072))[(k)] = __builtin_amdgcn_s_memrealtime(); } while (0)
#else
#define STAMP(k) do {} while (0)
#endif
#define SEAM(k) do { if (lo <= (k) && (k) + 1 < hi) xcd_barrier(bar); STAMP((k) + 1); } while (0)
    STAMP(0);

    if (IN(0)) { PHASE_BEGIN();
        {
            LAS float* sil = (LAS float*)(lds + 73728);
            LAS float* red = (LAS float*)(lds + 73728 + 20480);
            for (int i = tid; i < 5 * 1024; i += 512) { const int bi = i >> 10, k = i & 1023; const float v = bi < 4 ? in[I_C][bi * 1024 + k] : in[I_CCTX][k]; sil[i] = siluf_(v); }
            __syncthreads();
            for (int it = vcu; it < 2 * 96; it += G) {
                const int l = it / 96, n0 = (it % 96) * 64, kk = lane >> 4, q = lane & 15;
                f32x4 a[5];
#pragma unroll
                for (int bi = 0; bi < 5; ++bi) a[bi] = (f32x4){0.f, 0.f, 0.f, 0.f};
                const float* wp = in[I_WMOD] + (size_t)l * 1024 * 6144 + n0 + 4 * q;
#pragma unroll 8
                for (int i2 = 0; i2 < 32; ++i2) { const int k = wave * 128 + i2 * 4 + kk; const f32x4 w = *(const f32x4*)(wp + (size_t)k * 6144);
#pragma unroll
                    for (int bi = 0; bi < 5; ++bi) a[bi] = a[bi] + w * sil[bi * 1024 + k]; }
#pragma unroll
                for (int bi = 0; bi < 5; ++bi)
#pragma unroll
                    for (int j = 0; j < 4; ++j) { float v = a[bi][j]; v += SHX(v, 16); v += SHX(v, 32); a[bi][j] = v; }
                if (lane < 16) {
#pragma unroll
                    for (int bi = 0; bi < 5; ++bi)
#pragma unroll
                        for (int j = 0; j < 4; ++j) red[(wave * 5 + bi) * 64 + 4 * q + j] = a[bi][j]; }
                __syncthreads();
                if (tid < 320) { const int bi = tid >> 6, cc = tid & 63; float s = 0.f;
#pragma unroll
                    for (int w = 0; w < 8; ++w) s += red[(w * 5 + bi) * 64 + cc];
                    MODV[(l * 5 + bi) * 6144 + n0 + cc] = s + in[I_BMOD][l * 6144 + n0 + cc]; }
                __syncthreads();
            }
        }
        for (int i = gw * 64 + lane; i < 2 * 2 * 32 * 64; i += NGW * 64) {
            const int p = i & 63, g = (i >> 6) & 31, dir = (i >> 11) & 1, l = i >> 12;
            const float* are = in[dir ? I_AREB : I_AREF]; const float* aim = in[dir ? I_AIMB : I_AIMF]; const float* ldt = in[dir ? I_LDTB : I_LDTF];
            const double ar = are[(l * 32 + g) * 64 + p], ai = aim[(l * 32 + g) * 64 + p], dt = exp((double)ldt[l * 32 + g]);
            const double mag = exp(ar * dt), lr = mag * cos(ai * dt), li = mag * sin(ai * dt);
            LAMB[i] = (f32x2){(float)lr, (float)li};
            {
                bf16* pt = PT32 + ((size_t)(((l * 2 + dir) * 32 + g) * 2 + (p >> 5)) * 32) * 64 + 2 * (p & 31); float pr = (float)lr, pi = (float)li;
                for (int k = 1; k <= 32; ++k) { const int j = dir ? 32 - k : k - 1; *(unsigned*)(pt + j * 64) = pk2(pr, pi); const float nr = pr * (float)lr - pi * (float)li, ni = pr * (float)li + pi * (float)lr; pr = nr; pi = ni; }
            }
            const double nr = lr - 1.0, ni = li, den = ar * ar + ai * ai, cr = (nr * ar + ni * ai) / den, ci = (ni * ar - nr * ai) / den;
            const float* bre = in[I_BRE] + ((size_t)(l * 32 + g) * 64 + p) * 16; const float* bim = in[I_BIM] + ((size_t)(l * 32 + g) * 64 + p) * 16;
            bf16* bm = BMT + ((size_t)(((l * 2 + dir) * 32 + g) * 2 + (p >> 5)) * 2) * 512 + (p & 31) * 16;
            for (int j = 0; j < 16; ++j) { const double br = bre[j], bi2 = bim[j]; const float vr = (float)(cr * br - ci * bi2), vi = (float)(cr * bi2 + ci * br);
                BBAR[(size_t)i * 16 + j] = (f32x2){vr, vi}; bm[j] = (bf16)f2bf(vr); bm[512 + j] = (bf16)f2bf(vi); }
        }
        for (int i = gw * 64 + lane; i < 2 * 32 * 16 * 2 * 64; i += NGW * 64) {
            const int k = i & 63, ph = (i >> 6) & 1, hh = (i >> 7) & 15, g = (i >> 11) & 31, l = i >> 16, p = 32 * ph + (k >> 1);
            const size_t ci = ((size_t)(l * 32 + g) * 16 + hh) * 64 + p;
            CMT[i] = (bf16)f2bf((k & 1) ? -in[I_CIM][ci] : in[I_CRE][ci]);
        }
        for (int i = gw * 64 + lane; i < 2 * 2 * 256 * 128; i += NGW * 64) {
            const int n = i & 255, kc = (i >> 8) & 127, dir = (i >> 15) & 1, l = i >> 16;
            const float* lr = in[dir ? I_LRB : I_LRF] + (size_t)l * 16 * 256 + n; float lrv[16];
#pragma unroll
            for (int j = 0; j < 16; ++j) lrv[j] = lr[j * 256];
            float o[8];
#pragma unroll
            for (int kk = 0; kk < 8; ++kk) { const float* wr_ = in[I_WIN] + ((size_t)l * 1024 + kc * 8 + kk) * INW_SRC + 768 + 16 * dir; float s = 0.f;
#pragma unroll
                for (int j4 = 0; j4 < 4; ++j4) { const f32x4 w = *(const f32x4*)(wr_ + 4 * j4); s += w[0] * lrv[4 * j4] + w[1] * lrv[4 * j4 + 1] + w[2] * lrv[4 * j4 + 2] + w[3] * lrv[4 * j4 + 3]; }
                o[kk] = s; }
            v2u w; w.x = pk4_i8(o[0] * SC_WGU, o[1] * SC_WGU, o[2] * SC_WGU, o[3] * SC_WGU); w.y = pk4_i8(o[4] * SC_WGU, o[5] * SC_WGU, o[6] * SC_WGU, o[7] * SC_WGU);
            *(v2u*)((unsigned char*)(wb + W_IN) + ((size_t)l * INW + 768 + 256 * dir + n) * 1024 + kc * 8) = w;
        }
        {
            LAS unsigned char* scr = lds + wave * 9216;
            constexpr int IT_IN = 16 * 64, IT_GLU = 8 * 8, IT_P = 8 * 16, IT_OUT = 16 * 16, IT_F = 16 * 44, IT_FD = 44 * 16;
            constexpr int IT_L = IT_IN + IT_GLU + 2 * IT_P + IT_OUT, NIT = 2 * IT_L + 2 * IT_F + IT_FD;
            const int dgw = NGW > 256 ? gw - 128 : gw, dng = NGW > 256 ? NGW - 128 : NGW;
            if (dgw >= 0) for (int it = dgw; it < NIT; it += dng) {
                int r = it;
                if (r < 2 * IT_L) { const int l = r / IT_L; r -= l * IT_L;
                    if (conv_matrix_q<2>(r, in[I_WIN] + (size_t)l * 1024 * INW_SRC, 1024, INW_SRC, (unsigned char*)(wb + W_IN) + (size_t)l * INW * 1024, 1, 0, SC_WGU, scr, lane)) continue;
                    if (conv_matrix(r, in[I_WGLU] + (size_t)l * 512 * 512, 512, 512, (bf16*)(wb + W_GLU) + (size_t)l * 512 * 512, 0, 0, scr, lane)) continue;
                    if (conv_matrix(r, in[I_WGP] + (size_t)l * 512 * 1024, 512, 1024, (bf16*)(wb + W_GP) + (size_t)l * 1024 * 512, 0, 0, scr, lane)) continue;
                    if (conv_matrix(r, in[I_WSP] + (size_t)l * 512 * 1024, 512, 1024, (bf16*)(wb + W_SP) + (size_t)l * 1024 * 512, 0, 0, scr, lane)) continue;
                    conv_matrix_q<2>(r, in[I_WOUT] + (size_t)l * 1024 * 1024, 1024, 1024, (unsigned char*)(wb + W_OUT) + (size_t)l * 1024 * 1024, 0, 0, SC_WGU, scr, lane); continue; }
                r -= 2 * IT_L;
                if (conv_matrix_q<2>(r, in[I_FG], 1024, FFD, (unsigned char*)(wb + W_FGU), 2, 0, SC_WGU, scr, lane)) continue;
                if (conv_matrix_q<2>(r, in[I_FU], 1024, FFD, (unsigned char*)(wb + W_FGU), 2, 128, SC_WGU, scr, lane)) continue;
                conv_matrix(r, in[I_FD], FFD, 1024, (bf16*)(wb + W_FD), 0, 0, scr, lane);
            }
        }
    }
    SEAM(0);

    for (int l = 0; l < 2; ++l) {
        const int pb = 1 + 11 * l;
#define MODVL (MODV + (size_t)l * 5 * 6144)
#define RES_L (l == 0 ? in[I_X] : (const float*)LATX)
#define RES_C (l == 0 ? in[I_CTX] : (const float*)(LATX + (size_t)NLAT * 1024))
        const int nrows = NROW;
        const int mpan = l == 0 ? NPAN : NLAT / 256;
        if (IN(pb + 0)) { PHASE_BEGIN();
            const float* nw = in[I_N1W] + l * 1024;
            for (int row = gw; row < nrows; row += NGW) {
                const float* xr = row < NLAT ? RES_L + (size_t)row * 1024 : RES_C + (size_t)(row - NLAT) * 1024;
                const int bi = row < NLAT ? row >> 12 : 4; const float* sh = MODVL + bi * 6144; const float* sc = sh + 1024;
                f32x4 v[4]; float ss = 0.f;
#pragma unroll
                for (int j = 0; j < 4; ++j) { v[j] = *(const f32x4*)(xr + 4 * lane + 256 * j);
                    if (l == 1 && row >= NLAT) {
                        f32x4 a = (f32x4){0.f, 0.f, 0.f, 0.f};
#pragma unroll
                        for (int k11 = 0; k11 < 11; ++k11) a = a + *(const f32x4*)(FPART + ((size_t)k11 * NCTX + (row - NLAT)) * 1024 + 4 * lane + 256 * j);
                        v[j] = v[j] + *(const f32x4*)(MODV + 4 * 6144 + 5 * 1024 + 4 * lane + 256 * j) * a; }
                    ss += v[j][0] * v[j][0] + v[j][1] * v[j][1] + v[j][2] * v[j][2] + v[j][3] * v[j][3]; }
                const float rstd = rsqrtf(wave_sum(ss, lane) * (1.f / 1024.f) + EPS);
                float am = 1e-20f;
#pragma unroll
                for (int j = 0; j < 4; ++j) { const int c = 4 * lane + 256 * j; const f32x4 w = *(const f32x4*)(nw + c), s1 = *(const f32x4*)(sc + c), s0 = *(const f32x4*)(sh + c);
#pragma unroll
                    for (int e = 0; e < 4; ++e) { v[j][e] = v[j][e] * rstd * w[e] * (1.f + s1[e]) + s0[e]; am = fmaxf(am, fabsf(v[j][e])); } }
#pragma unroll
                for (int o = 1; o < 64; o <<= 1) am = fmaxf(am, SHX(am, o));
                const float sx = 127.f * __builtin_amdgcn_rcpf(am);
#pragma unroll
                for (int j = 0; j < 4; ++j) *(unsigned*)((unsigned char*)XN + (size_t)row * 1024 + 4 * lane + 256 * j) = pk4_i8(v[j][0] * sx, v[j][1] * sx, v[j][2] * sx, v[j][3] * sx);
                LDS_WAIT();
                if (lane == 0) XNS1[row] = am * (1.f / 127.f);
            }
        }
        SEAM(pb + 0);
        if (IN(pb + 1)) { PHASE_BEGIN();
            pg8::Order S; S.init1(G, bxp, XN, (unsigned char*)(wb + W_IN) + (size_t)l * INW * 1024, NPAN, 18, 512);
            EpiInProj E{Kb, Vb, Ub, Qb, Rb, GAb, GMb, GF, GB, in[I_BIASF] + l * 256, in[I_BIASB] + l * 256, XNS1, (LAS float*)(lds + EPI_SB_OFF)};
            pg8::gemm_phase<EpiInProj, pg8::Order, false, true, true, 2>(lds + RING_OFF, tid, 512, S, E);
        }
        SEAM(pb + 1);
        if (IN(pb + 2)) { PHASE_BEGIN();
            for (int u = vcu; u < 4 * 68; u += G) gla_c1_unit(ws, lds, u / 68, u % 68, tid);
            {
                const int extra = 4 * 68 > G ? 4 * 68 - G : 0;
                if (vcu >= extra) for (int wu = (vcu - extra) * NWAVES + wave; wu < 4 * 68 * 32; wu += (G - extra) * NWAVES) {
                    const int g = wu & 31, ts = (wu >> 5) % 68, b = (wu >> 5) / 68;
                    s5_unit<0>(ws, in, lds + wave * 9216, l, b, ts, g, lane);
                }
            }
        }
        SEAM(pb + 2);
        if (IN(pb + 3)) { PHASE_BEGIN();
            for (int i = gw * 64 + lane; i < 32 * 128 * 32; i += NGW * 64) {
                const int dp = i & 31, e = (i >> 5) & 127, chain = i >> 12;
                const bf16* dsp = DSB + (size_t)chain * 68 * 8192 + e * 64 + 2 * dp; bf16* sp = SSTB + (size_t)chain * 68 * 8192 + e * 64 + 2 * dp; const float* dcp = DECB + (size_t)chain * 68 * 64 + 2 * dp;
                float s0 = 0.f, s1 = 0.f;
#pragma unroll 1
                for (int cb = 0; cb < 68; cb += 17) {
                    f32x2 t[17], dc[17];
#pragma unroll
                    for (int j = 0; j < 17; ++j) { const unsigned tw = *(const unsigned*)(dsp + (size_t)(cb + j) * 8192); t[j] = (f32x2){bflo(tw), bfhi(tw)}; dc[j] = *(const f32x2*)(dcp + (cb + j) * 64); }
#pragma unroll
                    for (int j = 0; j < 17; ++j) { *(unsigned*)(sp + (size_t)(cb + j) * 8192) = cvtpk(s0, s1); s0 = dc[j][0] * s0 + t[j][0]; s1 = dc[j][1] * s1 + t[j][1]; }
                }
            }
            if (wave == 0) for (int i = vcu * 64 + lane; i < 2 * 4 * 32 * 64; i += G * 64) {
                const int p = i & 63, g = (i >> 6) & 31, dir = i >> 13;
                const f32x2 lam = LAMB[((l * 2 + dir) * 32 + g) * 64 + p];
                float ar = lam[0], ai = lam[1];
#pragma unroll
                for (int q = 0; q < 6; ++q) cmul(ar, ai, ar, ai);
                const f32x2* f = S5F + (size_t)(i >> 6) * 68 * 64 + p; f32x2* fo = S5H + (size_t)(i >> 6) * 68 * 64 + p;
                float hr = 0.f, hi_ = 0.f;
#pragma unroll 1
                for (int cb = 0; cb < 68; cb += 17) { f32x2 t[17];
#pragma unroll
                    for (int j = 0; j < 17; ++j) t[j] = f[(cb + j) * 64];
#pragma unroll
                    for (int j = 0; j < 17; ++j) { fo[(cb + j) * 64] = (f32x2){hr, hi_}; const float nr = ar * hr - ai * hi_ + t[j][0], ni = ar * hi_ + ai * hr + t[j][1]; hr = nr; hi_ = ni; } }
            }
        }
        SEAM(pb + 3);
        if (IN(pb + 4)) { PHASE_BEGIN();
            {
                const int skip = l == 1 ? 4 : 0, nts = 68 - skip;
                for (int u = vcu; u < 4 * nts; u += G) gla_c3_unit(ws, in, lds, l, u / nts, skip + u % nts, tid);
                const int extra = 4 * nts > G ? 4 * nts - G : 0;
                if (vcu >= extra) for (int wu = vcu - extra; wu < 4 * nts * 4; wu += G - extra) {
                    const int g = 8 * (wu & 3) + wave, ts = skip + (wu >> 2) % nts, b = (wu >> 2) / nts;
                    s5_unit<1>(ws, in, lds + wave * 9216, l, b, ts, g, lane);
                }
            }
        }
        SEAM(pb + 4);
        if (IN(pb + 5)) { PHASE_BEGIN();
            pg8::Order S; S.init1(G, bxp, SG, (bf16*)(wb + W_GLU) + (size_t)l * 512 * 512, mpan, 2, 512);
            S.A1 = (const char*)OG; S.B1 = (const char*)((bf16*)(wb + W_GP) + (size_t)l * 1024 * 512); S.nM1 = mpan; S.nN1 = 4; S.kind1 = 1;
            EpiD12 E{SG, S2, in[I_BGLU] + l * 512, GAb, Tb};
            pg8::gemm_phase<EpiD12, pg8::Order>(lds + RING_OFF, tid, 512, S, E);
        }
        SEAM(pb + 5);
        if (IN(pb + 6)) { PHASE_BEGIN();
            pg8::Order S; S.init1(G, bxp, S2, (bf16*)(wb + W_SP) + (size_t)l * 1024 * 512, mpan, 4, 512);
            EpiD3 E{Tb, GMb, XN};
            pg8::gemm_phase<EpiD3, pg8::Order>(lds + RING_OFF, tid, 512, S, E);
            if (l == 0 && G == 256 && bxp >= NPAN * 4 - G) {
                int lane2; asm volatile("v_mbcnt_lo_u32_b32 %0, -1, 0\n\tv_mbcnt_hi_u32_b32 %0, -1, %0" : "=v"(lane2));
                LAS unsigned char* scr = lds + wave * 9216;
                constexpr int IT_G = 16 * 56;
                const int nidle = 2 * G - NPAN * 4;
                for (int it = (bxp - (NPAN * 4 - G)) * NWAVES + wave; it < MOE_NPRE * 2 * IT_G; it += nidle * NWAVES) {
                    const int e = it / (2 * IT_G); int r = it - e * 2 * IT_G; unsigned char* dst = ws + WS_XN + 17 * MiB + (size_t)e * 7168 * 1024;
                    if (conv_matrix_q<2>(r, in[I_MG] + (size_t)e * 1024 * FFE, 1024, FFE, dst, 2, 0, SC_WGU, scr, lane2)) continue;
                    conv_matrix_q<2>(r, in[I_MU] + (size_t)e * 1024 * FFE, 1024, FFE, dst, 2, 128, SC_WGU, scr, lane2);
                }
            }
        }
        SEAM(pb + 6);
        if (IN(pb + 7)) { PHASE_BEGIN();
            pg8::Order S; S.init1(G, bxp, XN, (unsigned char*)(wb + W_OUT) + (size_t)l * 1024 * 1024, NLAT / 256, 4, 512);
            if (l == 0) { S.A1 = S.A0; S.B1 = S.B0; S.nM1 = NPAN - NLAT / 256; S.nN1 = 4; S.kind1 = 1; S.nt1 = 2; S.ksl1 = 4; S.kbytes1 = (size_t)256; S.pm1off = NLAT / 256; }
            EpiResidT<true> E{RES_L, RES_C, LATX, MODVL, 2, FPART, 1.f / (SC_MB * SC_WGU)};
            pg8::gemm_phase<EpiResidT<true>, pg8::Order, true, true, true, 2>(lds + RING_OFF, tid, 512, S, E);
        }
        SEAM(pb + 7);
        if (IN(pb + 8)) { PHASE_BEGIN();
            const float* nw = in[I_N2W] + l * 1024;
            LAS float* rw = (LAS float*)(lds);
            if (l == 1) { for (int i = tid; i < 8192; i += 512) rw[i] = in[I_ROUTER][i]; __syncthreads(); }
            const int nr2 = l == 0 ? NROW : NLAT;
            for (int row = gw; row < nr2; row += NGW) {
                const float* xr = LATX + (size_t)row * 1024;
                const int bi = row < NLAT ? row >> 12 : 4; const float* sh = MODVL + bi * 6144 + 3 * 1024; const float* sc = sh + 1024;
                f32x4 v[4]; float ss = 0.f;
#pragma unroll
                for (int j = 0; j < 4; ++j) {
                    if (l == 0 && row >= NLAT) {
                        f32x4 a = (f32x4){0.f, 0.f, 0.f, 0.f};
#pragma unroll 1
                        for (int k4 = 0; k4 < 4; ++k4) a = a + *(const f32x4*)(FPART + ((size_t)k4 * NCTX + (row - NLAT)) * 1024 + 4 * lane + 256 * j);
                        v[j] = *(const f32x4*)(in[I_CTX] + (size_t)(row - NLAT) * 1024 + 4 * lane + 256 * j) + *(const f32x4*)(MODV + 4 * 6144 + 2 * 1024 + 4 * lane + 256 * j) * a;
                        *(f32x4*)(LATX + (size_t)row * 1024 + 4 * lane + 256 * j) = v[j];
                    } else v[j] = *(const f32x4*)(xr + 4 * lane + 256 * j);
                    ss += v[j][0] * v[j][0] + v[j][1] * v[j][1] + v[j][2] * v[j][2] + v[j][3] * v[j][3]; }
                const float rstd = rsqrtf(wave_sum(ss, lane) * (1.f / 1024.f) + EPS);
                float lg[8]; float am1 = 1e-20f;
#pragma unroll
                for (int e = 0; e < 8; ++e) lg[e] = 0.f;
                if (l == 0) {
                    float am = 1e-20f;
#pragma unroll
                    for (int j = 0; j < 4; ++j) { const int c = 4 * lane + 256 * j; const f32x4 w = *(const f32x4*)(nw + c), s1 = *(const f32x4*)(sc + c), s0 = *(const f32x4*)(sh + c);
#pragma unroll
                        for (int e = 0; e < 4; ++e) { v[j][e] = v[j][e] * rstd * w[e] * (1.f + s1[e]) + s0[e]; am = fmaxf(am, fabsf(v[j][e])); } }
#pragma unroll
                    for (int o = 1; o < 64; o <<= 1) am = fmaxf(am, SHX(am, o));
                    const float sx = 127.f * __builtin_amdgcn_rcpf(am);
#pragma unroll
                    for (int j = 0; j < 4; ++j) *(unsigned*)((unsigned char*)XN + (size_t)row * 1024 + 4 * lane + 256 * j) = pk4_i8(v[j][0] * sx, v[j][1] * sx, v[j][2] * sx, v[j][3] * sx);
                    LDS_WAIT();
                    if (lane == 0) XNS[row] = am * (1.f / 127.f);
                    continue;
                }
#pragma unroll
                for (int j = 0; j < 4; ++j) { const int c = 4 * lane + 256 * j; const f32x4 w = *(const f32x4*)(nw + c), s1 = *(const f32x4*)(sc + c), s0 = *(const f32x4*)(sh + c);
                    f32x4 y;
#pragma unroll
                    for (int e = 0; e < 4; ++e) { y[e] = v[j][e] * rstd * w[e] * (1.f + s1[e]) + s0[e]; am1 = fmaxf(am1, fabsf(y[e])); }
                    v[j] = y;
                    {
#pragma unroll
                        for (int e = 0; e < 4; ++e) { const f32x4 r0 = *(const LAS f32x4*)(rw + (c + e) * 8), r1 = *(const LAS f32x4*)(rw + (c + e) * 8 + 4);
                            lg[0] += y[e] * r0[0]; lg[1] += y[e] * r0[1]; lg[2] += y[e] * r0[2]; lg[3] += y[e] * r0[3]; lg[4] += y[e] * r1[0]; lg[5] += y[e] * r1[1]; lg[6] += y[e] * r1[2]; lg[7] += y[e] * r1[3]; } } }
                if (l == 1) {
#pragma unroll
                    for (int o = 1; o < 64; o <<= 1) am1 = fmaxf(am1, SHX(am1, o));
                    { const float sx = 127.f * __builtin_amdgcn_rcpf(am1);
#pragma unroll
                      for (int j = 0; j < 4; ++j) *(unsigned*)(XN2 + (size_t)row * 1024 + 4 * lane + 256 * j) = pk4_i8(v[j][0] * sx, v[j][1] * sx, v[j][2] * sx, v[j][3] * sx); }
#pragma unroll
                    for (int e = 0; e < 8; ++e) lg[e] = wave_sum(lg[e], lane);
                    int e1 = 0; float v1 = lg[0];
#pragma unroll
                    for (int e = 1; e < 8; ++e) if (lg[e] > v1) { v1 = lg[e]; e1 = e; }
                    int e2 = -1; float v2 = -3.0e38f;
#pragma unroll
                    for (int e = 0; e < 8; ++e) if (e != e1 && lg[e] > v2) { v2 = lg[e]; e2 = e; }
                    if (lane == 0) {
                        const float w1 = 1.f / (1.f + __expf(v2 - v1));
                        const int p1 = (int)__hip_atomic_fetch_add(ctl + CW_CNT + 64 * e1, 1u, RLX_AGENT), p2 = (int)__hip_atomic_fetch_add(ctl + CW_CNT + 64 * e2, 1u, RLX_AGENT);
                        TOKE[row] = make_int4(e1, p1, e2, p2); TOKW[row] = (f32x2){w1, 1.f - w1}; XNS[row] = am1 * (1.f / 127.f);
                    }
                }
            }
        }
        SEAM(pb + 8);
        if (l == 0) {
            if (IN(10)) { PHASE_BEGIN();
                pg8::Order S; S.init1(G, bxp, XN, wb + W_FGU, NPAN, 22, 512);
                EpiSwigluS<true, false> E{(unsigned char*)HMID, FFD, 0, XNS, 1.f / SC_WGU, 1.f, (LAS float*)(lds + EPI_SB_OFF)};
                pg8::gemm_phase<EpiSwigluS<true, false>, pg8::Order, false, true, true, 2>(lds + RING_OFF, tid, 512, S, E);
            }
            SEAM(10);
            if (IN(11)) { PHASE_BEGIN();
                pg8::Order S; S.init1(G, bxp, HMID, (bf16*)(wb + W_FD), NLAT / 256, 4, FFD);
                S.A1 = S.A0; S.B1 = S.B0; S.nM1 = NPAN - NLAT / 256; S.nN1 = 4; S.kind1 = 1; S.nt1 = 4; S.ksl1 = 11; S.kbytes1 = (size_t)256 * 2; S.pm1off = NLAT / 256;
                EpiResid E{LATX, LATX + (size_t)NLAT * 1024, LATX, MODVL, 5, FPART, 1.f};
                pg8::gemm_phase<EpiResid, pg8::Order, true>(lds + RING_OFF, tid, FFD, S, E);
            }
            SEAM(11);
        }
    }

    int pbase[9];
    {
        int a = 0;
#pragma unroll
        for (int e = 0; e < 8; ++e) { pbase[e] = a; const unsigned c = hi > 21 ? __hip_atomic_load((gu32*)(args.ws + WS_CTL) + CW_CNT + 64 * e, RLX_AGENT) : 0u; a += (int)((c + 255u) >> 8); }
        pbase[8] = a;
    }
    if (IN(21)) { PHASE_BEGIN();
        unsigned qn[4]; int4 ten; float isn;
        { const int r0 = gw < NLAT ? gw : 0; ten = TOKE[r0]; isn = XNS[r0];
#pragma unroll
          for (int j = 0; j < 4; ++j) qn[j] = *(const unsigned*)(XN2 + (size_t)r0 * 1024 + 4 * lane + 256 * j); }
        for (int row = gw; row < NLAT; row += NGW) {
            const int4 te = ten; const float isx = isn; unsigned q[4];
#pragma unroll
            for (int j = 0; j < 4; ++j) q[j] = qn[j];
            { const int rn = row + NGW < NLAT ? row + NGW : row; ten = TOKE[rn]; isn = XNS[rn];
#pragma unroll
              for (int j = 0; j < 4; ++j) qn[j] = *(const unsigned*)(XN2 + (size_t)rn * 1024 + 4 * lane + 256 * j); }
            int s1 = 0, s2 = 0;
#pragma unroll
            for (int e = 0; e < 8; ++e) { if (te.x == e) s1 = pbase[e] * 256 + te.y; if (te.z == e) s2 = pbase[e] * 256 + te.w; }
            if (lane == 0) { TOKS[row] = make_int2(s1, s2); XSI[s1] = isx; XSI[s2] = isx; }
#pragma unroll
            for (int j = 0; j < 4; ++j) { const int c = 4 * lane + 256 * j; *(unsigned*)(XG + (size_t)s1 * 1024 + c) = q[j]; *(unsigned*)(XG + (size_t)s2 * 1024 + c) = q[j]; }
        }
        {
            LAS unsigned char* scr = lds + wave * 9216;
            constexpr int IT_G = 16 * 56, IT_D = 56 * 16;
            const int ite = G >= 8 * MOE_NCONV ? 2 * IT_G : 2 * IT_G + IT_D;
            const int e0 = G == 256 ? MOE_NPRE : 0;
            for (int it = gw; it < (8 - e0) * ite; it += NGW) {
                const int e = e0 + it / ite; int r = it - (e - e0) * ite;
                if (conv_matrix_q<2>(r, in[I_MG] + (size_t)e * 1024 * FFE, 1024, FFE, WMGU + (size_t)e * 7168 * 1024, 2, 0, SC_WGU, scr, lane)) continue;
                if (conv_matrix_q<2>(r, in[I_MU] + (size_t)e * 1024 * FFE, 1024, FFE, WMGU + (size_t)e * 7168 * 1024, 2, 128, SC_WGU, scr, lane)) continue;
                conv_matrix_q<1>(r, in[I_MD] + (size_t)e * FFE * 1024, FFE, 1024, WMD + (size_t)e * 1024 * FFE, 0, 0, SC_WD, scr, lane);
            }
        }
    }
    SEAM(21);
    {
        const int P = pbase[8];
        if (IN(22)) { PHASE_BEGIN();
            const int nconv = G >= 8 * MOE_NCONV ? MOE_NCONV : 0, Gg = G - nconv;
            if (bxp >= Gg) {
                LAS unsigned char* scr = lds + wave * 9216;
                constexpr int IT_D = 56 * 16;
                for (int it = (bxp - Gg) * NWAVES + wave; it < 8 * IT_D; it += nconv * NWAVES) {
                    const int e = it / IT_D; int r = it - e * IT_D;
                    conv_matrix_q<1>(r, in[I_MD] + (size_t)e * FFE * 1024, FFE, 1024, WMD + (size_t)e * 1024 * FFE, 0, 0, SC_WD, scr, lane);
                }
            } else {
                pg8::Order S; S.init1(Gg, bxp, XG, WMGU, P, 28, 512);
                S.moe = 1; S.pb1 = pbase[1]; S.pb2 = pbase[2]; S.pb3 = pbase[3]; S.pb4 = pbase[4]; S.pb5 = pbase[5]; S.pb6 = pbase[6]; S.pb7 = pbase[7]; S.estride = (size_t)7168 * 1024;
                if (G == 256) { S.nelo = MOE_NPRE; S.elo = (size_t)(WS_XN + 17 * MiB) - (size_t)(WS_WM + WM_GU); }
                EpiSwigluS<true, true> E{HM, FFE, 0, XSI, 1.f / SC_WGU, SC_H, (LAS float*)(lds + EPI_SB_OFF)};
                pg8::gemm_phase<EpiSwigluS<true, true>, pg8::Order, false, true, true, 2>(lds + RING_OFF, tid, 512, S, E);
            }
        }
        SEAM(22);
        if (IN(23)) { PHASE_BEGIN();
            const int nmain = P < 128 ? P : 128, ntail = P - nmain;
            pg8::Order S; S.init1(G, bxp, HM, WMD, nmain, 4, FFE / 2);
            S.moe = 1; S.pb1 = pbase[1]; S.pb2 = pbase[2]; S.pb3 = pbase[3]; S.pb4 = pbase[4]; S.pb5 = pbase[5]; S.pb6 = pbase[6]; S.pb7 = pbase[7]; S.estride = (size_t)1024 * FFE;
            S.A1 = S.A0; S.B1 = S.B0; S.nM1 = ntail; S.nN1 = 4; S.kind1 = 1; S.nt1 = 4; S.ksl1 = 7; S.kbytes1 = (size_t)512;
            S.pm1off = nmain;
            EpiPlain E{YS, YTP, 1.f / (SC_H * SC_WD)};
            pg8::gemm_phase<EpiPlain, pg8::Order, true, true, true, 1>(lds + RING_OFF, tid, FFE / 2, S, E);
        }
        SEAM(23);
    }
    if (IN(24)) { PHASE_BEGIN();
        const float* modv = MODV + (size_t)5 * 6144; const float* fw = in[I_FNW];
#ifdef PROBE_LO
        const unsigned long long* stp = (const unsigned long long*)(ws + WS_CTL + 131072);
        const float probe_scale = 1.0f + (float)(__hip_atomic_load(stp + PROBE_HI, RLX_AGENT) - __hip_atomic_load(stp + PROBE_LO, RLX_AGENT)) * 0.01f * 5e-4f;
#else
        const float probe_scale = 1.0f;
#endif
        f32x4 fwv[4];
#pragma unroll
        for (int j = 0; j < 4; ++j) fwv[j] = *(const f32x4*)(fw + 4 * lane + 256 * j);
        int2 sl_c = make_int2(0, 0), sl_n = make_int2(0, 0); f32x2 tw_c = (f32x2){0.f, 0.f}, tw_n = (f32x2){0.f, 0.f};
        f32x4 xn[4], gn_[4]; v2u y1n[4], y2n[4];
#define FIN_LOAD(row_, sl_) do { const float* xr_ = LATX + (size_t)(row_) * 1024; const float* g2_ = modv + ((row_) >> 12) * 6144 + 5 * 1024; \
            const bf16* y1p_ = YS + (size_t)((sl_).x >= 32768 ? 0 : (sl_).x) * 1024; const bf16* y2p_ = YS + (size_t)((sl_).y >= 32768 ? 0 : (sl_).y) * 1024; \
            _Pragma("unroll") for (int j = 0; j < 4; ++j) { const int c = 4 * lane + 256 * j; xn[j] = *(const f32x4*)(xr_ + c); gn_[j] = *(const f32x4*)(g2_ + c); y1n[j] = *(const v2u*)(y1p_ + c); y2n[j] = *(const v2u*)(y2p_ + c); } } while (0)
        if (gw < NLAT) { sl_c = TOKS[gw]; tw_c = TOKW[gw]; }
        if (gw + NGW < NLAT) { sl_n = TOKS[gw + NGW]; tw_n = TOKW[gw + NGW]; }
        if (gw < NLAT) FIN_LOAD(gw, sl_c);
        for (int row = gw; row < NLAT; row += NGW) {
            const int2 sl = sl_c; const f32x2 tw = tw_c;
            f32x4 x[4], gg[4]; v2u y1[4], y2[4];
#pragma unroll
            for (int j = 0; j < 4; ++j) { x[j] = xn[j]; gg[j] = gn_[j]; y1[j] = y1n[j]; y2[j] = y2n[j]; }
            sl_c = sl_n; tw_c = tw_n;
            if (row + NGW < NLAT) FIN_LOAD(row + NGW, sl_c);
            if (row + 2 * NGW < NLAT) { sl_n = TOKS[row + 2 * NGW]; tw_n = TOKW[row + 2 * NGW]; }
            const bool tx = sl.x >= 32768, ty = sl.y >= 32768;
            f32x4 a[4], bq[4];
#pragma unroll
            for (int j = 0; j < 4; ++j) { a[j] = (f32x4){bflo(y1[j].x), bfhi(y1[j].x), bflo(y1[j].y), bfhi(y1[j].y)}; bq[j] = (f32x4){bflo(y2[j].x), bfhi(y2[j].x), bflo(y2[j].y), bfhi(y2[j].y)}; }
            if (tx) {
#pragma unroll
                for (int j = 0; j < 4; ++j) { a[j] = (f32x4){0.f, 0.f, 0.f, 0.f};
#pragma unroll
                    for (int k7 = 0; k7 < 7; ++k7) { const v2u y = *(const v2u*)(YTP + ((size_t)k7 * 2048 + (sl.x - 32768)) * 1024 + 4 * lane + 256 * j); a[j] = a[j] + (f32x4){bflo(y.x), bfhi(y.x), bflo(y.y), bfhi(y.y)}; } } }
            if (ty) {
#pragma unroll
                for (int j = 0; j < 4; ++j) { bq[j] = (f32x4){0.f, 0.f, 0.f, 0.f};
#pragma unroll
                    for (int k7 = 0; k7 < 7; ++k7) { const v2u y = *(const v2u*)(YTP + ((size_t)k7 * 2048 + (sl.y - 32768)) * 1024 + 4 * lane + 256 * j); bq[j] = bq[j] + (f32x4){bflo(y.x), bfhi(y.x), bflo(y.y), bfhi(y.y)}; } } }
            f32x4 v[4]; float ss = 0.f;
#pragma unroll
            for (int j = 0; j < 4; ++j) { v[j] = x[j] + gg[j] * (a[j] * tw[0] + bq[j] * tw[1]); ss += v[j][0] * v[j][0] + v[j][1] * v[j][1] + v[j][2] * v[j][2] + v[j][3] * v[j][3]; }
            const float rstd = rsqrtf(wave_sum(ss, lane) * (1.f / 1024.f) + EPS);
#pragma unroll
            for (int j = 0; j < 4; ++j) { const int c = 4 * lane + 256 * j; *(f32x4*)(args.out + (size_t)row * 1024 + c) = v[j] * rstd * fwv[j] * probe_scale; }
        }
#undef FIN_LOAD
    }
#undef IN
#undef SEAM
}

extern "C" void kernel_launch(void* const* d_in, const int* in_sizes, int n_in, void* d_out, int out_size, void* d_ws, size_t ws_size, hipStream_t stream) {
    static int grid = 0;
    if (grid == 0) {
        if (n_in != N_IN || out_size != NLAT * D || ws_size < WS_END) { fprintf(stderr, "kernel_launch: unexpected shapes (n_in %d, out %d, ws %zu)\n", n_in, out_size, ws_size); grid = -1; return; }
        int dev = 0, cus = 0, per_cu = 0;
        if (hipGetDevice(&dev) != hipSuccess || hipDeviceGetAttribute(&cus, hipDeviceAttributeMultiprocessorCount, dev) != hipSuccess) { grid = -1; return; }
        if (hipFuncSetAttribute((const void*)fwd_kernel, hipFuncAttributeMaxDynamicSharedMemorySize, LDS_BYTES) != hipSuccess) { fprintf(stderr, "kernel_launch: hipFuncSetAttribute failed\n"); grid = -1; return; }
        if (hipOccupancyMaxActiveBlocksPerMultiprocessor(&per_cu, (const void*)fwd_kernel, NWAVES * 64, LDS_BYTES) != hipSuccess || per_cu < 1) fprintf(stderr, "kernel_launch: occupancy query reports %d\n", per_cu);
        (void)hipGetLastError();
        grid = cus;
    }
    if (grid < 0) return;
    if (hipMemsetAsync((char*)d_ws + WS_CTL, 0, CTL_ZERO_BYTES, stream) != hipSuccess) return;
    Args a{};
    for (int i = 0; i < N_IN; ++i) a.in[i] = (const float*)d_in[i];
    a.out = (float*)d_out; a.ws = (unsigned char*)d_ws;
#if MK_ONE_LAUNCH
    a.ph_lo = 0; a.ph_hi = NPH;
    hipLaunchKernelGGL(fwd_kernel, dim3(grid), dim3(NWAVES * 64), LDS_BYTES, stream, a);
#else
    for (int p = 0; p < NPH; ++p) { a.ph_lo = p; a.ph_hi = p + 1; hipLaunchKernelGGL(fwd_kernel, dim3(grid), dim3(NWAVES * 64), LDS_BYTES, stream, a); }
#endif
}
```

```cpp
#include <hip/hip_runtime.h>
#include <cstdio>
#include <cstdint>

#ifndef MK_ONE_LAUNCH
#define MK_ONE_LAUNCH 1
#endif

namespace pg8 {
#define PG8_LAS __attribute__((address_space(3)))
typedef unsigned short bf16_t;
typedef short bf16x8 __attribute__((ext_vector_type(8)));
typedef float f32x4 __attribute__((ext_vector_type(4)));
typedef unsigned u32x4 __attribute__((ext_vector_type(4)));
constexpr int BM = 256, BK = 64, HALF = 128, HTB = HALF * BK * 2, STAGE_BYTES = 8 * HTB, NXCD = 8, WGM = 8;

__host__ __device__ __forceinline__ int lds_byte(int r, int c) { const int st = (r >> 4) * 2 + (c >> 5), rr = r & 15, cc = c & 31, ob = rr * 64 + cc * 2; return st * 1024 + (ob ^ (((ob >> 9) & 1) << 5)); }
__host__ __device__ __forceinline__ void stage_rc(int b, int& R, int& C) { const int st = b / 1024, sb = b % 1024, swz = sb ^ (((sb >> 9) & 1) << 5); R = (st >> 1) * 16 + swz / 64; C = (st & 1) * 32 + (swz % 64) / 2; }
__host__ __device__ __forceinline__ int perm32(int rho) { const int n = rho >> 4, i = rho & 15; return 8 * (i >> 2) + 4 * n + (i & 3); }

struct Unit { int pm, pn, kind, nt, slice, par; const char* A; const char* B; };

struct Order {
    int G, c;
    int n0;
    const char* A0; const char* B0; int nM0, nN0, kind0;
    const char* A1; const char* B1; int nM1, nN1, kind1;
    size_t tstep;
    int pm0;
    int pm1off;
    int apm0;
    int moe; int pb1, pb2, pb3, pb4, pb5, pb6, pb7; size_t estride;
    int nelo; size_t elo;
    int nt0, nt1;
    int ksl1; size_t kbytes1;
    __device__ __forceinline__ void init1(int G_, int c_, const void* A, const void* B, int nM, int nN, int K) {
        G = G_; c = c_; A0 = (const char*)A; B0 = (const char*)B; nM0 = nM; nN0 = nN; kind0 = 0; n0 = nM * nN; A1 = A0; B1 = B0; nM1 = 0; nN1 = 1; kind1 = 1;
        tstep = (size_t)256 * K * 2; pm0 = 0; pm1off = 0; apm0 = 0; moe = 0; pb1 = pb2 = pb3 = pb4 = pb5 = pb6 = pb7 = 0; estride = 0; nelo = 0; elo = 0; nt0 = nt1 = K / BK; ksl1 = 1; kbytes1 = 0; }
    __device__ __forceinline__ bool next(int i, Unit& u) const {
        long L = (long)i * G + c; const bool s = L >= n0; if (s) L -= n0;
        const int nM = s ? nM1 : nM0, nN = s ? nN1 : nN0, nwg = nM * nN; const int ksl = s ? ksl1 : 1; if (L >= (long)nwg * ksl) return false;
        const int slice = (int)(L % ksl); L /= ksl;
        int wgid = (int)L; { const int q = nwg / NXCD, r = nwg % NXCD, xcd = wgid % NXCD, off = wgid / NXCD; wgid = (xcd < r ? xcd * (q + 1) : r * (q + 1) + (xcd - r) * q) + off; }
        const int nig = WGM * nN, gid = wgid / nig, fm = gid * WGM, gsz = (nM - fm) < WGM ? (nM - fm) : WGM;
        const int pm = pm0 + (s ? pm1off : 0) + fm + ((wgid % nig) % gsz), pn = (wgid % nig) / gsz;
        u.pm = pm; u.pn = pn; u.kind = s ? kind1 : kind0; u.nt = s ? nt1 : nt0; u.slice = slice;
        u.A = (s ? A1 : A0) + (size_t)(pm - apm0) * tstep + (size_t)slice * kbytes1;
        const char* b = (s ? B1 : B0) + (size_t)pn * tstep + (size_t)slice * kbytes1;
        if (moe) { const int e = (pm >= pb1) + (pm >= pb2) + (pm >= pb3) + (pm >= pb4) + (pm >= pb5) + (pm >= pb6) + (pm >= pb7); b += (size_t)e * estride + (e < nelo ? elo : (size_t)0); }
        u.B = b; return true;
    }
    __device__ __forceinline__ void a_ready(const Unit&) const {}
    __device__ __forceinline__ void done(const Unit&) const {}
};

__device__ __forceinline__ unsigned cvt_pk_bf16(float lo, float hi) { unsigned r; asm volatile("v_cvt_pk_bf16_f32 %0, %1, %2" : "=v"(r) : "v"(lo), "v"(hi)); return r; }

typedef int i32x4 __attribute__((ext_vector_type(4)));
typedef int i32x8 __attribute__((ext_vector_type(8)));
__device__ __forceinline__ i32x8 cat32(bf16x8 a, bf16x8 b) { return __builtin_shufflevector(__builtin_bit_cast(i32x4, a), __builtin_bit_cast(i32x4, b), 0, 1, 2, 3, 4, 5, 6, 7); }
template <class E> struct epi_has_pre { template <class T> static auto t(int) -> decltype(&T::pre, char()); template <class T> static long t(...); static constexpr bool value = sizeof(t<E>(0)) == 1; };
template <class Epi, class Sched, bool MIXED = false, bool ALIGN_EPI = true, bool SP2 = true, int QM = 0>
__device__ __forceinline__ void gemm_phase(PG8_LAS unsigned char* lds, const int tid, const int K, const Sched& S, const Epi& E) {
    const int wid = __builtin_amdgcn_readfirstlane(tid >> 6), lane = tid & 63, wr = wid >> 2, wc = wid & 3, fr = lane & 15, fq = lane >> 4;
    unsigned voffA[2], voffB[2];
#pragma unroll
    for (int i = 0; i < 2; ++i) { int R, C; stage_rc(tid * 16 + i * 8192, R, C); const int Rb = ((R & ~31) + perm32(R & 31));
        voffA[i] = (unsigned)(R * K + C) * 2u; voffB[i] = (unsigned)(Rb * K + C) * 2u; }
    const size_t kstep = (size_t)(BK * 2);
    const size_t hstep = (size_t)HALF * K * 2;
    const unsigned ldsw = (unsigned)wid * 1024u;
    const int aoff = lds_byte(wr * 64 + fr, fq * 8), boff = lds_byte(wc * 32 + fr, fq * 8);
#define PG8_SA(b, h) (((b) * 2 + (h)) * HTB)
#define PG8_SB(b, h) ((4 + (b) * 2 + (h)) * HTB)
#define PG8_STAGE(bufoff, gbase, voff) do { _Pragma("unroll") for (int _i = 0; _i < 2; ++_i) \
        __builtin_amdgcn_global_load_lds((const unsigned*)((const char*)(gbase) + (voff)[_i]), (PG8_LAS unsigned*)(lds + (bufoff) + ldsw + _i * 8192), 16, 0, 0); } while (0)
#define PG8_LDA(dst, b, h) do { _Pragma("unroll") for (int m = 0; m < 4; ++m) _Pragma("unroll") for (int k = 0; k < 2; ++k) dst[m][k] = *(const PG8_LAS bf16x8*)(lds + PG8_SA(b, h) + aoff + m * 2048 + k * 1024); } while (0)
#define PG8_LDB(dst, b, h) do { _Pragma("unroll") for (int n = 0; n < 2; ++n) _Pragma("unroll") for (int k = 0; k < 2; ++k) dst[n][k] = *(const PG8_LAS bf16x8*)(lds + PG8_SB(b, h) + boff + n * 2048 + k * 1024); } while (0)
#define PG8_MMA(ai, bj, At, Bt) do { __builtin_amdgcn_s_setprio(1); \
        if constexpr (QM == 2) { _Pragma("unroll") for (int k = 0; k < 2; ++k) _Pragma("unroll") for (int m = 0; m < 4; ++m) _Pragma("unroll") for (int n = 0; n < 2; ++n) \
            asm volatile("v_mfma_i32_16x16x64_i8 %0, %1, %2, %0" : "+v"(acc[ai][bj][m][n]) : "v"(Bt[n][k]), "v"(At[m][k])); } \
        _Pragma("unroll") for (int m = 0; m < 4; ++m) _Pragma("unroll") for (int n = 0; n < 2; ++n) { \
        if constexpr (QM == 1) asm volatile("v_mfma_f32_16x16x128_f8f6f4 %0, %1, %2, %0" : "+v"(acc[ai][bj][m][n]) : "v"(cat32(Bt[n][0], Bt[n][1])), "v"(cat32(At[m][0], At[m][1]))); \
        else if constexpr (QM == 2) { } \
        else { _Pragma("unroll") for (int k = 0; k < 2; ++k) acc[ai][bj][m][n] = __builtin_amdgcn_mfma_f32_16x16x32_bf16(Bt[n][k], At[m][k], acc[ai][bj][m][n], 0, 0, 0); } } __builtin_amdgcn_s_setprio(0); } while (0)
#define PG8_WAIT_V(n) asm volatile("s_waitcnt vmcnt(" #n ")" ::: "memory")
#define PG8_WAIT_L(n) asm volatile("s_waitcnt lgkmcnt(" #n ")" ::: "memory")
#define PG8_BAR __builtin_amdgcn_s_barrier()
#define PG8_SCHED __builtin_amdgcn_sched_barrier(0)
    Unit cur, nxt; int ui = 0;
    if (!S.next(0, cur)) return;
    f32x4 acc[2][2][4][2];
#pragma unroll
    for (int a = 0; a < 2; ++a)
#pragma unroll
        for (int b = 0; b < 2; ++b)
#pragma unroll
            for (int m = 0; m < 4; ++m)
#pragma unroll
                for (int n = 0; n < 2; ++n) acc[a][b][m][n] = (f32x4){0.f, 0.f, 0.f, 0.f};
    bf16x8 At[4][2], B0[2][2], B1[2][2];
    const char* cA = cur.A; const char* cB = cur.B;
    cur.par = 0;
    if constexpr (epi_has_pre<Epi>::value) E.pre(cur, wid, lane);
    S.a_ready(cur);
    if constexpr (SP2) {
        PG8_STAGE(PG8_SB(0, 0), cB, voffB); PG8_STAGE(PG8_SB(0, 1), cB + hstep, voffB); PG8_STAGE(PG8_SA(0, 0), cA, voffA); PG8_STAGE(PG8_SA(0, 1), cA + hstep, voffA);
        if (wr == 1) PG8_BAR;
        PG8_WAIT_V(2); PG8_BAR;
        PG8_STAGE(PG8_SB(1, 0), cB + kstep, voffB); PG8_STAGE(PG8_SA(1, 0), cA + kstep, voffA); PG8_STAGE(PG8_SB(1, 1), cB + hstep + kstep, voffB);
        PG8_WAIT_V(6); PG8_BAR;
    } else {
        PG8_STAGE(PG8_SB(0, 0), cB, voffB); PG8_STAGE(PG8_SA(0, 0), cA, voffA); PG8_STAGE(PG8_SB(0, 1), cB + hstep, voffB); PG8_STAGE(PG8_SA(0, 1), cA + hstep, voffA);
        if (wr == 1) PG8_BAR;
        PG8_WAIT_V(4); PG8_BAR;
        PG8_STAGE(PG8_SB(1, 0), cB + kstep, voffB); PG8_STAGE(PG8_SA(1, 0), cA + kstep, voffA); PG8_STAGE(PG8_SB(1, 1), cB + hstep + kstep, voffB);
        PG8_WAIT_V(6); PG8_BAR;
    }
    for (;;) {
        const bool has_next = S.next(ui + 1, nxt);
        const char* nA = has_next ? nxt.A : cA; const char* nB = has_next ? nxt.B : cB;
        int nt = MIXED ? cur.nt : K / BK;
        if constexpr (QM != 0) asm volatile("" : "+s"(nt));
        for (int t = 0; t < nt; t += 2) {
            const bool last = (t == nt - 2);
            const char* a1 = cA + (size_t)(t + 1) * kstep;
            const char* a2 = last ? nA : cA + (size_t)(t + 2) * kstep; const char* b2 = last ? nB : cB + (size_t)(t + 2) * kstep;
            const char* a3 = a2 + kstep; const char* b3 = b2 + kstep;
            if (last && has_next) S.a_ready(nxt);
            if constexpr (SP2) {
            PG8_LDB(B0, 0, 0); PG8_LDB(B1, 0, 1); PG8_SCHED; PG8_LDA(At, 0, 0); PG8_STAGE(PG8_SA(1, 1), a1 + hstep, voffA);
            PG8_WAIT_V(8); PG8_WAIT_L(0); PG8_BAR; PG8_MMA(0, 0, At, B0); PG8_MMA(0, 1, At, B1); PG8_BAR; PG8_SCHED;
            PG8_LDA(At, 0, 1); PG8_STAGE(PG8_SB(0, 0), b2, voffB); PG8_STAGE(PG8_SB(0, 1), b2 + hstep, voffB); PG8_STAGE(PG8_SA(0, 0), a2, voffA);
            PG8_WAIT_V(8); PG8_WAIT_L(0); PG8_BAR; PG8_MMA(1, 0, At, B0); PG8_MMA(1, 1, At, B1); PG8_BAR; PG8_SCHED;
            PG8_LDB(B0, 1, 0); PG8_LDB(B1, 1, 1); PG8_SCHED; PG8_LDA(At, 1, 0); PG8_STAGE(PG8_SA(0, 1), a2 + hstep, voffA);
            PG8_WAIT_V(8); PG8_WAIT_L(0); PG8_BAR; PG8_MMA(0, 0, At, B0); PG8_MMA(0, 1, At, B1); PG8_BAR; PG8_SCHED;
            PG8_LDA(At, 1, 1); PG8_STAGE(PG8_SB(1, 0), b3, voffB); PG8_STAGE(PG8_SB(1, 1), b3 + hstep, voffB); PG8_STAGE(PG8_SA(1, 0), a3, voffA);
            PG8_WAIT_V(8); PG8_WAIT_L(0); PG8_BAR; PG8_MMA(1, 0, At, B0); PG8_MMA(1, 1, At, B1); PG8_BAR; PG8_SCHED;
            } else {
            PG8_LDB(B0, 0, 0); PG8_SCHED; PG8_LDA(At, 0, 0); PG8_STAGE(PG8_SA(1, 1), a1 + hstep, voffA);
            PG8_WAIT_L(8); PG8_BAR; PG8_WAIT_L(0); PG8_MMA(0, 0, At, B0); PG8_BAR; PG8_SCHED;
            PG8_LDB(B1, 0, 1); PG8_STAGE(PG8_SB(0, 0), b2, voffB);
            PG8_BAR; PG8_WAIT_L(0); PG8_MMA(0, 1, At, B1); PG8_BAR;
            PG8_LDA(At, 0, 1); PG8_STAGE(PG8_SA(0, 0), a2, voffA);
            PG8_BAR; PG8_WAIT_L(0); PG8_MMA(1, 0, At, B0); PG8_BAR; PG8_SCHED;
            PG8_STAGE(PG8_SB(0, 1), b2 + hstep, voffB);
            PG8_WAIT_V(6); PG8_BAR; PG8_MMA(1, 1, At, B1); PG8_BAR;
            PG8_LDB(B0, 1, 0); PG8_SCHED; PG8_LDA(At, 1, 0); PG8_STAGE(PG8_SA(0, 1), a2 + hstep, voffA);
            PG8_WAIT_L(8); PG8_BAR; PG8_WAIT_L(0); PG8_MMA(0, 0, At, B0); PG8_BAR; PG8_SCHED;
            PG8_LDB(B1, 1, 1); PG8_STAGE(PG8_SB(1, 0), b3, voffB);
            PG8_BAR; PG8_WAIT_L(0); PG8_MMA(0, 1, At, B1); PG8_BAR;
            PG8_LDA(At, 1, 1); PG8_STAGE(PG8_SA(1, 0), a3, voffA);
            PG8_BAR; PG8_WAIT_L(0); PG8_MMA(1, 0, At, B0); PG8_BAR; PG8_SCHED;
            PG8_STAGE(PG8_SB(1, 1), b3 + hstep, voffB);
            PG8_WAIT_V(6); PG8_BAR; PG8_MMA(1, 1, At, B1); PG8_BAR;
            }
        }
        if constexpr (QM != 0) asm volatile("s_nop 15\n\ts_nop 15" ::: "memory");
        if constexpr (ALIGN_EPI) { if (wr == 0) PG8_BAR; }
        E(acc, cur, wr, wc, fr, fq); S.done(cur);
        nxt.par = cur.par ^ 1;
        if constexpr (epi_has_pre<Epi>::value) { if (has_next) E.pre(nxt, wid, lane); }
        if (!has_next) break;
#pragma unroll
        for (int a = 0; a < 2; ++a)
#pragma unroll
            for (int b = 0; b < 2; ++b)
#pragma unroll
                for (int m = 0; m < 4; ++m)
#pragma unroll
                    for (int n = 0; n < 2; ++n) acc[a][b][m][n] = (f32x4){0.f, 0.f, 0.f, 0.f};
        cur = nxt; cA = nA; cB = nB; ++ui;
        if constexpr (ALIGN_EPI) { if (wr == 1) PG8_BAR; }
    }
    PG8_WAIT_V(0);
    if constexpr (!ALIGN_EPI) { if (wr == 0) PG8_BAR; }
    PG8_BAR;
#undef PG8_SA
#undef PG8_SB
#undef PG8_STAGE
#undef PG8_LDA
#undef PG8_LDB
#undef PG8_MMA
#undef PG8_WAIT_V
#undef PG8_WAIT_L
#undef PG8_BAR
#undef PG8_SCHED
}
}

constexpr int NWAVES = 8;
constexpr int D = 1024, NBATCH = 4, SEQ = 4096, CTXL = 256;
constexpr int NLAT = NBATCH * SEQ, NCTX = NBATCH * CTXL, NROW = NLAT + NCTX, NPAN = NROW / 256;
constexpr int INW_SRC = 4128, INW = 4608;
constexpr int FFD = 2816, FFE = 3584, NEXP = 8;
constexpr float EPS = 1e-6f;

constexpr size_t MiB = 1u << 20;
constexpr size_t WS_CTL = 0, CTL_ZERO_BYTES = 256 * 1024;
constexpr size_t WS_TAB = 1 * MiB;
constexpr size_t WS_LATX = 8 * MiB;
constexpr size_t WS_W = 76 * MiB;
constexpr size_t WS_XN = 120 * MiB;
constexpr size_t WS_IP = 154 * MiB;
constexpr size_t WS_DS = 324 * MiB;
constexpr size_t WS_S5F = 392 * MiB;
constexpr size_t WS_OG = 401 * MiB;
constexpr size_t WS_SG = 418 * MiB;
constexpr size_t WS_O32 = 435 * MiB;
constexpr size_t WS_Y32 = 469 * MiB;
constexpr size_t WS_SST = 435 * MiB;
constexpr size_t WS_BC = 478 * MiB;
constexpr size_t WS_S5H = 469 * MiB;
constexpr size_t WS_WM = 76 * MiB;
constexpr size_t WS_XG = 244 * MiB;
constexpr size_t WS_HM = 312 * MiB;
constexpr size_t WS_YS = 438 * MiB;
constexpr size_t WS_YT = 506 * MiB;
constexpr size_t WS_END = 534 * MiB;
constexpr size_t IP_K = 0, IP_V = IP_K + (size_t)NROW * 256 * 2, IP_GF = IP_V + (size_t)NROW * 512 * 2, IP_GB = IP_GF + (size_t)NROW * 256 * 4,
                 IP_U = IP_GB + (size_t)NROW * 256 * 4, IP_Q = IP_U + (size_t)NROW * 512 * 2, IP_R = IP_Q + (size_t)NROW * 256 * 2,
                 IP_GA = IP_R + (size_t)NROW * 512 * 2, IP_GM = IP_GA + (size_t)NROW * 1024 * 2, IP_END = IP_GM + (size_t)NROW * 1024 * 2;
static_assert(IP_END <= 170 * MiB, "in-proj region");
constexpr size_t IP_T = IP_K;
constexpr size_t IP_S2 = IP_U;
constexpr size_t IP_HMID = 0;
static_assert((size_t)NROW * 1024 * 2 <= IP_GB, "T overlay");
static_assert((size_t)NROW * FFD * 2 <= 170 * MiB, "HMID overlay");
constexpr size_t W_IN = 0;
constexpr size_t W_GLU = 18 * MiB;
constexpr size_t W_GP = 19 * MiB;
constexpr size_t W_SP = 21 * MiB;
constexpr size_t W_OUT = 23 * MiB;
constexpr size_t W_FGU = 27 * MiB;
constexpr size_t W_FD = 38 * MiB;
constexpr size_t WM_GU = 0;
constexpr size_t WM_D = 112 * MiB;
constexpr size_t T_MODV = 0;
constexpr size_t T_LAMB = 256 * 1024;
constexpr size_t T_BBAR = 512 * 1024;
constexpr size_t T_TOKE = 2 * MiB;
constexpr size_t T_TOKW = 2 * MiB + 256 * 1024;
constexpr size_t T_TOKS = 2 * MiB + 512 * 1024;
constexpr size_t T_BMT = 3 * MiB;
constexpr size_t T_CMT = 3 * MiB + 512 * 1024;
constexpr size_t T_DEC = 4 * MiB;
constexpr size_t T_PT = 5 * MiB;
constexpr size_t T_XSI = 6 * MiB;
constexpr size_t T_XNS = 6 * MiB + 256 * 1024;
constexpr int CW_TMO = 0, CW_CODE = 1;
constexpr int CW_BAR = 4096;
constexpr int CW_CNT = 16384;

constexpr int RING_OFF = 0, RING_BYTES = 135168;
constexpr int LDSCTL_OFF = RING_BYTES, MISC_OFF = LDSCTL_OFF + 320;
constexpr int LDS_BYTES = 147456;
constexpr int MOE_NPRE = 2;
constexpr int MOE_NCONV = 24;
constexpr int EPI_SB_OFF = 139264;

#define GAS __attribute__((address_space(1)))
#define LAS __attribute__((address_space(3)))
typedef unsigned short bf16;
typedef unsigned v4u __attribute__((ext_vector_type(4)));
typedef unsigned v2u __attribute__((ext_vector_type(2)));
typedef float f32x4 __attribute__((ext_vector_type(4)));
typedef float f32x2 __attribute__((ext_vector_type(2)));
typedef short bf16x8 __attribute__((ext_vector_type(8)));
typedef GAS unsigned gu32;
#define RLX_AGENT __ATOMIC_RELAXED, __HIP_MEMORY_SCOPE_AGENT
#define LDS_WAIT() asm volatile("s_waitcnt lgkmcnt(0)" ::: "memory")
#define VM_WAIT() asm volatile("s_waitcnt vmcnt(0)" ::: "memory")
__device__ __forceinline__ unsigned f2bf(float f) { unsigned u = __builtin_bit_cast(unsigned, f); return (u + 0x7fffu + ((u >> 16) & 1u)) >> 16; }
__device__ __forceinline__ unsigned pk2(float lo, float hi) { return f2bf(lo) | (f2bf(hi) << 16); }
__device__ __forceinline__ float bf2f(unsigned b) { return __builtin_bit_cast(float, b << 16); }
__device__ __forceinline__ float bflo(unsigned w) { return __builtin_bit_cast(float, w << 16); }
__device__ __forceinline__ float bfhi(unsigned w) { return __builtin_bit_cast(float, w & 0xffff0000u); }
__device__ __forceinline__ float sigmoidf_(float x) { return __builtin_amdgcn_rcpf(1.0f + __expf(-x)); }
__device__ __forceinline__ float siluf_(float x) { return x * __builtin_amdgcn_rcpf(1.0f + __expf(-x)); }
__device__ __forceinline__ float geluf_(float x) { const float t = 1.5957691216057308f * (x + 0.044715f * x * x * x); return x * __builtin_amdgcn_rcpf(1.0f + __expf(-t)); }
__device__ __forceinline__ float logsigmoidf_(float z) { return fminf(z, 0.f) - __logf(1.0f + __expf(-fabsf(z))); }

#define XB_TMO      128
#define XB_XCNT(j)  (256  + 64 * (j))
#define XB_XSUB(j)  (1280 + 64 * (j))
#define XB_XGEN(j)  (2304 + 64 * (j))
#define XB_TOP      3328
#define XB_TOPGEN   3392
#define XCD_BAR_WORDS 3456
#define XB_SPIN_CAP (1u << 18)
__device__ __forceinline__ unsigned xb_ld(unsigned* p)              { return __hip_atomic_load(p, __ATOMIC_RELAXED, __HIP_MEMORY_SCOPE_AGENT); }
__device__ __forceinline__ unsigned xb_add(unsigned* p, unsigned v) { return __hip_atomic_fetch_add(p, v, __ATOMIC_RELAXED, __HIP_MEMORY_SCOPE_AGENT); }
__device__ __forceinline__ unsigned xb_xcc_id() { return (unsigned)__builtin_amdgcn_s_getreg((3 << 11) | 20) & 0xFu; }
#define XB_SPIN(cond, bar) do { unsigned _sp = 0; while (cond) { __builtin_amdgcn_s_sleep(1); \
    if ((++_sp & 255u) == 0u) { if (xb_ld(&(bar)[XB_TMO])) break; if (_sp > XB_SPIN_CAP) { atomicAdd(&(bar)[XB_TMO], 1u); break; } } } } while (0)
struct XcdBarrier { unsigned* bar; unsigned x; volatile LAS unsigned* st; };
__device__ __forceinline__ XcdBarrier xcd_barrier_post(unsigned* bar, volatile LAS unsigned* st) {
    XcdBarrier b; b.bar = bar; b.x = xb_xcc_id(); b.st = st;
    if (threadIdx.x == 0) (void)xb_add(&bar[XB_XCNT(b.x)], 1u);
    return b;
}
__device__ __forceinline__ void xcd_barrier_complete(unsigned* bar, unsigned x, unsigned& nloc, unsigned& nx) {
    const unsigned G = gridDim.x * gridDim.y * gridDim.z;
    unsigned sum, cnt, mine, sp = 0u;
    for (;;) {
        sum = 0u; cnt = 0u; mine = 0u;
#pragma unroll
        for (unsigned j = 0; j < 16; ++j) { const unsigned c = xb_ld(&bar[XB_XCNT(j)]); sum += c; cnt += (c > 0u) ? 1u : 0u; mine = (j == x) ? c : mine; }
        if (sum == G) break;
        __builtin_amdgcn_s_sleep(1);
        if ((++sp & 255u) == 0u) { if (xb_ld(&bar[XB_TMO])) break; if (sp > XB_SPIN_CAP) { atomicAdd(&bar[XB_TMO], 1u); break; } }
    }
    nloc = mine > 0u ? mine : 1u; nx = cnt > 0u ? cnt : 1u;
}
__device__ __forceinline__ void xcd_barrier(const XcdBarrier& b) {
    asm volatile("s_waitcnt vmcnt(0)" ::: "memory");
    __syncthreads();
    if (threadIdx.x == 0) {
        unsigned* bar = b.bar;
        __builtin_amdgcn_s_waitcnt(0);
        unsigned nloc = b.st[0], nx = b.st[1];
        if (nloc == 0u) { xcd_barrier_complete(bar, b.x, nloc, nx); b.st[0] = nloc; b.st[1] = nx; }
        const unsigned old = xb_add(&bar[XB_XSUB(b.x)], 1u);
        const unsigned gen = old / nloc;
        if (old + 1u == (gen + 1u) * nloc) {
            __builtin_amdgcn_fence(__ATOMIC_RELEASE, "agent");
            asm volatile("s_waitcnt vmcnt(0)" ::: "memory");
            const unsigned og = xb_add(&bar[XB_TOP], 1u);
            const unsigned tg = og / nx;
            if (og + 1u != (tg + 1u) * nx) XB_SPIN(xb_ld(&bar[XB_TOP]) < (tg + 1u) * nx, bar);
            __builtin_amdgcn_fence(__ATOMIC_ACQUIRE, "");
            asm volatile("s_waitcnt vmcnt(0)" ::: "memory");
            xb_add(&bar[XB_XGEN(b.x)], 1u);
        } else {
            XB_SPIN(xb_ld(&bar[XB_XGEN(b.x)]) == gen, bar);
            __builtin_amdgcn_fence(__ATOMIC_ACQUIRE, "agent");
            asm volatile("s_waitcnt vmcnt(0)" ::: "memory");
        }
    }
    __syncthreads();
}

enum InIdx { I_X = 0, I_C, I_CTX, I_CCTX, I_WMOD, I_BMOD, I_N1W, I_N2W, I_FNW, I_WIN, I_LRF, I_LRB, I_BIASF, I_BIASB, I_GNW,
             I_AREF, I_AIMF, I_LDTF, I_AREB, I_AIMB, I_LDTB, I_BRE, I_BIM, I_CRE, I_CIM, I_S5D, I_WGLU, I_BGLU, I_WGP, I_WSP, I_WOUT,
             I_FG, I_FU, I_FD, I_ROUTER, I_MG, I_MU, I_MD, N_IN };
struct Args { const float* in[N_IN]; float* out; unsigned char* ws; int ph_lo, ph_hi; };

#define SHX(v, m) __builtin_bit_cast(float, __builtin_amdgcn_ds_bpermute((lane ^ (m)) << 2, __builtin_bit_cast(int, (float)(v))))
__device__ __forceinline__ float wave_sum(float v, const int lane) {
#pragma unroll
    for (int o = 1; o < 64; o <<= 1) v += SHX(v, o);
    return v;
}

typedef short tr_v4i16 __attribute__((ext_vector_type(4)));
__device__ __forceinline__ void transpose_item(const float* W, int ldw, int k0, int n0, bf16* WT, int ldt, int drow0, LAS unsigned char* scr, int lane) {
    const int kk = lane >> 4, n4 = (lane & 15) * 4;
    f32x4 v[16];
#pragma unroll
    for (int i = 0; i < 16; ++i) v[i] = *(const f32x4*)(W + (size_t)(k0 + 4 * i + kk) * ldw + n0 + n4);
#pragma unroll
    for (int i = 0; i < 16; ++i) { v2u o; o.x = pk2(v[i][0], v[i][1]); o.y = pk2(v[i][2], v[i][3]); *(LAS v2u*)(scr + (4 * i + kk) * 144 + n4 * 2) = o; }
    LDS_WAIT(); asm volatile("" ::: "memory");
    const int hh = lane >> 5, blk = (lane >> 4) & 1, q = (lane & 15) >> 2, p = lane & 3, li = lane & 15;
#pragma unroll
    for (int it = 0; it < 4; ++it)
#pragma unroll
        for (int ct = 0; ct < 2; ++ct) { const int kc = 2 * it + hh, col0 = 32 * ct;
            const LAS unsigned char* a0 = scr + (8 * kc + q) * 144 + (col0 + 16 * blk + 4 * p) * 2;
            const tr_v4i16 lo = __builtin_amdgcn_ds_read_tr16_b64_v4i16((LAS tr_v4i16*)a0), hi = __builtin_amdgcn_ds_read_tr16_b64_v4i16((LAS tr_v4i16*)(a0 + 4 * 144));
            const bf16x8 o = __builtin_shufflevector(lo, hi, 0, 1, 2, 3, 4, 5, 6, 7);
            *(bf16x8*)(WT + (size_t)(drow0 + col0 + 16 * blk + li) * ldt + k0 + 8 * kc) = o; }
    LDS_WAIT(); asm volatile("" ::: "memory");
}
constexpr float SC_MB = 32.f;
constexpr float SC_XIN = 20.f;
constexpr float SC_WGU = 1024.f, SC_WD = 2048.f, SC_H = 8.f;
__device__ __forceinline__ unsigned pk4_fp8(float a, float b, float c, float d) {
    a = __builtin_amdgcn_fmed3f(a, -448.f, 448.f); b = __builtin_amdgcn_fmed3f(b, -448.f, 448.f); c = __builtin_amdgcn_fmed3f(c, -448.f, 448.f); d = __builtin_amdgcn_fmed3f(d, -448.f, 448.f);
    int r = __builtin_amdgcn_cvt_pk_fp8_f32(a, b, 0, false); r = __builtin_amdgcn_cvt_pk_fp8_f32(c, d, r, true); return (unsigned)r; }
__device__ __forceinline__ unsigned pk4_i8(float a, float b, float c, float d) {
    a = __builtin_amdgcn_fmed3f(__builtin_rintf(a), -127.f, 127.f) + 128.f; b = __builtin_amdgcn_fmed3f(__builtin_rintf(b), -127.f, 127.f) + 128.f;
    c = __builtin_amdgcn_fmed3f(__builtin_rintf(c), -127.f, 127.f) + 128.f; d = __builtin_amdgcn_fmed3f(__builtin_rintf(d), -127.f, 127.f) + 128.f;
    unsigned r = __builtin_amdgcn_cvt_pk_u8_f32(a, 0, 0); r = __builtin_amdgcn_cvt_pk_u8_f32(b, 1, r); r = __builtin_amdgcn_cvt_pk_u8_f32(c, 2, r); r = __builtin_amdgcn_cvt_pk_u8_f32(d, 3, r);
    return r ^ 0x80808080u; }
template <int FMT> __device__ __forceinline__ unsigned pk4_q(float a, float b, float c, float d) { if constexpr (FMT == 2) return pk4_i8(a, b, c, d); else return pk4_fp8(a, b, c, d); }
template <int FMT> __device__ __forceinline__ unsigned pk4_q_bf(tr_v4i16 v, float sc) {
    return pk4_q<FMT>(__builtin_bit_cast(float, (unsigned)(unsigned short)v[0] << 16) * sc, __builtin_bit_cast(float, (unsigned)(unsigned short)v[1] << 16) * sc,
                      __builtin_bit_cast(float, (unsigned)(unsigned short)v[2] << 16) * sc, __builtin_bit_cast(float, (unsigned)(unsigned short)v[3] << 16) * sc); }
__device__ __forceinline__ unsigned pk4_fp8_bf(tr_v4i16 v, float sc) {
    return pk4_fp8(__builtin_bit_cast(float, (unsigned)(unsigned short)v[0] << 16) * sc, __builtin_bit_cast(float, (unsigned)(unsigned short)v[1] << 16) * sc,
                   __builtin_bit_cast(float, (unsigned)(unsigned short)v[2] << 16) * sc, __builtin_bit_cast(float, (unsigned)(unsigned short)v[3] << 16) * sc); }
template <int FMT> __device__ __forceinline__ void transpose_item_q(const float* W, int ldw, int k0, int n0, unsigned char* WT, int ldt, int drow0, float sc, LAS unsigned char* scr, int lane) {
    const int kk = lane >> 4, n4 = (lane & 15) * 4;
    f32x4 v[16];
#pragma unroll
    for (int i = 0; i < 16; ++i) v[i] = *(const f32x4*)(W + (size_t)(k0 + 4 * i + kk) * ldw + n0 + n4);
#pragma unroll
    for (int i = 0; i < 16; ++i) { v2u o; o.x = pk2(v[i][0], v[i][1]); o.y = pk2(v[i][2], v[i][3]); *(LAS v2u*)(scr + (4 * i + kk) * 144 + n4 * 2) = o; }
    LDS_WAIT(); asm volatile("" ::: "memory");
    const int hh = lane >> 5, blk = (lane >> 4) & 1, q = (lane & 15) >> 2, p = lane & 3, li = lane & 15;
#pragma unroll
    for (int it = 0; it < 2; ++it)
#pragma unroll
        for (int ct = 0; ct < 2; ++ct) { const int kc = 4 * it + 2 * hh, col0 = 32 * ct;
            const LAS unsigned char* a0 = scr + (8 * kc + q) * 144 + (col0 + 16 * blk + 4 * p) * 2;
            const tr_v4i16 t0 = __builtin_amdgcn_ds_read_tr16_b64_v4i16((LAS tr_v4i16*)a0), t1 = __builtin_amdgcn_ds_read_tr16_b64_v4i16((LAS tr_v4i16*)(a0 + 4 * 144)),
                           t2 = __builtin_amdgcn_ds_read_tr16_b64_v4i16((LAS tr_v4i16*)(a0 + 8 * 144)), t3 = __builtin_amdgcn_ds_read_tr16_b64_v4i16((LAS tr_v4i16*)(a0 + 12 * 144));
            v4u o; o.x = pk4_q_bf<FMT>(t0, sc); o.y = pk4_q_bf<FMT>(t1, sc); o.z = pk4_q_bf<FMT>(t2, sc); o.w = pk4_q_bf<FMT>(t3, sc);
            *(v4u*)(WT + (size_t)(drow0 + col0 + 16 * blk + li) * ldt + k0 + 8 * kc) = o; }
    LDS_WAIT(); asm volatile("" ::: "memory");
}
__device__ __forceinline__ bool conv_matrix(int& r, const float* W, int K, int N, bf16* WT, int mode, int roff, LAS unsigned char* scr, int lane) {
    const int nblk = mode == 1 ? 64 : N / 64, items = (K / 64) * nblk;
    if (r >= items) { r -= items; return false; }
    const int kb = r / nblk, nb = r % nblk, k0 = 64 * kb;
    int n0, drow0;
    if (mode == 0) { n0 = 64 * nb; drow0 = n0 + roff; }
    else if (mode == 1) { n0 = nb < 12 ? 64 * nb : 800 + 64 * (nb - 12); drow0 = nb < 12 ? n0 : n0 + 480; }
    else { n0 = 64 * nb; drow0 = (n0 >> 7) * 256 + (n0 & 127) + roff; }
    transpose_item(W, N, k0, n0, WT, K, drow0, scr, lane);
    return true;
}
template <int FMT> __device__ __forceinline__ bool conv_matrix_q(int& r, const float* W, int K, int N, unsigned char* WT, int mode, int roff, float sc, LAS unsigned char* scr, int lane) {
    const int nblk = mode == 1 ? 64 : N / 64, items = (K / 64) * nblk;
    if (r >= items) { r -= items; return false; }
    const int kb = r / nblk, nb = r % nblk, k0 = 64 * kb;
    int n0 = 64 * nb, drow0;
    if (mode == 0) drow0 = n0 + roff;
    else if (mode == 1) { n0 = nb < 12 ? 64 * nb : 800 + 64 * (nb - 12); drow0 = nb < 12 ? n0 : n0 + 480; }
    else drow0 = (n0 >> 7) * 256 + (n0 & 127) + roff;
    transpose_item_q<FMT>(W, N, k0, n0, WT, K, drow0, sc, scr, lane);
    return true;
}

using pg8::Unit; using pg8::cvt_pk_bf16;
typedef pg8::f32x4 accv;
#define EPI_ARGS const accv (&acc)[2][2][4][2], const Unit& u, int wr, int wc, int fr, int fq
__device__ __forceinline__ v4u pack8(f32x4 a, f32x4 b) { v4u w; w.x = cvt_pk_bf16(a[0], a[1]); w.y = cvt_pk_bf16(a[2], a[3]); w.z = cvt_pk_bf16(b[0], b[1]); w.w = cvt_pk_bf16(b[2], b[3]); return w; }
__device__ __forceinline__ void unpack8(v4u w, f32x4& a, f32x4& b) { a = (f32x4){bflo(w.x), bfhi(w.x), bflo(w.y), bfhi(w.y)}; b = (f32x4){bflo(w.z), bfhi(w.z), bflo(w.w), bfhi(w.w)}; }

struct EpiInProj {
    bf16 *Kb, *Vb, *Ub, *Qb, *Rb, *GAb, *GMb; float *GF, *GB; const float *bias_f, *bias_b; const float* xsi; LAS float* sb;
    __device__ __forceinline__ void pre(const Unit& u, int wid, int lane) const {
        if (wid < 4) __builtin_amdgcn_global_load_lds((const unsigned*)(xsi + (size_t)u.pm * 256 + wid * 64 + lane), (LAS unsigned*)(sb + u.par * 256 + wid * 64), 4, 0, 0);
    }
    static __device__ __forceinline__ f32x4 cv(const accv& a, float is) { const float a0 = a[0], a1 = a[1], a2 = a[2], a3 = a[3];
        return (f32x4){(float)__builtin_bit_cast(int, a0) * is, (float)__builtin_bit_cast(int, a1) * is, (float)__builtin_bit_cast(int, a2) * is, (float)__builtin_bit_cast(int, a3) * is}; }
    __device__ __forceinline__ void operator()(EPI_ARGS) const {
        const int pn = u.pn, row0 = u.pm * 256 + wr * 64 + fr, cw = wc * 32 + 8 * fq;
        float is[2][4];
#pragma unroll
        for (int ai = 0; ai < 2; ++ai)
#pragma unroll
            for (int m = 0; m < 4; ++m) is[ai][m] = sb[u.par * 256 + wr * 64 + fr + ai * 128 + m * 16] * (1.f / SC_WGU);
        if (pn == 3 || pn == 4) {
            float* dst = pn == 3 ? GF : GB; const float* bias = pn == 3 ? bias_f : bias_b;
#pragma unroll
            for (int bj = 0; bj < 2; ++bj) { const int c = cw + bj * 128; const f32x4 b0 = *(const f32x4*)(bias + c), b1 = *(const f32x4*)(bias + c + 4);
#pragma unroll
                for (int ai = 0; ai < 2; ++ai)
#pragma unroll
                    for (int m = 0; m < 4; ++m) { float* p = dst + (size_t)(row0 + ai * 128 + m * 16) * 256 + c; f32x4 v0 = cv(acc[ai][bj][m][0], is[ai][m]) + b0, v1 = cv(acc[ai][bj][m][1], is[ai][m]) + b1;
#pragma unroll
                        for (int j = 0; j < 4; ++j) { v0[j] = logsigmoidf_(v0[j]) * 0.0625f; v1[j] = logsigmoidf_(v1[j]) * 0.0625f; }
                        *(f32x4*)p = v0; *(f32x4*)(p + 4) = v1; } }
            return;
        }
        bf16* dst; int ld, cb, act;
        if (pn == 0) { dst = Kb; ld = 256; cb = 0; act = 0; }
        else if (pn <= 2) { dst = Vb; ld = 512; cb = (pn - 1) * 256; act = 0; }
        else if (pn <= 6) { dst = Ub; ld = 512; cb = (pn - 5) * 256; act = 0; }
        else if (pn == 7) { dst = Qb; ld = 256; cb = 0; act = 1; }
        else if (pn <= 9) { dst = Rb; ld = 512; cb = (pn - 8) * 256; act = 2; }
        else if (pn <= 13) { dst = GAb; ld = 1024; cb = (pn - 10) * 256; act = 3; }
        else { dst = GMb; ld = 1024; cb = (pn - 14) * 256; act = 3; }
#pragma unroll
        for (int ai = 0; ai < 2; ++ai)
#pragma unroll
            for (int m = 0; m < 4; ++m) { bf16* rowp = dst + (size_t)(row0 + ai * 128 + m * 16) * ld + cb + cw;
#pragma unroll
                for (int bj = 0; bj < 2; ++bj) { f32x4 v0 = cv(acc[ai][bj][m][0], is[ai][m]), v1 = cv(acc[ai][bj][m][1], is[ai][m]);
                    if (act == 1) { v0 = v0 * 0.125f; v1 = v1 * 0.125f; }
                    else if (act == 2) {
#pragma unroll
                        for (int j = 0; j < 4; ++j) { v0[j] = siluf_(v0[j]); v1[j] = siluf_(v1[j]); } }
                    else if (act == 3) {
#pragma unroll
                        for (int j = 0; j < 4; ++j) { v0[j] = sigmoidf_(v0[j]); v1[j] = sigmoidf_(v1[j]); } }
                    *(v4u*)(rowp + bj * 128) = pack8(v0, v1); } }
    }
};
struct EpiD12 {
    const bf16* SG; bf16* S2; const float* bglu; const bf16* GA; bf16* T;
    __device__ __forceinline__ void operator()(EPI_ARGS) const {
        const int row0 = u.pm * 256 + wr * 64 + fr, c0 = u.pn * 256 + wc * 32 + 8 * fq;
        if (u.kind == 0) {
            f32x4 b0[2], b1[2];
#pragma unroll
            for (int bj = 0; bj < 2; ++bj) { b0[bj] = *(const f32x4*)(bglu + c0 + bj * 128); b1[bj] = *(const f32x4*)(bglu + c0 + bj * 128 + 4); }
#pragma unroll
            for (int ai = 0; ai < 2; ++ai)
#pragma unroll
                for (int m = 0; m < 4; ++m) { const size_t row = (size_t)(row0 + ai * 128 + m * 16);
#pragma unroll
                    for (int bj = 0; bj < 2; ++bj) { const int c = c0 + bj * 128; f32x4 v0 = acc[ai][bj][m][0], v1 = acc[ai][bj][m][1], s0, s1;
                        unpack8(*(const v4u*)(SG + row * 512 + c), s0, s1);
#pragma unroll
                        for (int j = 0; j < 4; ++j) { v0[j] = s0[j] * sigmoidf_(v0[j] + b0[bj][j]); v1[j] = s1[j] * sigmoidf_(v1[j] + b1[bj][j]); }
                        *(v4u*)(S2 + row * 512 + c) = pack8(v0, v1); } }
        } else {
#pragma unroll
            for (int ai = 0; ai < 2; ++ai)
#pragma unroll
                for (int m = 0; m < 4; ++m) { const size_t row = (size_t)(row0 + ai * 128 + m * 16);
#pragma unroll
                    for (int bj = 0; bj < 2; ++bj) { const int c = c0 + bj * 128; f32x4 s0, s1;
                        unpack8(*(const v4u*)(GA + row * 1024 + c), s0, s1); *(v4u*)(T + row * 1024 + c) = pack8(acc[ai][bj][m][0] * s0, acc[ai][bj][m][1] * s1); } }
        }
    }
};
struct EpiD3 {
    const bf16* T; const bf16* GM; bf16* MB;
    __device__ __forceinline__ void operator()(EPI_ARGS) const {
        const int row0 = u.pm * 256 + wr * 64 + fr, c0 = u.pn * 256 + wc * 32 + 8 * fq;
#pragma unroll
        for (int ai = 0; ai < 2; ++ai)
#pragma unroll
            for (int m = 0; m < 4; ++m) { const size_t row = (size_t)(row0 + ai * 128 + m * 16);
#pragma unroll
                for (int bj = 0; bj < 2; ++bj) { const int c = c0 + bj * 128; f32x4 t0, t1, g0, g1; unpack8(*(const v4u*)(T + row * 1024 + c), t0, t1); unpack8(*(const v4u*)(GM + row * 1024 + c), g0, g1);
                    const f32x4 m0 = (t0 + g0 * acc[ai][bj][m][0]) * SC_MB, m1 = (t1 + g1 * acc[ai][bj][m][1]) * SC_MB;
                    v2u o; o.x = pk4_i8(m0[0], m0[1], m0[2], m0[3]); o.y = pk4_i8(m1[0], m1[1], m1[2], m1[3]);
                    *(v2u*)((unsigned char*)MB + row * 1024 + c) = o; } }
    }
};
template <bool I32>
struct EpiResidT {
    const float* rl; const float* rc; float* out; const float* modv; int gidx; float* part; float osc;
    static __device__ __forceinline__ f32x4 cv(const accv& a, float sc) { if constexpr (I32) { const float a0 = a[0], a1 = a[1], a2 = a[2], a3 = a[3];
            return (f32x4){(float)__builtin_bit_cast(int, a0) * sc, (float)__builtin_bit_cast(int, a1) * sc, (float)__builtin_bit_cast(int, a2) * sc, (float)__builtin_bit_cast(int, a3) * sc}; } else return a; }
    __device__ __forceinline__ void operator()(EPI_ARGS) const {
        const int row0 = u.pm * 256 + wr * 64 + fr, c0 = u.pn * 256 + wc * 32 + 8 * fq;
        if (u.kind == 1) {
            float* pp = part + (size_t)u.slice * NCTX * 1024;
#pragma unroll
            for (int ai = 0; ai < 2; ++ai)
#pragma unroll
                for (int m = 0; m < 4; ++m)
#pragma unroll
                    for (int bj = 0; bj < 2; ++bj) { float* op = pp + (size_t)(row0 - NLAT + ai * 128 + m * 16) * 1024 + c0 + bj * 128; *(f32x4*)op = cv(acc[ai][bj][m][0], osc); *(f32x4*)(op + 4) = cv(acc[ai][bj][m][1], osc); }
            return;
        }
        const int bi = u.pm < NLAT / 256 ? (u.pm >> 4) : 4;
        const float* gp = modv + bi * 6144 + gidx * 1024;
#pragma unroll
        for (int bj = 0; bj < 2; ++bj) { const int c = c0 + bj * 128; const f32x4 g0 = *(const f32x4*)(gp + c), g1 = *(const f32x4*)(gp + c + 4);
#pragma unroll
            for (int ai = 0; ai < 2; ++ai)
#pragma unroll
                for (int m = 0; m < 4; ++m) { const int row = row0 + ai * 128 + m * 16;
                    const float* rp = (row < NLAT ? rl + (size_t)row * 1024 : rc + (size_t)(row - NLAT) * 1024) + c; float* op = out + (size_t)row * 1024 + c;
                    const f32x4 r0 = *(const f32x4*)rp, r1 = *(const f32x4*)(rp + 4);
                    *(f32x4*)op = r0 + g0 * cv(acc[ai][bj][m][0], osc); *(f32x4*)(op + 4) = r1 + g1 * cv(acc[ai][bj][m][1], osc); } }
    }
};
typedef EpiResidT<false> EpiResid;
struct EpiSwiglu {
    bf16* H; int ld; int pmoff;
    __device__ __forceinline__ void operator()(EPI_ARGS) const {
        const int row0 = (u.pm - pmoff) * 256 + wr * 64 + fr, c = u.pn * 128 + wc * 32 + 8 * fq;
#pragma unroll
        for (int ai = 0; ai < 2; ++ai)
#pragma unroll
            for (int m = 0; m < 4; ++m) { f32x4 g0 = acc[ai][0][m][0], g1 = acc[ai][0][m][1]; const f32x4 u0 = acc[ai][1][m][0], u1 = acc[ai][1][m][1];
#pragma unroll
                for (int j = 0; j < 4; ++j) { g0[j] = siluf_(g0[j]) * u0[j]; g1[j] = siluf_(g1[j]) * u1[j]; }
                *(v4u*)(H + (size_t)(row0 + ai * 128 + m * 16) * ld + c) = pack8(g0, g1); }
    }
};
template <bool I32, bool OUT8>
struct EpiSwigluS {
    unsigned char* H; int ld; int pmoff; const float* xsi; float wsi, hs; LAS float* sb;
    static __device__ __forceinline__ float cv(float x) { if constexpr (I32) return (float)__builtin_bit_cast(int, x); else return x; }
    __device__ __forceinline__ void pre(const Unit& u, int wid, int lane) const {
        if (wid < 4) __builtin_amdgcn_global_load_lds((const unsigned*)(xsi + (size_t)u.pm * 256 + wid * 64 + lane), (LAS unsigned*)(sb + u.par * 256 + wid * 64), 4, 0, 0);
    }
    __device__ __forceinline__ void operator()(EPI_ARGS) const {
        const int row0 = (u.pm - pmoff) * 256 + wr * 64 + fr, c = u.pn * 128 + wc * 32 + 8 * fq;
        const LAS float* xp = sb + u.par * 256 + wr * 64 + fr;
#pragma unroll
        for (int ai = 0; ai < 2; ++ai)
#pragma unroll
            for (int m = 0; m < 4; ++m) { const float is = xp[ai * 128 + m * 16] * wsi, is2 = is * hs;
                f32x4 g0 = acc[ai][0][m][0], g1 = acc[ai][0][m][1]; const f32x4 u0 = acc[ai][1][m][0], u1 = acc[ai][1][m][1];
#pragma unroll
                for (int j = 0; j < 4; ++j) { g0[j] = siluf_(cv(g0[j]) * is) * (cv(u0[j]) * is2); g1[j] = siluf_(cv(g1[j]) * is) * (cv(u1[j]) * is2); }
                if constexpr (OUT8) { v2u o; o.x = pk4_fp8(g0[0], g0[1], g0[2], g0[3]); o.y = pk4_fp8(g1[0], g1[1], g1[2], g1[3]); *(v2u*)(H + (size_t)(row0 + ai * 128 + m * 16) * ld + c) = o; }
                else *(v4u*)((bf16*)H + (size_t)(row0 + ai * 128 + m * 16) * ld + c) = pack8(g0, g1); }
    }
};
struct EpiPlain {
    bf16* Y; bf16* YT; float osc;
    __device__ __forceinline__ void operator()(EPI_ARGS) const {
        const int row0 = u.pm * 256 + wr * 64 + fr, c0 = u.pn * 256 + wc * 32 + 8 * fq;
        if (u.kind == 1) {
            bf16* yp = YT + (size_t)u.slice * 2048 * 1024;
#pragma unroll
            for (int ai = 0; ai < 2; ++ai)
#pragma unroll
                for (int m = 0; m < 4; ++m)
#pragma unroll
                    for (int bj = 0; bj < 2; ++bj) *(v4u*)(yp + (size_t)(row0 - 32768 + ai * 128 + m * 16) * 1024 + c0 + bj * 128) = pack8(acc[ai][bj][m][0] * osc, acc[ai][bj][m][1] * osc);
            return;
        }
#pragma unroll
        for (int ai = 0; ai < 2; ++ai)
#pragma unroll
            for (int m = 0; m < 4; ++m)
#pragma unroll
                for (int bj = 0; bj < 2; ++bj) *(v4u*)(Y + (size_t)(row0 + ai * 128 + m * 16) * 1024 + c0 + bj * 128) = pack8(acc[ai][bj][m][0] * osc, acc[ai][bj][m][1] * osc);
    }
};

#define PHASE_BEGIN() int tid_; asm volatile("v_mbcnt_lo_u32_b32 %0, -1, 0\n\tv_mbcnt_hi_u32_b32 %0, -1, %0" : "=v"(tid_)); tid_ += wave_s_ * 64; GAS unsigned char* wsg_ = (GAS unsigned char*)args.ws; asm volatile("" : "+s"(wsg_)); unsigned char* ws = (unsigned char*)wsg_; \
    const int tid = tid_, lane = tid & 63, wave = __builtin_amdgcn_readfirstlane(tid >> 6), gw = vcu * NWAVES + wave; (void)lane; (void)gw; \
    const float* const* in = args.in; (void)in; gu32* ctl = (gu32*)(ws + WS_CTL); (void)ctl; int bxp = bx; asm volatile("" : "+s"(bxp)); (void)bxp;
#define LATX ((float*)(ws + WS_LATX))
#define XN ((bf16*)(ws + WS_XN))
#define Kb ((bf16*)(ws + WS_IP + IP_K))
#define Vb ((bf16*)(ws + WS_IP + IP_V))
#define GF ((float*)(ws + WS_IP + IP_GF))
#define GB ((float*)(ws + WS_IP + IP_GB))
#define Ub ((bf16*)(ws + WS_IP + IP_U))
#define Qb ((bf16*)(ws + WS_IP + IP_Q))
#define Rb ((bf16*)(ws + WS_IP + IP_R))
#define GAb ((bf16*)(ws + WS_IP + IP_GA))
#define GMb ((bf16*)(ws + WS_IP + IP_GM))
#define Tb ((bf16*)(ws + WS_IP + IP_T))
#define S2 ((bf16*)(ws + WS_IP + IP_S2))
#define HMID ((bf16*)(ws + WS_IP + IP_HMID))
#define OG ((bf16*)(ws + WS_OG))
#define SG ((bf16*)(ws + WS_SG))
#define O32 ((float*)(ws + WS_O32))
#define Y32 ((float*)(ws + WS_Y32))
#define MODV ((float*)(ws + WS_TAB + T_MODV))
#define LAMB ((f32x2*)(ws + WS_TAB + T_LAMB))
#define BBAR ((f32x2*)(ws + WS_TAB + T_BBAR))
#define BMT ((bf16*)(ws + WS_TAB + T_BMT))
#define CMT ((bf16*)(ws + WS_TAB + T_CMT))
#define PT32 ((bf16*)(ws + WS_TAB + T_PT))
#define S5F ((f32x2*)(ws + WS_S5F))
#define S5H ((f32x2*)(ws + WS_S5H))
#define DSB ((bf16*)(ws + WS_DS))
#define SSTB ((bf16*)(ws + WS_SST))
#define QDB ((bf16*)(ws + WS_BC))
#define KDB ((bf16*)(ws + WS_BC + (size_t)2 * NROW * 256 * 2))
#define DECB ((float*)(ws + WS_TAB + T_DEC))
#define TOKE ((int4*)(ws + WS_TAB + T_TOKE))
#define TOKW ((f32x2*)(ws + WS_TAB + T_TOKW))
#define TOKS ((int2*)(ws + WS_TAB + T_TOKS))
#define wb (ws + WS_W)
#define WMGU ((unsigned char*)(ws + WS_WM + WM_GU))
#define WMD ((unsigned char*)(ws + WS_WM + WM_D))
#define XG ((unsigned char*)(ws + WS_XG))
#define HM ((unsigned char*)(ws + WS_HM))
#define XSI ((float*)(ws + WS_TAB + T_XSI))
#define XNS ((float*)(ws + WS_TAB + T_XNS))
#define XN2 ((unsigned char*)(ws + 216 * MiB))
#define XNS1 ((float*)(ws + WS_TAB + T_XNS + 128 * 1024 + (size_t)l * 128 * 1024))
#define YS ((bf16*)(ws + WS_YS))
#define YTP ((bf16*)(ws + WS_YT))
#define FPART ((float*)(ws + WS_DS))


typedef __bf16 bf16x2_t __attribute__((ext_vector_type(2)));
__device__ __forceinline__ unsigned cvtpk(float lo, float hi) { const f32x2 v = {lo, hi}; const bf16x2_t b = __builtin_convertvector(v, bf16x2_t); return __builtin_bit_cast(unsigned, b); }
typedef float f32x16 __attribute__((ext_vector_type(16)));
#define MFMA32(a, b, c) __builtin_amdgcn_mfma_f32_32x32x16_bf16((a), (b), (c), 0, 0, 0)
#define MFMA_FENCE() do { __builtin_amdgcn_sched_barrier(0); asm volatile("s_nop 15\n\ts_nop 15" ::: "memory"); __builtin_amdgcn_sched_barrier(0); } while (0)
#define MFMA16(a, b, c) __builtin_amdgcn_mfma_f32_16x16x32_bf16((a), (b), (c), 0, 0, 0)
__device__ __forceinline__ void cmul(float& ar, float& ai, float br, float bi) { const float r = ar * br - ai * bi, i = ar * bi + ai * br; ar = r; ai = i; }
template <int DIR> __device__ __forceinline__ void s5_scan(f32x16 (&tre)[2], f32x16 (&tim)[2], const float lr, const float li, float& sr, float& si) {
#pragma unroll
    for (int q = 0; q < 32; ++q) { const int idx = DIR ? 31 - q : q, mt = idx >> 4, i = idx & 15;
        const float nr = lr * sr - li * si + tre[mt][i], ni = lr * si + li * sr + tim[mt][i]; sr = nr; si = ni; tre[mt][i] = sr; tim[mt][i] = si; }
}
template <int DIR> __device__ __forceinline__ void s5_fix(f32x16 (&tre)[2], f32x16 (&tim)[2], const float lr, const float li, const float xr, const float xi) {
    float fr = lr, fi = li;
#pragma unroll
    for (int q = 0; q < 32; ++q) { const int idx = DIR ? 31 - q : q, mt = idx >> 4, i = idx & 15;
        tre[mt][i] += fr * xr - fi * xi; tim[mt][i] += fr * xi + fi * xr; cmul(fr, fi, lr, li); }
}
__device__ __forceinline__ void ts_rows(int b, int ts, int& rb, int& rs) { if (ts < 4) { rb = NLAT + b * CTXL + 64 * ts; rs = 1; } else { rb = b * SEQ + (ts - 4); rs = 64; } }
__device__ __forceinline__ int chain_pos(int dir, int ts) { return dir == 0 ? ts : (ts < 4 ? 3 - ts : 71 - ts); }

template <int MODE> __device__ __forceinline__ void s5_unit(unsigned char* ws, const float* const* in, LAS unsigned char* hbuf_raw, const int l, const int b, const int ts, const int g, const int lane) {
    const int r = lane & 31, hh = lane >> 5;
    int rb, rs; ts_rows(b, ts, rb, rs);
    bf16x8 ua[2];
#pragma unroll
    for (int mt = 0; mt < 2; ++mt) { const int tokA = 32 * ((r >> 2) & 1) + 16 * mt + (r & 3) + 4 * (r >> 3);
        ua[mt] = *(const bf16x8*)(Ub + (size_t)(rb + tokA * rs) * 512 + 16 * g + 8 * hh); }
    f32x4 yacc[4];
#pragma unroll
    for (int i = 0; i < 4; ++i) yacc[i] = (f32x4){0.f, 0.f, 0.f, 0.f};
    unsigned ue[4][2];
    LAS unsigned* hbuf = (LAS unsigned*)hbuf_raw;
    bf16x8 bre4[4], bim4[4]; f32x2 lam4[4], h04[4];
#pragma unroll
    for (int it = 0; it < 4; ++it) { const int dir = it >> 1, ph = it & 1, p = 32 * ph + r;
        const bf16* bm = BMT + ((size_t)((((l * 2 + dir) * 32 + g) * 2 + ph) * 2)) * 512 + r * 16 + 8 * hh;
        bre4[it] = *(const bf16x8*)bm; bim4[it] = *(const bf16x8*)(bm + 512); lam4[it] = LAMB[((l * 2 + dir) * 32 + g) * 64 + p];
        if (MODE == 1) h04[it] = S5H[((size_t)((dir * 4 + b) * 32 + g) * 68 + chain_pos(dir, ts)) * 64 + p];
        else h04[it] = (f32x2){0.f, 0.f}; }
#pragma unroll
    for (int dir = 0; dir < 2; ++dir) {
        const int cpos = chain_pos(dir, ts);
#pragma unroll
        for (int ph = 0; ph < 2; ++ph) {
            const bf16x8 bre = bre4[dir * 2 + ph], bim = bim4[dir * 2 + ph];
            f32x16 tre[2], tim[2];
            __builtin_amdgcn_sched_barrier(0);
#pragma unroll
            for (int mt = 0; mt < 2; ++mt) { f32x16 z;
#pragma unroll
                for (int i = 0; i < 16; ++i) z[i] = 0.f;
                tre[mt] = MFMA32(ua[mt], bre, z); tim[mt] = MFMA32(ua[mt], bim, z); }
            MFMA_FENCE(); MFMA_FENCE();
            const int p = 32 * ph + r;
            const f32x2 lam = lam4[dir * 2 + ph];
            const size_t fidx = ((size_t)((dir * 4 + b) * 32 + g) * 68 + cpos) * 64 + p;
            const bool first = (hh == dir);
            bf16x8 cb2[2], pa2[2][2];
            if (MODE == 1 && dir == 1 && ph == 1) {
#pragma unroll
                for (int m4 = 0; m4 < 4; ++m4)
#pragma unroll
                    for (int i = 0; i < 4; i += 2) ue[m4][i >> 1] = (unsigned)Ub[(size_t)(rb + (16 * m4 + 4 * (lane >> 4) + i) * rs) * 512 + 16 * g + (lane & 15)]
                                                                  | ((unsigned)Ub[(size_t)(rb + (16 * m4 + 4 * (lane >> 4) + i + 1) * rs) * 512 + 16 * g + (lane & 15)] << 16);
            }
            if (MODE == 1) {
                const bf16* ptb = PT32 + ((size_t)((((l * 2 + dir) * 32 + g) * 2 + ph) * 32) + (lane & 15)) * 64 + 8 * (lane >> 4);
#pragma unroll
                for (int ks = 0; ks < 2; ++ks) { cb2[ks] = *(const bf16x8*)(CMT + ((size_t)((l * 32 + g) * 16 + (lane & 15)) * 2 + ph) * 64 + 32 * ks + 8 * (lane >> 4));
                    pa2[ks][0] = *(const bf16x8*)(ptb + 32 * ks); pa2[ks][1] = *(const bf16x8*)(ptb + (size_t)16 * 64 + 32 * ks); }
            }
            float sr = 0.f, si = 0.f;
            if (MODE == 1) { const f32x2 h0 = h04[dir * 2 + ph]; if (first) { sr = h0[0]; si = h0[1]; } }
            if (dir == 0) s5_scan<0>(tre, tim, lam[0], lam[1], sr, si); else s5_scan<1>(tre, tim, lam[0], lam[1], sr, si);
            const float orr = SHX(sr, 32), oi = SHX(si, 32);
            if (MODE == 0) {
                float l32r = lam[0], l32i = lam[1];
#pragma unroll
                for (int q = 0; q < 5; ++q) cmul(l32r, l32i, l32r, l32i);
                const float fr_ = first ? sr : orr, fi_ = first ? si : oi, sr_ = first ? orr : sr, si_ = first ? oi : si;
                const f32x2 fv = (f32x2){l32r * fr_ - l32i * fi_ + sr_, l32r * fi_ + l32i * fr_ + si_};
                asm volatile("s_waitcnt lgkmcnt(0)" ::: "memory");
                if (hh == 0) S5F[fidx] = fv;
            } else {
#pragma unroll
                for (int mt = 0; mt < 2; ++mt)
#pragma unroll
                    for (int i = 0; i < 16; ++i) hbuf[(32 * hh + 16 * mt + i) * 36 + r] = cvt_pk_bf16(tre[mt][i], tim[mt][i]);
                (void)orr; (void)oi;
                float xq[2][4][2];
#pragma unroll
                for (int ks = 0; ks < 2; ++ks)
#pragma unroll
                    for (int q = 0; q < 4; ++q) { const int src = (16 * ks + 4 * (lane >> 4) + q + 32 * dir) << 2;
                        xq[ks][q][0] = __builtin_bit_cast(float, __builtin_amdgcn_ds_bpermute(src, __builtin_bit_cast(int, sr))); xq[ks][q][1] = __builtin_bit_cast(float, __builtin_amdgcn_ds_bpermute(src, __builtin_bit_cast(int, si))); }
                LDS_WAIT();
#pragma unroll
                for (int ks = 0; ks < 2; ++ks) {
                    const bf16x8 cb = cb2[ks];
#pragma unroll
                    for (int m4 = 0; m4 < 4; ++m4) { const bf16x8 ha = *(const LAS bf16x8*)(hbuf + (16 * m4 + (lane & 15)) * 36 + 16 * ks + 4 * (lane >> 4)); yacc[m4] = MFMA16(ha, cb, yacc[m4]); }
                    v4u zp;
                    { const v4u cw = __builtin_bit_cast(v4u, cb); const unsigned cwa[4] = {cw.x, cw.y, cw.z, cw.w}; unsigned zz[4];
#pragma unroll
                      for (int q = 0; q < 4; ++q) { const float c0 = bflo(cwa[q]), c1 = bfhi(cwa[q]); zz[q] = cvtpk(c0 * xq[ks][q][0] + c1 * xq[ks][q][1], c1 * xq[ks][q][0] - c0 * xq[ks][q][1]); }
                      zp.x = zz[0]; zp.y = zz[1]; zp.z = zz[2]; zp.w = zz[3]; }
                    const bf16x8 zb = __builtin_bit_cast(bf16x8, zp);
#pragma unroll
                    for (int m = 0; m < 2; ++m) { const bf16x8 pa = pa2[ks][m];
                        if (dir == 0) yacc[2 + m] = MFMA16(pa, zb, yacc[2 + m]); else yacc[m] = MFMA16(pa, zb, yacc[m]); }
                    MFMA_FENCE();
                }
                LDS_WAIT();
            }
        }
    }
    if (MODE == 1) {
        const int hc = lane & 15; const float dsk = in[I_S5D][l * 512 + 16 * g + hc];
#pragma unroll
        for (int m4 = 0; m4 < 4; ++m4)
#pragma unroll
            for (int i = 0; i < 4; ++i) { const int tok = 16 * m4 + 4 * (lane >> 4) + i; const size_t o = (size_t)(rb + tok * rs) * 512 + 16 * g + hc;
                SG[o] = (bf16)f2bf(geluf_(yacc[m4][i] + dsk * ((i & 1) ? bfhi(ue[m4][i >> 1]) : bflo(ue[m4][i >> 1])))); }
    }
}


__device__ __forceinline__ int gla_rowbase(int b, int ts) { return ts < 4 ? NLAT + b * CTXL + 64 * ts : b * SEQ + 64 * (ts - 4); }
constexpr int VROW = 1040, VIMG_BYTES = 64 * VROW;
typedef short v4i16_t __attribute__((ext_vector_type(4)));
__device__ __forceinline__ void gla_v_image(unsigned char* ws, LAS unsigned char* img, int rb, int tid) {
#pragma unroll
    for (int i = 0; i < 8; ++i) { const int ci = tid + 512 * i, row = ci >> 6, ch = ci & 63; *(LAS v4u*)(img + row * VROW + ch * 16) = *(const v4u*)(Vb + (size_t)(rb + row) * 512 + ch * 8); }
}
__device__ __forceinline__ v4i16_t gla_vtr(LAS unsigned char* img, int row0, int col0, int lane) {
    const int blk = (lane >> 4) & 1, q = (lane & 15) >> 2, p = lane & 3;
    return __builtin_amdgcn_ds_read_tr16_b64_v4i16((LAS v4i16_t*)(img + (row0 + q) * VROW + (col0 + 16 * blk + 4 * p) * 2));
}
__device__ __forceinline__ bf16x8 cat8(v4i16_t lo, v4i16_t hi) { return __builtin_shufflevector(lo, hi, 0, 1, 2, 3, 4, 5, 6, 7); }
__device__ __forceinline__ void gla_c1_unit(unsigned char* ws, LAS unsigned char* lds, const int b, const int ts, const int tid) {
    const int lane = tid & 63, w = __builtin_amdgcn_readfirstlane(tid >> 6), dir = w >> 2, h = w & 3;
    const int rb = gla_rowbase(b, ts), chain = (dir * 4 + b) * 4 + h, cpos = chain_pos(dir, ts);
    gla_v_image(ws, lds + 65536, rb, tid);
    {
        const int c4 = lane & 15, tq = lane >> 4, d0 = 4 * c4;
        const float* gp = (dir ? GB : GF) + (size_t)(rb + 16 * tq) * 256 + h * 64 + d0;
        const bf16* kp = Kb + (size_t)(rb + 16 * tq) * 256 + h * 64 + d0;
        const bf16* qp = Qb + (size_t)(rb + 16 * tq) * 256 + h * 64 + d0;
        f32x4 P[16]; v2u kv[16], qv[16];
#pragma unroll
        for (int j = 0; j < 16; ++j) { P[j] = *(const f32x4*)(gp + j * 256); kv[j] = *(const v2u*)(kp + j * 256); qv[j] = *(const v2u*)(qp + j * 256); }
        f32x4 gsave[16];
#pragma unroll
        for (int j = 0; j < 16; ++j) gsave[j] = P[j];
#pragma unroll
        for (int j = 1; j < 16; ++j) P[j] = P[j] + P[j - 1];
        const f32x4 S = P[15];
        f32x4 Qa, Qb_, Qc;
#pragma unroll
        for (int e = 0; e < 4; ++e) { Qa[e] = SHX(S[e], 16); Qb_[e] = SHX(S[e], 32); Qc[e] = SHX(S[e], 48); }
        const f32x4 total = (S + Qa) + (Qb_ + Qc);
        f32x4 off = (f32x4){0.f, 0.f, 0.f, 0.f};
        if ((tq ^ 1) < tq) off = off + Qa;
        if ((tq ^ 2) < tq) off = off + Qb_;
        if ((tq ^ 3) < tq) off = off + Qc;
        f32x4 dec;
#pragma unroll
        for (int e = 0; e < 4; ++e) dec[e] = __expf(total[e]);
        bf16* qdp = QDB + ((size_t)dir * NROW + rb + 16 * tq) * 256 + h * 64 + d0;
        bf16* kdp = KDB + ((size_t)dir * NROW + rb + 16 * tq) * 256 + h * 64 + d0;
        unsigned klp[4][8];
#pragma unroll
        for (int j = 0; j < 16; ++j) {
            const f32x4 pf = P[j] + off;
            f32x4 bc; if (dir == 0) bc = pf; else bc = total - pf + gsave[j];
            const f32x4 kk = (f32x4){bflo(kv[j].x), bfhi(kv[j].x), bflo(kv[j].y), bfhi(kv[j].y)}, qq = (f32x4){bflo(qv[j].x), bfhi(qv[j].x), bflo(qv[j].y), bfhi(qv[j].y)};
            f32x4 kd, qd, kl;
#pragma unroll
            for (int e = 0; e < 4; ++e) { const float ex = __expf(bc[e]); qd[e] = qq[e] * ex; kd[e] = kk[e] * __builtin_amdgcn_rcpf(ex); kl[e] = kd[e] * dec[e]; }
            v2u qo, ko; qo.x = cvtpk(qd[0], qd[1]); qo.y = cvtpk(qd[2], qd[3]); ko.x = cvtpk(kd[0], kd[1]); ko.y = cvtpk(kd[2], kd[3]);
            *(v2u*)(qdp + j * 256) = qo; *(v2u*)(kdp + j * 256) = ko;
            if (j & 1) {
#pragma unroll
                for (int e = 0; e < 4; ++e) klp[e][j >> 1] = cvtpk(__uint_as_float(klp[e][j >> 1]), kl[e]);
            } else {
#pragma unroll
                for (int e = 0; e < 4; ++e) klp[e][j >> 1] = __float_as_uint(kl[e]);
            }
        }
#pragma unroll
        for (int e = 0; e < 4; ++e) { const int d = d0 + e, sw = (d >> 1) & 7;
            v4u v0, v1; v0.x = klp[e][0]; v0.y = klp[e][1]; v0.z = klp[e][2]; v0.w = klp[e][3]; v1.x = klp[e][4]; v1.y = klp[e][5]; v1.z = klp[e][6]; v1.w = klp[e][7];
            *(LAS v4u*)(lds + w * 8192 + d * 128 + (((2 * tq) ^ sw) * 16)) = v0; *(LAS v4u*)(lds + w * 8192 + d * 128 + (((2 * tq + 1) ^ sw) * 16)) = v1; }
        if (tq == 0) *(f32x4*)(DECB + (size_t)(chain * 68 + cpos) * 64 + d0) = dec;
    }
    __syncthreads();
    {
        const int r = lane & 31, hh = lane >> 5;
        bf16x8 afr[2][4];
#pragma unroll
        for (int dt = 0; dt < 2; ++dt)
#pragma unroll
            for (int ks = 0; ks < 4; ++ks) { const int d = 32 * dt + r; afr[dt][ks] = *(const LAS bf16x8*)(lds + w * 8192 + d * 128 + (((2 * ks + hh) ^ ((d >> 1) & 7)) * 16)); }
        bf16* dsp = DSB + (size_t)(chain * 68 + cpos) * 8192 + (size_t)r * 64 + 4 * hh;
#pragma unroll 1
        for (int et = 0; et < 4; ++et) {
            f32x16 acc[2];
#pragma unroll
            for (int i = 0; i < 16; ++i) { acc[0][i] = 0.f; acc[1][i] = 0.f; }
#pragma unroll
            for (int ks = 0; ks < 4; ++ks) { const bf16x8 bfrag = cat8(gla_vtr(lds + 65536, 16 * ks + 8 * hh, h * 128 + 32 * et, lane), gla_vtr(lds + 65536, 16 * ks + 8 * hh + 4, h * 128 + 32 * et, lane));
                acc[0] = MFMA32(afr[0][ks], bfrag, acc[0]); acc[1] = MFMA32(afr[1][ks], bfrag, acc[1]); MFMA_FENCE(); }
#pragma unroll
            for (int dt = 0; dt < 2; ++dt)
#pragma unroll
                for (int a = 0; a < 4; ++a) { v2u o; o.x = cvtpk(acc[dt][4 * a], acc[dt][4 * a + 1]); o.y = cvtpk(acc[dt][4 * a + 2], acc[dt][4 * a + 3]); *(v2u*)(dsp + (size_t)(32 * et) * 64 + 32 * dt + 8 * a) = o; }
        }
    }
    __syncthreads();
}
__device__ __forceinline__ void gla_c3_unit(unsigned char* ws, const float* const* in, LAS unsigned char* lds, const int l, const int b, const int ts, const int tid) {
    const int lane = tid & 63, w = __builtin_amdgcn_readfirstlane(tid >> 6), h = w >> 1, eh = w & 1, r = lane & 31, hh = lane >> 5;
    const int rb = gla_rowbase(b, ts);
    gla_v_image(ws, lds, rb, tid);
    __syncthreads();
    f32x16 acc[2][2];
#pragma unroll
    for (int a = 0; a < 2; ++a)
#pragma unroll
        for (int c = 0; c < 2; ++c)
#pragma unroll
            for (int i = 0; i < 16; ++i) acc[a][c][i] = 0.f;
#pragma unroll 1
    for (int dir = 0; dir < 2; ++dir) {
        const int chain = (dir * 4 + b) * 4 + h, cpos = chain_pos(dir, ts);
        bf16x8 QD[2][4], KD[2][4];
        {
            const bf16* qb = QDB + ((size_t)dir * NROW + rb + r) * 256 + h * 64 + 8 * hh; const bf16* kb = KDB + ((size_t)dir * NROW + rb + r) * 256 + h * 64 + 8 * hh;
#pragma unroll
            for (int tile = 0; tile < 2; ++tile)
#pragma unroll
                for (int ks = 0; ks < 4; ++ks) { QD[tile][ks] = *(const bf16x8*)(qb + (size_t)(32 * tile) * 256 + 16 * ks); KD[tile][ks] = *(const bf16x8*)(kb + (size_t)(32 * tile) * 256 + 16 * ks); }
        }
#pragma unroll
        for (int st = 0; st < 2; ++st) {
#pragma unroll
            for (int tt = 0; tt < 2; ++tt) {
                const bool dead = dir == 0 ? (st == 1 && tt == 0) : (st == 0 && tt == 1);
                if (!dead) {
                    f32x16 at;
#pragma unroll
                    for (int i = 0; i < 16; ++i) at[i] = 0.f;
#pragma unroll
                    for (int ks = 0; ks < 4; ++ks) at = MFMA32(KD[st][ks], QD[tt][ks], at);
                    MFMA_FENCE();
                    const int tq = 32 * tt + r;
#pragma unroll
                    for (int i = 0; i < 16; ++i) { const int sq = 32 * st + (i & 3) + 8 * (i >> 2) + 4 * hh; const bool keep = dir == 0 ? (sq <= tq) : (sq >= tq); at[i] = keep ? at[i] : 0.f; }
#pragma unroll
                    for (int sp = 0; sp < 2; ++sp) {
                        v4u pp; pp.x = cvtpk(at[8 * sp], at[8 * sp + 1]); pp.y = cvtpk(at[8 * sp + 2], at[8 * sp + 3]); pp.z = cvtpk(at[8 * sp + 4], at[8 * sp + 5]); pp.w = cvtpk(at[8 * sp + 6], at[8 * sp + 7]);
                        const bf16x8 p = __builtin_bit_cast(bf16x8, pp);
#pragma unroll
                        for (int et = 0; et < 2; ++et) { const int col0 = h * 128 + 64 * eh + 32 * et, row0 = 32 * st + 16 * sp + 4 * hh;
                            acc[et][tt] = MFMA32(cat8(gla_vtr(lds, row0, col0, lane), gla_vtr(lds, row0 + 8, col0, lane)), p, acc[et][tt]); }
                        MFMA_FENCE();
                    }
                }
            }
        }
        {
            const bf16* sst = SSTB + ((size_t)(chain * 68 + cpos) * 128 + 64 * eh + r) * 64 + 8 * hh;
            bf16x8 SF[2][4];
#pragma unroll
            for (int et = 0; et < 2; ++et)
#pragma unroll
                for (int ks = 0; ks < 4; ++ks) SF[et][ks] = *(const bf16x8*)(sst + (size_t)(32 * et) * 64 + 16 * ks);
#pragma unroll
            for (int et = 0; et < 2; ++et)
#pragma unroll
                for (int ks = 0; ks < 4; ++ks) { acc[et][0] = MFMA32(SF[et][ks], QD[0][ks], acc[et][0]); acc[et][1] = MFMA32(SF[et][ks], QD[1][ks], acc[et][1]); }
            MFMA_FENCE();
        }
    }
    float ss[2];
#pragma unroll
    for (int tt = 0; tt < 2; ++tt) { float s = 0.f;
#pragma unroll
        for (int et = 0; et < 2; ++et)
#pragma unroll
            for (int i = 0; i < 16; ++i) s += acc[et][tt][i] * acc[et][tt][i];
        s += SHX(s, 32); ss[tt] = s; }
    LAS float* sqb = (LAS float*)(lds + 67584);
    asm volatile("s_waitcnt lgkmcnt(0)" ::: "memory");
    if (hh == 0) { sqb[w * 64 + r] = ss[0]; sqb[w * 64 + 32 + r] = ss[1]; }
    __syncthreads();
    const float* gnw = in[I_GNW] + l * 128;
    f32x4 gn[2][4]; v2u rr[2][2][4];
#pragma unroll
    for (int et = 0; et < 2; ++et)
#pragma unroll
        for (int a = 0; a < 4; ++a) { const int e0 = 64 * eh + 32 * et + 8 * a + 4 * hh; gn[et][a] = *(const f32x4*)(gnw + e0);
#pragma unroll
            for (int tt = 0; tt < 2; ++tt) rr[tt][et][a] = *(const v2u*)(Rb + (size_t)(rb + 32 * tt + r) * 512 + h * 128 + e0); }
#pragma unroll
    for (int tt = 0; tt < 2; ++tt) {
        const float rstd = rsqrtf((ss[tt] + sqb[(w ^ 1) * 64 + 32 * tt + r]) * (1.f / 128.f) + EPS);
        const size_t row = (size_t)(rb + 32 * tt + r);
#pragma unroll
        for (int et = 0; et < 2; ++et)
#pragma unroll
            for (int a = 0; a < 4; ++a) { const int e0 = 64 * eh + 32 * et + 8 * a + 4 * hh; const v2u rv = rr[tt][et][a]; const f32x4 g4 = gn[et][a];
                v2u o; o.x = cvtpk(acc[et][tt][4 * a] * rstd * g4[0] * bflo(rv.x), acc[et][tt][4 * a + 1] * rstd * g4[1] * bfhi(rv.x));
                o.y = cvtpk(acc[et][tt][4 * a + 2] * rstd * g4[2] * bflo(rv.y), acc[et][tt][4 * a + 3] * rstd * g4[3] * bfhi(rv.y));
                *(v2u*)(OG + row * 512 + h * 128 + e0) = o; }
    }
    __syncthreads();
}

constexpr int NPH = 25;

__global__ void __launch_bounds__(NWAVES * 64, 2) fwd_kernel(Args args) {
    extern __shared__ __attribute__((aligned(16))) unsigned char lds_raw[];
    LAS unsigned char* lds = (LAS unsigned char*)lds_raw;
    volatile LAS unsigned* MISC = (volatile LAS unsigned*)(lds + MISC_OFF);
    const int G = gridDim.x; const int bx = blockIdx.x; const int vcu = (G % 8 == 0) ? (bx % 8) * (G / 8) + bx / 8 : bx;
    const int NGW = G * NWAVES;
    const int wave_s_ = __builtin_amdgcn_readfirstlane((int)threadIdx.x >> 6);
    for (int i = threadIdx.x; i < (LDS_BYTES - LDSCTL_OFF) / 4; i += NWAVES * 64) ((LAS unsigned*)(lds + LDSCTL_OFF))[i] = 0u;
    __syncthreads();
    XcdBarrier bar; bar.bar = (unsigned*)(args.ws + WS_CTL) + CW_BAR; bar.x = 0; bar.st = nullptr;
    if (MK_ONE_LAUNCH) bar = xcd_barrier_post((unsigned*)(args.ws + WS_CTL) + CW_BAR, MISC + 8);
    const int lo = args.ph_lo, hi = args.ph_hi;
#define IN(k) (lo <= (k) && (k) < hi)
#ifdef PROBE_LO
#define STAMP(k) do { if (blockIdx.x == 0 && threadIdx.x == 0) ((unsigned long long*)(args.ws + WS_CTL + 131072))[(k)] = __builtin_amdgcn_s_memrealtime(); } while (0)
#else
#define STAMP(k) do {} while (0)
#endif
#define SEAM(k) do { if (lo <= (k) && (k) + 1 < hi) xcd_barrier(bar); STAMP((k) + 1); } while (0)
    STAMP(0);

    if (IN(0)) { PHASE_BEGIN();
        {
            LAS float* sil = (LAS float*)(lds + 73728);
            LAS float* red = (LAS float*)(lds + 73728 + 20480);
            for (int i = tid; i < 5 * 1024; i += 512) { const int bi = i >> 10, k = i & 1023; const float v = bi < 4 ? in[I_C][bi * 1024 + k] : in[I_CCTX][k]; sil[i] = siluf_(v); }
            __syncthreads();
            for (int it = vcu; it < 2 * 96; it += G) {
                const int l = it / 96, n0 = (it % 96) * 64, kk = lane >> 4, q = lane & 15;
                f32x4 a[5];
#pragma unroll
                for (int bi = 0; bi < 5; ++bi) a[bi] = (f32x4){0.f, 0.f, 0.f, 0.f};
                const float* wp = in[I_WMOD] + (size_t)l * 1024 * 6144 + n0 + 4 * q;
#pragma unroll 8
                for (int i2 = 0; i2 < 32; ++i2) { const int k = wave * 128 + i2 * 4 + kk; const f32x4 w = *(const f32x4*)(wp + (size_t)k * 6144);
#pragma unroll
                    for (int bi = 0; bi < 5; ++bi) a[bi] = a[bi] + w * sil[bi * 1024 + k]; }
#pragma unroll
                for (int bi = 0; bi < 5; ++bi)
#pragma unroll
                    for (int j = 0; j < 4; ++j) { float v = a[bi][j]; v += SHX(v, 16); v += SHX(v, 32); a[bi][j] = v; }
                if (lane < 16) {
#pragma unroll
                    for (int bi = 0; bi < 5; ++bi)
#pragma unroll
                        for (int j = 0; j < 4; ++j) red[(wave * 5 + bi) * 64 + 4 * q + j] = a[bi][j]; }
                __syncthreads();
                if (tid < 320) { const int bi = tid >> 6, cc = tid & 63; float s = 0.f;
#pragma unroll
                    for (int w = 0; w < 8; ++w) s += red[(w * 5 + bi) * 64 + cc];
                    MODV[(l * 5 + bi) * 6144 + n0 + cc] = s + in[I_BMOD][l * 6144 + n0 + cc]; }
                __syncthreads();
            }
        }
        for (int i = gw * 64 + lane; i < 2 * 2 * 32 * 64; i += NGW * 64) {
            const int p = i & 63, g = (i >> 6) & 31, dir = (i >> 11) & 1, l = i >> 12;
            const float* are = in[dir ? I_AREB : I_AREF]; const float* aim = in[dir ? I_AIMB : I_AIMF]; const float* ldt = in[dir ? I_LDTB : I_LDTF];
            const double ar = are[(l * 32 + g) * 64 + p], ai = aim[(l * 32 + g) * 64 + p], dt = exp((double)ldt[l * 32 + g]);
            const double mag = exp(ar * dt), lr = mag * cos(ai * dt), li = mag * sin(ai * dt);
            LAMB[i] = (f32x2){(float)lr, (float)li};
            {
                bf16* pt = PT32 + ((size_t)(((l * 2 + dir) * 32 + g) * 2 + (p >> 5)) * 32) * 64 + 2 * (p & 31); float pr = (float)lr, pi = (float)li;
                for (int k = 1; k <= 32; ++k) { const int j = dir ? 32 - k : k - 1; *(unsigned*)(pt + j * 64) = pk2(pr, pi); const float nr = pr * (float)lr - pi * (float)li, ni = pr * (float)li + pi * (float)lr; pr = nr; pi = ni; }
            }
            const double nr = lr - 1.0, ni = li, den = ar * ar + ai * ai, cr = (nr * ar + ni * ai) / den, ci = (ni * ar - nr * ai) / den;
            const float* bre = in[I_BRE] + ((size_t)(l * 32 + g) * 64 + p) * 16; const float* bim = in[I_BIM] + ((size_t)(l * 32 + g) * 64 + p) * 16;
            bf16* bm = BMT + ((size_t)(((l * 2 + dir) * 32 + g) * 2 + (p >> 5)) * 2) * 512 + (p & 31) * 16;
            for (int j = 0; j < 16; ++j) { const double br = bre[j], bi2 = bim[j]; const float vr = (float)(cr * br - ci * bi2), vi = (float)(cr * bi2 + ci * br);
                BBAR[(size_t)i * 16 + j] = (f32x2){vr, vi}; bm[j] = (bf16)f2bf(vr); bm[512 + j] = (bf16)f2bf(vi); }
        }
        for (int i = gw * 64 + lane; i < 2 * 32 * 16 * 2 * 64; i += NGW * 64) {
            const int k = i & 63, ph = (i >> 6) & 1, hh = (i >> 7) & 15, g = (i >> 11) & 31, l = i >> 16, p = 32 * ph + (k >> 1);
            const size_t ci = ((size_t)(l * 32 + g) * 16 + hh) * 64 + p;
            CMT[i] = (bf16)f2bf((k & 1) ? -in[I_CIM][ci] : in[I_CRE][ci]);
        }
        for (int i = gw * 64 + lane; i < 2 * 2 * 256 * 128; i += NGW * 64) {
            const int n = i & 255, kc = (i >> 8) & 127, dir = (i >> 15) & 1, l = i >> 16;
            const float* lr = in[dir ? I_LRB : I_LRF] + (size_t)l * 16 * 256 + n; float lrv[16];
#pragma unroll
            for (int j = 0; j < 16; ++j) lrv[j] = lr[j * 256];
            float o[8];
#pragma unroll
            for (int kk = 0; kk < 8; ++kk) { const float* wr_ = in[I_WIN] + ((size_t)l * 1024 + kc * 8 + kk) * INW_SRC + 768 + 16 * dir; float s = 0.f;
#pragma unroll
                for (int j4 = 0; j4 < 4; ++j4) { const f32x4 w = *(const f32x4*)(wr_ + 4 * j4); s += w[0] * lrv[4 * j4] + w[1] * lrv[4 * j4 + 1] + w[2] * lrv[4 * j4 + 2] + w[3] * lrv[4 * j4 + 3]; }
                o[kk] = s; }
            v2u w; w.x = pk4_i8(o[0] * SC_WGU, o[1] * SC_WGU, o[2] * SC_WGU, o[3] * SC_WGU); w.y = pk4_i8(o[4] * SC_WGU, o[5] * SC_WGU, o[6] * SC_WGU, o[7] * SC_WGU);
            *(v2u*)((unsigned char*)(wb + W_IN) + ((size_t)l * INW + 768 + 256 * dir + n) * 1024 + kc * 8) = w;
        }
        {
            LAS unsigned char* scr = lds + wave * 9216;
            constexpr int IT_IN = 16 * 64, IT_GLU = 8 * 8, IT_P = 8 * 16, IT_OUT = 16 * 16, IT_F = 16 * 44, IT_FD = 44 * 16;
            constexpr int IT_L = IT_IN + IT_GLU + 2 * IT_P + IT_OUT, NIT = 2 * IT_L + 2 * IT_F + IT_FD;
            const int dgw = NGW > 256 ? gw - 128 : gw, dng = NGW > 256 ? NGW - 128 : NGW;
            if (dgw >= 0) for (int it = dgw; it < NIT; it += dng) {
                int r = it;
                if (r < 2 * IT_L) { const int l = r / IT_L; r -= l * IT_L;
                    if (conv_matrix_q<2>(r, in[I_WIN] + (size_t)l * 1024 * INW_SRC, 1024, INW_SRC, (unsigned char*)(wb + W_IN) + (size_t)l * INW * 1024, 1, 0, SC_WGU, scr, lane)) continue;
                    if (conv_matrix(r, in[I_WGLU] + (size_t)l * 512 * 512, 512, 512, (bf16*)(wb + W_GLU) + (size_t)l * 512 * 512, 0, 0, scr, lane)) continue;
                    if (conv_matrix(r, in[I_WGP] + (size_t)l * 512 * 1024, 512, 1024, (bf16*)(wb + W_GP) + (size_t)l * 1024 * 512, 0, 0, scr, lane)) continue;
                    if (conv_matrix(r, in[I_WSP] + (size_t)l * 512 * 1024, 512, 1024, (bf16*)(wb + W_SP) + (size_t)l * 1024 * 512, 0, 0, scr, lane)) continue;
                    conv_matrix_q<2>(r, in[I_WOUT] + (size_t)l * 1024 * 1024, 1024, 1024, (unsigned char*)(wb + W_OUT) + (size_t)l * 1024 * 1024, 0, 0, SC_WGU, scr, lane); continue; }
                r -= 2 * IT_L;
                if (conv_matrix_q<2>(r, in[I_FG], 1024, FFD, (unsigned char*)(wb + W_FGU), 2, 0, SC_WGU, scr, lane)) continue;
                if (conv_matrix_q<2>(r, in[I_FU], 1024, FFD, (unsigned char*)(wb + W_FGU), 2, 128, SC_WGU, scr, lane)) continue;
                conv_matrix(r, in[I_FD], FFD, 1024, (bf16*)(wb + W_FD), 0, 0, scr, lane);
            }
        }
    }
    SEAM(0);

    for (int l = 0; l < 2; ++l) {
        const int pb = 1 + 11 * l;
#define MODVL (MODV + (size_t)l * 5 * 6144)
#define RES_L (l == 0 ? in[I_X] : (const float*)LATX)
#define RES_C (l == 0 ? in[I_CTX] : (const float*)(LATX + (size_t)NLAT * 1024))
        const int nrows = NROW;
        const int mpan = l == 0 ? NPAN : NLAT / 256;
        if (IN(pb + 0)) { PHASE_BEGIN();
            const float* nw = in[I_N1W] + l * 1024;
            for (int row = gw; row < nrows; row += NGW) {
                const float* xr = row < NLAT ? RES_L + (size_t)row * 1024 : RES_C + (size_t)(row - NLAT) * 1024;
                const int bi = row < NLAT ? row >> 12 : 4; const float* sh = MODVL + bi * 6144; const float* sc = sh + 1024;
                f32x4 v[4]; float ss = 0.f;
#pragma unroll
                for (int j = 0; j < 4; ++j) { v[j] = *(const f32x4*)(xr + 4 * lane + 256 * j);
                    if (l == 1 && row >= NLAT) {
                        f32x4 a = (f32x4){0.f, 0.f, 0.f, 0.f};
#pragma unroll
                        for (int k11 = 0; k11 < 11; ++k11) a = a + *(const f32x4*)(FPART + ((size_t)k11 * NCTX + (row - NLAT)) * 1024 + 4 * lane + 256 * j);
                        v[j] = v[j] + *(const f32x4*)(MODV + 4 * 6144 + 5 * 1024 + 4 * lane + 256 * j) * a; }
                    ss += v[j][0] * v[j][0] + v[j][1] * v[j][1] + v[j][2] * v[j][2] + v[j][3] * v[j][3]; }
                const float rstd = rsqrtf(wave_sum(ss, lane) * (1.f / 1024.f) + EPS);
                float am = 1e-20f;
#pragma unroll
                for (int j = 0; j < 4; ++j) { const int c = 4 * lane + 256 * j; const f32x4 w = *(const f32x4*)(nw + c), s1 = *(const f32x4*)(sc + c), s0 = *(const f32x4*)(sh + c);
#pragma unroll
                    for (int e = 0; e < 4; ++e) { v[j][e] = v[j][e] * rstd * w[e] * (1.f + s1[e]) + s0[e]; am = fmaxf(am, fabsf(v[j][e])); } }
#pragma unroll
                for (int o = 1; o < 64; o <<= 1) am = fmaxf(am, SHX(am, o));
                const float sx = 127.f * __builtin_amdgcn_rcpf(am);
#pragma unroll
                for (int j = 0; j < 4; ++j) *(unsigned*)((unsigned char*)XN + (size_t)row * 1024 + 4 * lane + 256 * j) = pk4_i8(v[j][0] * sx, v[j][1] * sx, v[j][2] * sx, v[j][3] * sx);
                LDS_WAIT();
                if (lane == 0) XNS1[row] = am * (1.f / 127.f);
            }
        }
        SEAM(pb + 0);
        if (IN(pb + 1)) { PHASE_BEGIN();
            pg8::Order S; S.init1(G, bxp, XN, (unsigned char*)(wb + W_IN) + (size_t)l * INW * 1024, NPAN, 18, 512);
            EpiInProj E{Kb, Vb, Ub, Qb, Rb, GAb, GMb, GF, GB, in[I_BIASF] + l * 256, in[I_BIASB] + l * 256, XNS1, (LAS float*)(lds + EPI_SB_OFF)};
            pg8::gemm_phase<EpiInProj, pg8::Order, false, true, true, 2>(lds + RING_OFF, tid, 512, S, E);
        }
        SEAM(pb + 1);
        if (IN(pb + 2)) { PHASE_BEGIN();
            for (int u = vcu; u < 4 * 68; u += G) gla_c1_unit(ws, lds, u / 68, u % 68, tid);
            {
                const int extra = 4 * 68 > G ? 4 * 68 - G : 0;
                if (vcu >= extra) for (int wu = (vcu - extra) * NWAVES + wave; wu < 4 * 68 * 32; wu += (G - extra) * NWAVES) {
                    const int g = wu & 31, ts = (wu >> 5) % 68, b = (wu >> 5) / 68;
                    s5_unit<0>(ws, in, lds + wave * 9216, l, b, ts, g, lane);
                }
            }
        }
        SEAM(pb + 2);
        if (IN(pb + 3)) { PHASE_BEGIN();
            for (int i = gw * 64 + lane; i < 32 * 128 * 32; i += NGW * 64) {
                const int dp = i & 31, e = (i >> 5) & 127, chain = i >> 12;
                const bf16* dsp = DSB + (size_t)chain * 68 * 8192 + e * 64 + 2 * dp; bf16* sp = SSTB + (size_t)chain * 68 * 8192 + e * 64 + 2 * dp; const float* dcp = DECB + (size_t)chain * 68 * 64 + 2 * dp;
                float s0 = 0.f, s1 = 0.f;
#pragma unroll 1
                for (int cb = 0; cb < 68; cb += 17) {
                    f32x2 t[17], dc[17];
#pragma unroll
                    for (int j = 0; j < 17; ++j) { const unsigned tw = *(const unsigned*)(dsp + (size_t)(cb + j) * 8192); t[j] = (f32x2){bflo(tw), bfhi(tw)}; dc[j] = *(const f32x2*)(dcp + (cb + j) * 64); }
#pragma unroll
                    for (int j = 0; j < 17; ++j) { *(unsigned*)(sp + (size_t)(cb + j) * 8192) = cvtpk(s0, s1); s0 = dc[j][0] * s0 + t[j][0]; s1 = dc[j][1] * s1 + t[j][1]; }
                }
            }
            if (wave == 0) for (int i = vcu * 64 + lane; i < 2 * 4 * 32 * 64; i += G * 64) {
                const int p = i & 63, g = (i >> 6) & 31, dir = i >> 13;
                const f32x2 lam = LAMB[((l * 2 + dir) * 32 + g) * 64 + p];
                float ar = lam[0], ai = lam[1];
#pragma unroll
                for (int q = 0; q < 6; ++q) cmul(ar, ai, ar, ai);
                const f32x2* f = S5F + (size_t)(i >> 6) * 68 * 64 + p; f32x2* fo = S5H + (size_t)(i >> 6) * 68 * 64 + p;
                float hr = 0.f, hi_ = 0.f;
#pragma unroll 1
                for (int cb = 0; cb < 68; cb += 17) { f32x2 t[17];
#pragma unroll
                    for (int j = 0; j < 17; ++j) t[j] = f[(cb + j) * 64];
#pragma unroll
                    for (int j = 0; j < 17; ++j) { fo[(cb + j) * 64] = (f32x2){hr, hi_}; const float nr = ar * hr - ai * hi_ + t[j][0], ni = ar * hi_ + ai * hr + t[j][1]; hr = nr; hi_ = ni; } }
            }
        }
        SEAM(pb + 3);
        if (IN(pb + 4)) { PHASE_BEGIN();
            {
                const int skip = l == 1 ? 4 : 0, nts = 68 - skip;
                for (int u = vcu; u < 4 * nts; u += G) gla_c3_unit(ws, in, lds, l, u / nts, skip + u % nts, tid);
                const int extra = 4 * nts > G ? 4 * nts - G : 0;
                if (vcu >= extra) for (int wu = vcu - extra; wu < 4 * nts * 4; wu += G - extra) {
                    const int g = 8 * (wu & 3) + wave, ts = skip + (wu >> 2) % nts, b = (wu >> 2) / nts;
                    s5_unit<1>(ws, in, lds + wave * 9216, l, b, ts, g, lane);
                }
            }
        }
        SEAM(pb + 4);
        if (IN(pb + 5)) { PHASE_BEGIN();
            pg8::Order S; S.init1(G, bxp, SG, (bf16*)(wb + W_GLU) + (size_t)l * 512 * 512, mpan, 2, 512);
            S.A1 = (const char*)OG; S.B1 = (const char*)((bf16*)(wb + W_GP) + (size_t)l * 1024 * 512); S.nM1 = mpan; S.nN1 = 4; S.kind1 = 1;
            EpiD12 E{SG, S2, in[I_BGLU] + l * 512, GAb, Tb};
            pg8::gemm_phase<EpiD12, pg8::Order>(lds + RING_OFF, tid, 512, S, E);
        }
        SEAM(pb + 5);
        if (IN(pb + 6)) { PHASE_BEGIN();
            pg8::Order S; S.init1(G, bxp, S2, (bf16*)(wb + W_SP) + (size_t)l * 1024 * 512, mpan, 4, 512);
            EpiD3 E{Tb, GMb, XN};
            pg8::gemm_phase<EpiD3, pg8::Order>(lds + RING_OFF, tid, 512, S, E);
            if (l == 0 && G == 256 && bxp >= NPAN * 4 - G) {
                int lane2; asm volatile("v_mbcnt_lo_u32_b32 %0, -1, 0\n\tv_mbcnt_hi_u32_b32 %0, -1, %0" : "=v"(lane2));
                LAS unsigned char* scr = lds + wave * 9216;
                constexpr int IT_G = 16 * 56;
                const int nidle = 2 * G - NPAN * 4;
                for (int it = (bxp - (NPAN * 4 - G)) * NWAVES + wave; it < MOE_NPRE * 2 * IT_G; it += nidle * NWAVES) {
                    const int e = it / (2 * IT_G); int r = it - e * 2 * IT_G; unsigned char* dst = ws + WS_XN + 17 * MiB + (size_t)e * 7168 * 1024;
                    if (conv_matrix_q<2>(r, in[I_MG] + (size_t)e * 1024 * FFE, 1024, FFE, dst, 2, 0, SC_WGU, scr, lane2)) continue;
                    conv_matrix_q<2>(r, in[I_MU] + (size_t)e * 1024 * FFE, 1024, FFE, dst, 2, 128, SC_WGU, scr, lane2);
                }
            }
        }
        SEAM(pb + 6);
        if (IN(pb + 7)) { PHASE_BEGIN();
            pg8::Order S; S.init1(G, bxp, XN, (unsigned char*)(wb + W_OUT) + (size_t)l * 1024 * 1024, NLAT / 256, 4, 512);
            if (l == 0) { S.A1 = S.A0; S.B1 = S.B0; S.nM1 = NPAN - NLAT / 256; S.nN1 = 4; S.kind1 = 1; S.nt1 = 2; S.ksl1 = 4; S.kbytes1 = (size_t)256; S.pm1off = NLAT / 256; }
            EpiResidT<true> E{RES_L, RES_C, LATX, MODVL, 2, FPART, 1.f / (SC_MB * SC_WGU)};
            pg8::gemm_phase<EpiResidT<true>, pg8::Order, true, true, true, 2>(lds + RING_OFF, tid, 512, S, E);
        }
        SEAM(pb + 7);
        if (IN(pb + 8)) { PHASE_BEGIN();
            const float* nw = in[I_N2W] + l * 1024;
            LAS float* rw = (LAS float*)(lds);
            if (l == 1) { for (int i = tid; i < 8192; i += 512) rw[i] = in[I_ROUTER][i]; __syncthreads(); }
            const int nr2 = l == 0 ? NROW : NLAT;
            for (int row = gw; row < nr2; row += NGW) {
                const float* xr = LATX + (size_t)row * 1024;
                const int bi = row < NLAT ? row >> 12 : 4; const float* sh = MODVL + bi * 6144 + 3 * 1024; const float* sc = sh + 1024;
                f32x4 v[4]; float ss = 0.f;
#pragma unroll
                for (int j = 0; j < 4; ++j) {
                    if (l == 0 && row >= NLAT) {
                        f32x4 a = (f32x4){0.f, 0.f, 0.f, 0.f};
#pragma unroll 1
                        for (int k4 = 0; k4 < 4; ++k4) a = a + *(const f32x4*)(FPART + ((size_t)k4 * NCTX + (row - NLAT)) * 1024 + 4 * lane + 256 * j);
                        v[j] = *(const f32x4*)(in[I_CTX] + (size_t)(row - NLAT) * 1024 + 4 * lane + 256 * j) + *(const f32x4*)(MODV + 4 * 6144 + 2 * 1024 + 4 * lane + 256 * j) * a;
                        *(f32x4*)(LATX + (size_t)row * 1024 + 4 * lane + 256 * j) = v[j];
                    } else v[j] = *(const f32x4*)(xr + 4 * lane + 256 * j);
                    ss += v[j][0] * v[j][0] + v[j][1] * v[j][1] + v[j][2] * v[j][2] + v[j][3] * v[j][3]; }
                const float rstd = rsqrtf(wave_sum(ss, lane) * (1.f / 1024.f) + EPS);
                float lg[8]; float am1 = 1e-20f;
#pragma unroll
                for (int e = 0; e < 8; ++e) lg[e] = 0.f;
                if (l == 0) {
                    float am = 1e-20f;
#pragma unroll
                    for (int j = 0; j < 4; ++j) { const int c = 4 * lane + 256 * j; const f32x4 w = *(const f32x4*)(nw + c), s1 = *(const f32x4*)(sc + c), s0 = *(const f32x4*)(sh + c);
#pragma unroll
                        for (int e = 0; e < 4; ++e) { v[j][e] = v[j][e] * rstd * w[e] * (1.f + s1[e]) + s0[e]; am = fmaxf(am, fabsf(v[j][e])); } }
#pragma unroll
                    for (int o = 1; o < 64; o <<= 1) am = fmaxf(am, SHX(am, o));
                    const float sx = 127.f * __builtin_amdgcn_rcpf(am);
#pragma unroll
                    for (int j = 0; j < 4; ++j) *(unsigned*)((unsigned char*)XN + (size_t)row * 1024 + 4 * lane + 256 * j) = pk4_i8(v[j][0] * sx, v[j][1] * sx, v[j][2] * sx, v[j][3] * sx);
                    LDS_WAIT();
                    if (lane == 0) XNS[row] = am * (1.f / 127.f);
                    continue;
                }
#pragma unroll
                for (int j = 0; j < 4; ++j) { const int c = 4 * lane + 256 * j; const f32x4 w = *(const f32x4*)(nw + c), s1 = *(const f32x4*)(sc + c), s0 = *(const f32x4*)(sh + c);
                    f32x4 y;
#pragma unroll
                    for (int e = 0; e < 4; ++e) { y[e] = v[j][e] * rstd * w[e] * (1.f + s1[e]) + s0[e]; am1 = fmaxf(am1, fabsf(y[e])); }
                    v[j] = y;
                    {
#pragma unroll
                        for (int e = 0; e < 4; ++e) { const f32x4 r0 = *(const LAS f32x4*)(rw + (c + e) * 8), r1 = *(const LAS f32x4*)(rw + (c + e) * 8 + 4);
                            lg[0] += y[e] * r0[0]; lg[1] += y[e] * r0[1]; lg[2] += y[e] * r0[2]; lg[3] += y[e] * r0[3]; lg[4] += y[e] * r1[0]; lg[5] += y[e] * r1[1]; lg[6] += y[e] * r1[2]; lg[7] += y[e] * r1[3]; } } }
                if (l == 1) {
#pragma unroll
                    for (int o = 1; o < 64; o <<= 1) am1 = fmaxf(am1, SHX(am1, o));
                    { const float sx = 127.f * __builtin_amdgcn_rcpf(am1);
#pragma unroll
                      for (int j = 0; j < 4; ++j) *(unsigned*)(XN2 + (size_t)row * 1024 + 4 * lane + 256 * j) = pk4_i8(v[j][0] * sx, v[j][1] * sx, v[j][2] * sx, v[j][3] * sx); }
#pragma unroll
                    for (int e = 0; e < 8; ++e) lg[e] = wave_sum(lg[e], lane);
                    int e1 = 0; float v1 = lg[0];
#pragma unroll
                    for (int e = 1; e < 8; ++e) if (lg[e] > v1) { v1 = lg[e]; e1 = e; }
                    int e2 = -1; float v2 = -3.0e38f;
#pragma unroll
                    for (int e = 0; e < 8; ++e) if (e != e1 && lg[e] > v2) { v2 = lg[e]; e2 = e; }
                    if (lane == 0) {
                        const float w1 = 1.f / (1.f + __expf(v2 - v1));
                        const int p1 = (int)__hip_atomic_fetch_add(ctl + CW_CNT + 64 * e1, 1u, RLX_AGENT), p2 = (int)__hip_atomic_fetch_add(ctl + CW_CNT + 64 * e2, 1u, RLX_AGENT);
                        TOKE[row] = make_int4(e1, p1, e2, p2); TOKW[row] = (f32x2){w1, 1.f - w1}; XNS[row] = am1 * (1.f / 127.f);
                    }
                }
            }
        }
        SEAM(pb + 8);
        if (l == 0) {
            if (IN(10)) { PHASE_BEGIN();
                pg8::Order S; S.init1(G, bxp, XN, wb + W_FGU, NPAN, 22, 512);
                EpiSwigluS<true, false> E{(unsigned char*)HMID, FFD, 0, XNS, 1.f / SC_WGU, 1.f, (LAS float*)(lds + EPI_SB_OFF)};
                pg8::gemm_phase<EpiSwigluS<true, false>, pg8::Order, false, true, true, 2>(lds + RING_OFF, tid, 512, S, E);
            }
            SEAM(10);
            if (IN(11)) { PHASE_BEGIN();
                pg8::Order S; S.init1(G, bxp, HMID, (bf16*)(wb + W_FD), NLAT / 256, 4, FFD);
                S.A1 = S.A0; S.B1 = S.B0; S.nM1 = NPAN - NLAT / 256; S.nN1 = 4; S.kind1 = 1; S.nt1 = 4; S.ksl1 = 11; S.kbytes1 = (size_t)256 * 2; S.pm1off = NLAT / 256;
                EpiResid E{LATX, LATX + (size_t)NLAT * 1024, LATX, MODVL, 5, FPART, 1.f};
                pg8::gemm_phase<EpiResid, pg8::Order, true>(lds + RING_OFF, tid, FFD, S, E);
            }
            SEAM(11);
        }
    }

    int pbase[9];
    {
        int a = 0;
#pragma unroll
        for (int e = 0; e < 8; ++e) { pbase[e] = a; const unsigned c = hi > 21 ? __hip_atomic_load((gu32*)(args.ws + WS_CTL) + CW_CNT + 64 * e, RLX_AGENT) : 0u; a += (int)((c + 255u) >> 8); }
        pbase[8] = a;
    }
    if (IN(21)) { PHASE_BEGIN();
        v4u qn; int4 ten; float isn;
        { const int r0 = gw < NLAT ? gw : 0; ten = TOKE[r0]; isn = XNS[r0]; qn = *(const v4u*)(XN2 + (size_t)r0 * 1024 + 16 * lane); }
        for (int row = gw; row < NLAT; row += NGW) {
            const int4 te = ten; const float isx = isn; const v4u q = qn;
            { const int rn = row + NGW < NLAT ? row + NGW : row; ten = TOKE[rn]; isn = XNS[rn]; qn = *(const v4u*)(XN2 + (size_t)rn * 1024 + 16 * lane); }
            int s1 = 0, s2 = 0;
#pragma unroll
            for (int e = 0; e < 8; ++e) { if (te.x == e) s1 = pbase[e] * 256 + te.y; if (te.z == e) s2 = pbase[e] * 256 + te.w; }
            if (lane == 0) { TOKS[row] = make_int2(s1, s2); XSI[s1] = isx; XSI[s2] = isx; }
            *(v4u*)(XG + (size_t)s1 * 1024 + 16 * lane) = q; *(v4u*)(XG + (size_t)s2 * 1024 + 16 * lane) = q;
        }
        {
            LAS unsigned char* scr = lds + wave * 9216;
            constexpr int IT_G = 16 * 56, IT_D = 56 * 16;
            const int ite = G >= 8 * MOE_NCONV ? 2 * IT_G : 2 * IT_G + IT_D;
            const int e0 = G == 256 ? MOE_NPRE : 0;
            for (int it = gw; it < (8 - e0) * ite; it += NGW) {
                const int e = e0 + it / ite; int r = it - (e - e0) * ite;
                if (conv_matrix_q<2>(r, in[I_MG] + (size_t)e * 1024 * FFE, 1024, FFE, WMGU + (size_t)e * 7168 * 1024, 2, 0, SC_WGU, scr, lane)) continue;
                if (conv_matrix_q<2>(r, in[I_MU] + (size_t)e * 1024 * FFE, 1024, FFE, WMGU + (size_t)e * 7168 * 1024, 2, 128, SC_WGU, scr, lane)) continue;
                conv_matrix_q<1>(r, in[I_MD] + (size_t)e * FFE * 1024, FFE, 1024, WMD + (size_t)e * 1024 * FFE, 0, 0, SC_WD, scr, lane);
            }
        }
    }
    SEAM(21);
    {
        const int P = pbase[8];
        if (IN(22)) { PHASE_BEGIN();
            const int nconv = G >= 8 * MOE_NCONV ? MOE_NCONV : 0, Gg = G - nconv;
            if (bxp >= Gg) {
                LAS unsigned char* scr = lds + wave * 9216;
                constexpr int IT_D = 56 * 16;
                for (int it = (bxp - Gg) * NWAVES + wave; it < 8 * IT_D; it += nconv * NWAVES) {
                    const int e = it / IT_D; int r = it - e * IT_D;
                    conv_matrix_q<1>(r, in[I_MD] + (size_t)e * FFE * 1024, FFE, 1024, WMD + (size_t)e * 1024 * FFE, 0, 0, SC_WD, scr, lane);
                }
            } else {
                pg8::Order S; S.init1(Gg, bxp, XG, WMGU, P, 28, 512);
                S.moe = 1; S.pb1 = pbase[1]; S.pb2 = pbase[2]; S.pb3 = pbase[3]; S.pb4 = pbase[4]; S.pb5 = pbase[5]; S.pb6 = pbase[6]; S.pb7 = pbase[7]; S.estride = (size_t)7168 * 1024;
                if (G == 256) { S.nelo = MOE_NPRE; S.elo = (size_t)(WS_XN + 17 * MiB) - (size_t)(WS_WM + WM_GU); }
                EpiSwigluS<true, true> E{HM, FFE, 0, XSI, 1.f / SC_WGU, SC_H, (LAS float*)(lds + EPI_SB_OFF)};
                pg8::gemm_phase<EpiSwigluS<true, true>, pg8::Order, false, true, true, 2>(lds + RING_OFF, tid, 512, S, E);
            }
        }
        SEAM(22);
        if (IN(23)) { PHASE_BEGIN();
            const int nmain = P < 128 ? P : 128, ntail = P - nmain;
            pg8::Order S; S.init1(G, bxp, HM, WMD, nmain, 4, FFE / 2);
            S.moe = 1; S.pb1 = pbase[1]; S.pb2 = pbase[2]; S.pb3 = pbase[3]; S.pb4 = pbase[4]; S.pb5 = pbase[5]; S.pb6 = pbase[6]; S.pb7 = pbase[7]; S.estride = (size_t)1024 * FFE;
            S.A1 = S.A0; S.B1 = S.B0; S.nM1 = ntail; S.nN1 = 4; S.kind1 = 1; S.nt1 = 4; S.ksl1 = 7; S.kbytes1 = (size_t)512;
            S.pm1off = nmain;
            EpiPlain E{YS, YTP, 1.f / (SC_H * SC_WD)};
            pg8::gemm_phase<EpiPlain, pg8::Order, true, true, true, 1>(lds + RING_OFF, tid, FFE / 2, S, E);
        }
        SEAM(23);
    }
    if (IN(24)) { PHASE_BEGIN();
        const float* modv = MODV + (size_t)5 * 6144; const float* fw = in[I_FNW];
#ifdef PROBE_LO
        const unsigned long long* stp = (const unsigned long long*)(ws + WS_CTL + 131072);
        const float probe_scale = 1.0f + (float)(__hip_atomic_load(stp + PROBE_HI, RLX_AGENT) - __hip_atomic_load(stp + PROBE_LO, RLX_AGENT)) * 0.01f * 5e-4f;
#else
        const float probe_scale = 1.0f;
#endif
        f32x4 fwv[4];
#pragma unroll
        for (int j = 0; j < 4; ++j) fwv[j] = *(const f32x4*)(fw + 4 * lane + 256 * j);
        int2 sl_c = make_int2(0, 0), sl_n = make_int2(0, 0); f32x2 tw_c = (f32x2){0.f, 0.f}, tw_n = (f32x2){0.f, 0.f};
        f32x4 xn[4], gn_[4]; v2u y1n[4], y2n[4];
#define FIN_LOAD(row_, sl_) do { const float* xr_ = LATX + (size_t)(row_) * 1024; const float* g2_ = modv + ((row_) >> 12) * 6144 + 5 * 1024; \
            const bf16* y1p_ = YS + (size_t)((sl_).x >= 32768 ? 0 : (sl_).x) * 1024; const bf16* y2p_ = YS + (size_t)((sl_).y >= 32768 ? 0 : (sl_).y) * 1024; \
            _Pragma("unroll") for (int j = 0; j < 4; ++j) { const int c = 4 * lane + 256 * j; xn[j] = *(const f32x4*)(xr_ + c); gn_[j] = *(const f32x4*)(g2_ + c); y1n[j] = *(const v2u*)(y1p_ + c); y2n[j] = *(const v2u*)(y2p_ + c); } } while (0)
        if (gw < NLAT) { sl_c = TOKS[gw]; tw_c = TOKW[gw]; }
        if (gw + NGW < NLAT) { sl_n = TOKS[gw + NGW]; tw_n = TOKW[gw + NGW]; }
        if (gw < NLAT) FIN_LOAD(gw, sl_c);
        for (int row = gw; row < NLAT; row += NGW) {
            const int2 sl = sl_c; const f32x2 tw = tw_c;
            f32x4 x[4], gg[4]; v2u y1[4], y2[4];
#pragma unroll
            for (int j = 0; j < 4; ++j) { x[j] = xn[j]; gg[j] = gn_[j]; y1[j] = y1n[j]; y2[j] = y2n[j]; }
            sl_c = sl_n; tw_c = tw_n;
            if (row + NGW < NLAT) FIN_LOAD(row + NGW, sl_c);
            if (row + 2 * NGW < NLAT) { sl_n = TOKS[row + 2 * NGW]; tw_n = TOKW[row + 2 * NGW]; }
            const bool tx = sl.x >= 32768, ty = sl.y >= 32768;
            f32x4 a[4], bq[4];
#pragma unroll
            for (int j = 0; j < 4; ++j) { a[j] = (f32x4){bflo(y1[j].x), bfhi(y1[j].x), bflo(y1[j].y), bfhi(y1[j].y)}; bq[j] = (f32x4){bflo(y2[j].x), bfhi(y2[j].x), bflo(y2[j].y), bfhi(y2[j].y)}; }
            if (tx) {
#pragma unroll
                for (int j = 0; j < 4; ++j) { a[j] = (f32x4){0.f, 0.f, 0.f, 0.f};
#pragma unroll
                    for (int k7 = 0; k7 < 7; ++k7) { const v2u y = *(const v2u*)(YTP + ((size_t)k7 * 2048 + (sl.x - 32768)) * 1024 + 4 * lane + 256 * j); a[j] = a[j] + (f32x4){bflo(y.x), bfhi(y.x), bflo(y.y), bfhi(y.y)}; } } }
            if (ty) {
#pragma unroll
                for (int j = 0; j < 4; ++j) { bq[j] = (f32x4){0.f, 0.f, 0.f, 0.f};
#pragma unroll
                    for (int k7 = 0; k7 < 7; ++k7) { const v2u y = *(const v2u*)(YTP + ((size_t)k7 * 2048 + (sl.y - 32768)) * 1024 + 4 * lane + 256 * j); bq[j] = bq[j] + (f32x4){bflo(y.x), bfhi(y.x), bflo(y.y), bfhi(y.y)}; } } }
            f32x4 v[4]; float ss = 0.f;
#pragma unroll
            for (int j = 0; j < 4; ++j) { v[j] = x[j] + gg[j] * (a[j] * tw[0] + bq[j] * tw[1]); ss += v[j][0] * v[j][0] + v[j][1] * v[j][1] + v[j][2] * v[j][2] + v[j][3] * v[j][3]; }
            const float rstd = rsqrtf(wave_sum(ss, lane) * (1.f / 1024.f) + EPS);
#pragma unroll
            for (int j = 0; j < 4; ++j) { const int c = 4 * lane + 256 * j; *(f32x4*)(args.out + (size_t)row * 1024 + c) = v[j] * rstd * fwv[j] * probe_scale; }
        }
#undef FIN_LOAD
    }
#undef IN
#undef SEAM
}

extern "C" void kernel_launch(void* const* d_in, const int* in_sizes, int n_in, void* d_out, int out_size, void* d_ws, size_t ws_size, hipStream_t stream) {
    static int grid = 0;
    if (grid == 0) {
        if (n_in != N_IN || out_size != NLAT * D || ws_size < WS_END) { fprintf(stderr, "kernel_launch: unexpected shapes (n_in %d, out %d, ws %zu)\n", n_in, out_size, ws_size); grid = -1; return; }
        int dev = 0, cus = 0, per_cu = 0;
        if (hipGetDevice(&dev) != hipSuccess || hipDeviceGetAttribute(&cus, hipDeviceAttributeMultiprocessorCount, dev) != hipSuccess) { grid = -1; return; }
        if (hipFuncSetAttribute((const void*)fwd_kernel, hipFuncAttributeMaxDynamicSharedMemorySize, LDS_BYTES) != hipSuccess) { fprintf(stderr, "kernel_launch: hipFuncSetAttribute failed\n"); grid = -1; return; }
        if (hipOccupancyMaxActiveBlocksPerMultiprocessor(&per_cu, (const void*)fwd_kernel, NWAVES * 64, LDS_BYTES) != hipSuccess || per_cu < 1) fprintf(stderr, "kernel_launch: occupancy query reports %d\n", per_cu);
        (void)hipGetLastError();
        grid = cus;
    }
    if (grid < 0) return;
    if (hipMemsetAsync((char*)d_ws + WS_CTL, 0, CTL_ZERO_BYTES, stream) != hipSuccess) return;
    Args a{};
    for (int i = 0; i < N_IN; ++i) a.in[i] = (const float*)d_in[i];
    a.out = (float*)d_out; a.ws = (unsigned char*)d_ws;
#if MK_ONE_LAUNCH
    a.ph_lo = 0; a.ph_hi = NPH;
    hipLaunchKernelGGL(fwd_kernel, dim3(grid), dim3(NWAVES * 64), LDS_BYTES, stream, a);
#else
    for (int p = 0; p < NPH; ++p) { a.ph_lo = p; a.ph_hi = p + 1; hipLaunchKernelGGL(fwd_kernel, dim3(grid), dim3(NWAVES * 64), LDS_BYTES, stream, a); }
#endif
}
```
